# Optimizing an MI355X kernel written in HIP

```python
import math
import jax, jax.numpy as jnp
from jax import lax
import numpy as np

D_MODEL = 1024
BATCH = 16
SEQ = 2048
DEPTH = 4

GRID_W = 64
CTX_LEN = 256
N_MIXERS = 4
KIND_POOL = 0
KIND_CONV = 1
KIND_MLA = 2
KIND_DIFF = 3
ATTN_KINDS = (KIND_MLA, KIND_DIFF)
Q_BLOCK = 128
ROPE_BASE = 10000.0
NORM_EPS = 1e-6
D_FF = 4 * D_MODEL
POOL_WINDOWS = (2, 4, 8, 16)
POOL_GROUP = D_MODEL // len(POOL_WINDOWS)
CONV_WIDTH = 3
MLA_HEADS = D_MODEL // 128
MLA_NOPE = 128
MLA_ROPE = 64
MLA_V = 128
MLA_Q_LORA = 3 * D_MODEL // 8
MLA_KV_LORA = D_MODEL // 4
MLA_SCALE = (MLA_NOPE + MLA_ROPE) ** -0.5
DIFF_HEADS = D_MODEL // 128
DIFF_HEAD_DIM = D_MODEL // (2 * DIFF_HEADS)
DIFF_SCALE = DIFF_HEAD_DIM ** -0.5

kernel_name = "hybrid_interleaved_diffusion_trunk"


def rms_norm(x, g):
    xf = x.astype(jnp.float32)
    y = xf * lax.rsqrt(jnp.mean(xf * xf, axis=-1, keepdims=True) + NORM_EPS)
    return (y * g.astype(jnp.float32)).astype(x.dtype)


def modulate(h, shift, scale):
    return h * (1.0 + scale) + shift


def axial_rope_tables(rows, rot_dim):
    t = jnp.arange(rows * GRID_W)
    row = (t // GRID_W).astype(jnp.float32)
    col = (t % GRID_W).astype(jnp.float32)
    n = rot_dim // 2
    inv_freq = ROPE_BASE ** (-jnp.arange(0, n, 2, dtype=jnp.float32) / n)

    def table(pos):
        ang = pos[:, None] * inv_freq[None, :]
        ang = jnp.concatenate([ang, ang], axis=-1)
        return (jnp.cos(ang), jnp.sin(ang))

    return table(row) + table(col)


def _rotate(x, cos, sin):
    half = x.shape[-1] // 2
    x1, x2 = x[..., :half], x[..., half:]
    return x * cos + jnp.concatenate([-x2, x1], axis=-1) * sin


def apply_axial_rope(x, rope):
    cos_r, sin_r, cos_c, sin_c = rope
    extra = x.ndim - 3

    def bc(t):
        return t.reshape((1, t.shape[0]) + (1,) * extra + (t.shape[1],))

    n = x.shape[-1] // 2
    xf = x.astype(jnp.float32)
    out = jnp.concatenate([_rotate(xf[..., :n], bc(cos_r), bc(sin_r)),
                           _rotate(xf[..., n:], bc(cos_c), bc(sin_c))], axis=-1)
    return out.astype(x.dtype)


def sweep_query_blocks(fn, *qs):
    b, length = qs[0].shape[:2]
    nb = length // Q_BLOCK
    blocks = tuple(jnp.moveaxis(q.reshape((b, nb, Q_BLOCK) + q.shape[2:]), 1, 0) for q in qs)
    out = lax.map(lambda blk: fn(*blk), blocks)
    return jnp.moveaxis(out, 0, 1).reshape((b, length) + out.shape[3:])


def pool_mixer(h, w_grp, scale):
    b, length, _ = h.shape
    hf = h.astype(jnp.float32)
    cs = jnp.concatenate([jnp.zeros_like(hf[:, :1]), jnp.cumsum(hf, axis=1)], axis=1)
    t = jnp.arange(length)
    parts = []
    for g, w in enumerate(POOL_WINDOWS):
        lo = w // 2
        hi = w - 1 - lo
        start = jnp.clip(t - lo, 0, length)
        end = jnp.clip(t + hi + 1, 0, length)
        sl = slice(g * POOL_GROUP, (g + 1) * POOL_GROUP)
        csg = cs[..., sl]
        win_sum = jnp.take(csg, end, axis=1) - jnp.take(csg, start, axis=1)
        count = (end - start).astype(jnp.float32)[None, :, None]
        parts.append(win_sum / count - hf[..., sl])
    d = jnp.stack(parts, axis=2).astype(h.dtype)
    y = jnp.einsum('blgc,gcd->blgd', d, w_grp).reshape(b, length, D_MODEL)
    return y * scale


def short_conv_mixer(h, w_in, conv_w, w_out):
    length = h.shape[1]
    b_gate, c_gate, v = jnp.split(h @ w_in, 3, axis=-1)
    u = c_gate * v
    pad = CONV_WIDTH // 2
    up = jnp.pad(u, ((0, 0), (pad, pad), (0, 0)))
    z = up[:, 0:length] * conv_w[0]
    for k in range(1, CONV_WIDTH):
        z = z + up[:, k:k + length] * conv_w[k]
    return (b_gate * z) @ w_out


def mla_mixer(h, hc, w_down, g_q, g_kv, w_uq, w_ukv, w_o, rope, need_ctx):
    def parse_q(a_q, rot):
        cq = rms_norm(a_q, g_q)
        q = (cq @ w_uq).reshape(a_q.shape[:2] + (MLA_HEADS, MLA_NOPE + MLA_ROPE))
        qn, qr = q[..., :MLA_NOPE], q[..., MLA_NOPE:]
        if rot is not None:
            qr = apply_axial_rope(qr, rot)
        return qn, qr

    def parse_kv(a_kv, rot):
        ckv = rms_norm(a_kv[..., :MLA_KV_LORA], g_kv)
        kr = a_kv[..., MLA_KV_LORA:]
        if rot is not None:
            kr = apply_axial_rope(kr, rot)
        kv = (ckv @ w_ukv).reshape(a_kv.shape[:2] + (MLA_HEADS, MLA_NOPE + MLA_V))
        return kv[..., :MLA_NOPE], kr, kv[..., MLA_NOPE:]

    def attend(qn, qr, kn, kr, v):
        def blk(qn_b, qr_b):
            s = (jnp.einsum('bqhd,bkhd->bhqk', qn_b, kn, preferred_element_type=jnp.float32)
                 + jnp.einsum('bqhr,bkr->bhqk', qr_b, kr, preferred_element_type=jnp.float32)) * MLA_SCALE
            p = jax.nn.softmax(s, axis=-1).astype(v.dtype)
            return jnp.einsum('bhqk,bkhd->bqhd', p, v)
        o = sweep_query_blocks(blk, qn, qr)
        return o.reshape(o.shape[:2] + (MLA_HEADS * MLA_V,)) @ w_o

    a = h @ w_down
    qn, qr = parse_q(a[..., :MLA_Q_LORA], rope)
    kn, kr, v = parse_kv(a[..., MLA_Q_LORA:], rope)
    if need_ctx:
        ac = hc @ w_down
        qn_c, qr_c = parse_q(ac[..., :MLA_Q_LORA], None)
        kn_c, kr_c, v_c = parse_kv(ac[..., MLA_Q_LORA:], None)
    else:
        kn_c, kr_c, v_c = parse_kv(hc @ w_down[:, MLA_Q_LORA:], None)
    y = attend(qn, qr, jnp.concatenate([kn, kn_c], axis=1), jnp.concatenate([kr, kr_c], axis=1),
               jnp.concatenate([v, v_c], axis=1))
    yc = attend(qn_c, qr_c, kn_c, kr_c, v_c) if need_ctx else None
    return y, yc


def diff_mixer(h, hc, w_qkv, lam_vecs, g_subln, w_o, lam_init, rope, need_ctx):
    lv = lam_vecs.astype(jnp.float32)
    lam = jnp.exp(jnp.sum(lv[0] * lv[1])) - jnp.exp(jnp.sum(lv[2] * lv[3])) + lam_init

    def heads_qk(t):
        return t.reshape(t.shape[:2] + (DIFF_HEADS, 2, DIFF_HEAD_DIM))

    def heads_v(t):
        return t.reshape(t.shape[:2] + (DIFF_HEADS, 2 * DIFF_HEAD_DIM))

    def attend(q, k, v):
        def blk(q_b):
            s = jnp.einsum('bqhjd,bkhjd->bhjqk', q_b, k, preferred_element_type=jnp.float32) * DIFF_SCALE
            p = jax.nn.softmax(s, axis=-1)
            a = p[:, :, 0] - lam * p[:, :, 1]
            return jnp.einsum('bhqk,bkhd->bqhd', a.astype(v.dtype), v)
        o = sweep_query_blocks(blk, q)
        o = rms_norm(o, g_subln) * (1.0 - lam_init)
        return o.reshape(o.shape[:2] + (D_MODEL,)) @ w_o

    q, k, v = jnp.split(h @ w_qkv, 3, axis=-1)
    q = apply_axial_rope(heads_qk(q), rope)
    k = apply_axial_rope(heads_qk(k), rope)
    v = heads_v(v)
    if need_ctx:
        qc, kc, vc = jnp.split(hc @ w_qkv, 3, axis=-1)
        qc = heads_qk(qc)
    else:
        kc, vc = jnp.split(hc @ w_qkv[:, D_MODEL:], 2, axis=-1)
    kc, vc = heads_qk(kc), heads_v(vc)
    y = attend(q, jnp.concatenate([k, kc], axis=1), jnp.concatenate([v, vc], axis=1))
    yc = attend(qc, kc, vc) if need_ctx else None
    return y, yc


def sqrelu_mlp(h, w1, w2):
    return jnp.square(jax.nn.relu(h @ w1)) @ w2


def setup_inputs(seed: int = 0) -> dict:
    key = jax.random.key(seed)
    k = jax.random.split(key, 24)

    def nrm(i, shape, scale):
        return jax.random.normal(k[i], shape, jnp.float32) * scale

    n_pool = len(range(KIND_POOL, DEPTH, N_MIXERS))
    n_conv = len(range(KIND_CONV, DEPTH, N_MIXERS))
    n_mla = len(range(KIND_MLA, DEPTH, N_MIXERS))
    n_diff = len(range(KIND_DIFF, DEPTH, N_MIXERS))
    D = D_MODEL
    return dict(
        x=nrm(0, (BATCH, SEQ, D), 1.0),
        c=nrm(1, (BATCH, D), 1.0),
        ctx=nrm(2, (BATCH, CTX_LEN, D), 1.0),
        c_ctx=nrm(3, (D,), 1.0),
        ada_w=nrm(4, (DEPTH, D, 6 * D), 0.5 * D ** -0.5),
        ada_b=nrm(5, (DEPTH, 6 * D), 0.02),
        norm_g=1.0 + nrm(6, (DEPTH, 4, D), 0.05),
        ffn_w1=nrm(7, (DEPTH, D, D_FF), D ** -0.5),
        ffn_w2=nrm(8, (DEPTH, D_FF, D), D_FF ** -0.5),
        pool_w=nrm(9, (n_pool, len(POOL_WINDOWS), POOL_GROUP, POOL_GROUP), POOL_GROUP ** -0.5),
        pool_scale=1.0 + nrm(10, (n_pool, D), 0.1),
        conv_in_w=nrm(11, (n_conv, D, 3 * D), D ** -0.5),
        conv_w=nrm(12, (n_conv, CONV_WIDTH, D), CONV_WIDTH ** -0.5),
        conv_out_w=nrm(13, (n_conv, D, D), D ** -0.5),
        mla_w_down=nrm(14, (n_mla, D, MLA_Q_LORA + MLA_KV_LORA + MLA_ROPE), D ** -0.5),
        mla_g_q=1.0 + nrm(15, (n_mla, MLA_Q_LORA), 0.05),
        mla_g_kv=1.0 + nrm(16, (n_mla, MLA_KV_LORA), 0.05),
        mla_w_uq=nrm(17, (n_mla, MLA_Q_LORA, MLA_HEADS * (MLA_NOPE + MLA_ROPE)), MLA_Q_LORA ** -0.5),
        mla_w_ukv=nrm(18, (n_mla, MLA_KV_LORA, MLA_HEADS * (MLA_NOPE + MLA_V)), MLA_KV_LORA ** -0.5),
        mla_w_o=nrm(19, (n_mla, MLA_HEADS * MLA_V, D), (MLA_HEADS * MLA_V) ** -0.5),
        diff_w_qkv=nrm(20, (n_diff, D, 3 * D), D ** -0.5),
        diff_lambda=nrm(21, (n_diff, 4, DIFF_HEAD_DIM), 0.1),
        diff_g_subln=1.0 + nrm(22, (n_diff, 2 * DIFF_HEAD_DIM), 0.05),
        diff_w_o=nrm(23, (n_diff, D, D), D ** -0.5),
    )


def reference(x, c, ctx, c_ctx, ada_w, ada_b, norm_g, ffn_w1, ffn_w2, pool_w, pool_scale,
              conv_in_w, conv_w, conv_out_w, mla_w_down, mla_g_q, mla_g_kv, mla_w_uq, mla_w_ukv,
              mla_w_o, diff_w_qkv, diff_lambda, diff_g_subln, diff_w_o):
    rows = x.shape[1] // GRID_W
    rope_mla = axial_rope_tables(rows, MLA_ROPE)
    rope_diff = axial_rope_tables(rows, DIFF_HEAD_DIM)
    silu_c = jax.nn.silu(c)
    silu_cc = jax.nn.silu(c_ctx)
    xc = ctx
    for i in range(DEPTH):
        kind = i % N_MIXERS
        j = i // N_MIXERS
        ctx_out = i < DEPTH - 1
        ctx_in = ctx_out or kind in ATTN_KINDS
        sh_m, sc_m, gt_m, sh_f, sc_f, gt_f = jnp.split(
            (silu_c @ ada_w[i] + ada_b[i])[:, None, :], 6, axis=-1)
        h = modulate(rms_norm(x, norm_g[i, 0]), sh_m, sc_m)
        hc = None
        if ctx_in:
            mc = jnp.split(silu_cc @ ada_w[i] + ada_b[i], 6)
            hc = modulate(rms_norm(xc, norm_g[i, 0]), mc[0], mc[1])
        if kind == KIND_POOL:
            y = pool_mixer(h, pool_w[j], pool_scale[j])
            yc = pool_mixer(hc, pool_w[j], pool_scale[j]) if ctx_out else None
        elif kind == KIND_CONV:
            y = short_conv_mixer(h, conv_in_w[j], conv_w[j], conv_out_w[j])
            yc = short_conv_mixer(hc, conv_in_w[j], conv_w[j], conv_out_w[j]) if ctx_out else None
        elif kind == KIND_MLA:
            y, yc = mla_mixer(h, hc, mla_w_down[j], mla_g_q[j], mla_g_kv[j], mla_w_uq[j],
                              mla_w_ukv[j], mla_w_o[j], rope_mla, ctx_out)
        else:
            lam_init = 0.8 - 0.6 * math.exp(-0.3 * i)
            y, yc = diff_mixer(h, hc, diff_w_qkv[j], diff_lambda[j], diff_g_subln[j], diff_w_o[j],
                               lam_init, rope_diff, ctx_out)
        x = x + gt_m * rms_norm(y, norm_g[i, 1])
        hf = modulate(rms_norm(x, norm_g[i, 2]), sh_f, sc_f)
        x = x + gt_f * rms_norm(sqrelu_mlp(hf, ffn_w1[i], ffn_w2[i]), norm_g[i, 3])
        if ctx_out:
            xc = xc + mc[2] * rms_norm(yc, norm_g[i, 1])
            hcf = modulate(rms_norm(xc, norm_g[i, 2]), mc[3], mc[4])
            xc = xc + mc[5] * rms_norm(sqrelu_mlp(hcf, ffn_w1[i], ffn_w2[i]), norm_g[i, 3])
    return x
```

```cpp
#include <hip/hip_runtime.h>
#include <hip/hip_cooperative_groups.h>
#include <cstdio>
#include <cstdint>
namespace cg = cooperative_groups;

#ifndef MK_ONE_LAUNCH
#define MK_ONE_LAUNCH 1
#endif

#define LAS __attribute__((address_space(3)))
typedef unsigned short bf16_t;
typedef short bf16x8 __attribute__((ext_vector_type(8)));
typedef short s16x4 __attribute__((ext_vector_type(4)));
typedef float f32x4 __attribute__((ext_vector_type(4)));
typedef float f32x16 __attribute__((ext_vector_type(16)));
typedef unsigned u32x4 __attribute__((ext_vector_type(4)));
typedef unsigned u32x2 __attribute__((ext_vector_type(2)));

constexpr int DM = 1024, NB = 16, SEQ = 2048, CTXL = 256, MLAT = NB * SEQ, MCTX = NB * CTXL, MALL = MLAT + MCTX;
constexpr float EPS = 1e-6f;
constexpr int NTHREADS = 512;
#ifndef MLA_NQL
#define MLA_NQL 4
#endif
constexpr int LDS_BYTES = (32768 + 49152 + 2048 + MLA_NQL * 8192) > 131072 ? (32768 + 49152 + 2048 + MLA_NQL * 8192) : 131072;

constexpr size_t WS_XC = 0;
constexpr size_t WS_H = WS_XC + (size_t)MCTX * DM * 4;
constexpr size_t WS_T1 = WS_H + (size_t)MALL * DM * 2;
constexpr size_t WS_W = WS_T1 + (size_t)MALL * 4096 * 2;
constexpr size_t W_ELTS = 45154304;
constexpr size_t WS_MOD = WS_W + W_ELTS * 2;
constexpr size_t WS_RS = WS_MOD + (size_t)4 * 17 * 6144 * 4;
constexpr size_t WS_ROPE = WS_RS + (size_t)MALL * 4;
constexpr size_t WS_SCR = WS_ROPE + 8192;
constexpr size_t WS_BAR = WS_SCR + (size_t)256 * 64 * 512 * 4;
constexpr size_t WS_END = WS_BAR + 256;
static_assert(WS_SCR % 256 == 0 && WS_MOD % 256 == 0 && WS_RS % 256 == 0 && WS_ROPE % 256 == 0, "align");
static_assert(WS_END <= 536870912ull, "workspace budget");
constexpr size_t W_FFN = 0;
constexpr size_t W_POOL = 33554432;
constexpr size_t W_CIN = W_POOL + 262144;
constexpr size_t W_COUT = W_CIN + 3145728;
constexpr size_t W_DOWN = W_COUT + 1048576;
constexpr size_t W_UQ = W_DOWN + 786432;
constexpr size_t W_UKV = W_UQ + 589824;
constexpr size_t W_MO = W_UKV + 524288;
constexpr size_t W_DQKV = W_MO + 1048576;
constexpr size_t W_DO = W_DQKV + 3145728;
static_assert(W_DO + 1048576 == W_ELTS, "weights");
constexpr size_t T_Q = 0;
constexpr size_t T_KV = T_Q + (size_t)MALL * 1536;
constexpr size_t T_CQ = T_KV + (size_t)MALL * 2048;
constexpr size_t T_KR = T_CQ + (size_t)MALL * 384;
constexpr size_t T_AB = T_KV;
static_assert(T_KR + (size_t)MALL * 64 <= (size_t)MALL * 4096, "arena");

struct Params {
    const float *x, *c, *ctx, *c_ctx, *ada_w, *ada_b, *norm_g, *ffn_w1, *ffn_w2, *pool_w, *pool_scale, *conv_in_w, *conv_w, *conv_out_w,
        *mla_w_down, *mla_g_q, *mla_g_kv, *mla_w_uq, *mla_w_ukv, *mla_w_o, *diff_w_qkv, *diff_lambda, *diff_g_subln, *diff_w_o;
    float* out; unsigned char* ws; int ph_lo, ph_hi;
};

__device__ __forceinline__ int tid_opaque() { int t = threadIdx.x; asm volatile("" : "+v"(t)); return t; }
__device__ __forceinline__ unsigned cvt_pk_bf16(float lo, float hi) { unsigned r; asm volatile("v_cvt_pk_bf16_f32 %0, %1, %2" : "=v"(r) : "v"(lo), "v"(hi)); return r; }
__device__ __forceinline__ float bf_lo(unsigned w) { return __uint_as_float(w << 16); }
__device__ __forceinline__ float bf_hi(unsigned w) { return __uint_as_float(w & 0xffff0000u); }
__device__ __forceinline__ float wave_sum(float v) {
#pragma unroll
    for (int o = 32; o >= 1; o >>= 1) v += __shfl_xor(v, o);
    return v;
}
__device__ __forceinline__ int modrow(int row) { return row < MLAT ? (row >> 11) : NB; }
__device__ __forceinline__ void load_bf4(const bf16_t* p, float* v) { const u32x2 w = *(const u32x2*)p; v[0] = bf_lo(w.x); v[1] = bf_hi(w.x); v[2] = bf_lo(w.y); v[3] = bf_hi(w.y); }
__device__ __forceinline__ void store_bf4(bf16_t* p, float a, float b, float c, float d) { u32x2 w; w.x = cvt_pk_bf16(a, b); w.y = cvt_pk_bf16(c, d); *(u32x2*)p = w; }

constexpr int BM = 256, BK = 64, HALF = 128, HTB = HALF * BK * 2;
__device__ __forceinline__ int lds_byte(int r, int c) { const int st = (r >> 4) * 2 + (c >> 5), rr = r & 15, cc = c & 31, ob = rr * 64 + cc * 2; return st * 1024 + (ob ^ (((ob >> 9) & 1) << 5)); }
__device__ __forceinline__ void stage_rc(int b, int& R, int& C) { const int st = b / 1024, sb = b % 1024, swz = sb ^ (((sb >> 9) & 1) << 5); R = (st >> 1) * 16 + swz / 64; C = (st & 1) * 32 + (swz % 64) / 2; }

struct Unit { int pm, pn, ks, nt; };
struct GemmP { const bf16_t* A; const bf16_t* Bt; int lda, ldb, K, nM, nN, a_pn_off, ksplit, a_tiled, rev, magicN; };
struct EpiP { bf16_t* O; int ldo; int mode; const float* colscale; const float* rope; bf16_t* Opart; };

__device__ __forceinline__ bool unit_next(const GemmP& g, int i, Unit& u) {
    const int nMf = g.ksplit > 1 ? 128 : g.nM;
    const int nwg = nMf * g.nN; const int L = i * (int)gridDim.x + (g.rev ? (int)gridDim.x - 1 - (int)blockIdx.x : (int)blockIdx.x);
    if (L >= nwg) {
        if (g.ksplit <= 1) return false;
        const int idx = L - nwg; if (idx >= (g.nM - nMf) * 16) return false;
        u.pm = nMf + (idx >> 4); const int r = idx & 15; u.pn = r >> 2; u.ks = r & 3; u.nt = g.K >> 8; return true;
    }
    int wgid = L; { const int q = nwg >> 3, xcd = wgid & 7, off = wgid >> 3; wgid = xcd * q + off; }
    const int w8 = wgid >> 3, gid = (w8 * g.magicN) >> 16, rem = wgid - gid * 8 * g.nN;
    u.pm = gid * 8 + (rem & 7); u.pn = rem >> 3; u.ks = -1; u.nt = g.K >> 6; return true;
}

__device__ __forceinline__ void epi_store(const f32x4 (&acc)[2][2][4][2], const Unit& u, int wr, int wc, int fr, int fq, const EpiP& e) {
    const int row0 = u.pm * BM + wr * 64 + fr;
    if (e.mode < 2) {
        const int col0 = u.pn * BM + wc * 32 + 8 * fq;
#pragma unroll
        for (int bj = 0; bj < 2; ++bj) {
            const int c = col0 + bj * HALF;
            f32x4 cs0 = {1.f, 1.f, 1.f, 1.f}, cs1 = {1.f, 1.f, 1.f, 1.f};
            if (e.mode == 0 && e.colscale) { cs0 = *(const f32x4*)(e.colscale + c); cs1 = *(const f32x4*)(e.colscale + c + 4); }
#pragma unroll
            for (int ai = 0; ai < 2; ++ai)
#pragma unroll
                for (int m = 0; m < 4; ++m) {
                    const int row = row0 + ai * HALF + m * 16;
                    f32x4 v0 = acc[ai][bj][m][0], v1 = acc[ai][bj][m][1];
                    if (e.mode == 1) {
#pragma unroll
                        for (int j = 0; j < 4; ++j) { const float a = fmaxf(v0[j], 0.f), b = fmaxf(v1[j], 0.f); v0[j] = a * a; v1[j] = b * b; }
                    } else { v0 *= cs0; v1 *= cs1; }
                    bf16_t* rowp = (u.ks < 0 ? e.O + (size_t)row * e.ldo : e.Opart + ((size_t)u.ks * MCTX + (row - MLAT)) * 1024) + c;
                    if (e.mode == 1)
                        rowp = (bf16_t*)((char*)e.O + ((size_t)(u.pm * 64 + u.pn * 4 + bj * 2 + (wc >> 1))) * 32768 + ai * 16384 + (((wr * 4 + m) * 2 + (wc & 1)) * 1024) + (fr * 4 + fq) * 16);
                    u32x4 w; w.x = cvt_pk_bf16(v0[0], v0[1]); w.y = cvt_pk_bf16(v0[2], v0[3]); w.z = cvt_pk_bf16(v1[0], v1[1]); w.w = cvt_pk_bf16(v1[2], v1[3]);
                    *(u32x4*)rowp = w;
                }
        }
        return;
    }
    const int col0 = u.pn * BM + wc * 32 + 4 * fq;
#pragma unroll
    for (int bj = 0; bj < 2; ++bj) {
        const int c = col0 + bj * HALF;
        int kind = 0;
        if (e.mode == 2) { if (c < 2048) kind = ((c >> 5) & 1) ? 2 : 1; }
        else { const int d = c % 192; if (d >= 128) kind = (d >= 160) ? 2 : 1; }
#pragma unroll
        for (int ai = 0; ai < 2; ++ai)
#pragma unroll
            for (int m = 0; m < 4; ++m) {
                const int row = row0 + ai * HALF + m * 16;
                f32x4 v0 = acc[ai][bj][m][0], v1 = acc[ai][bj][m][1];
                if (kind != 0 && row < MLAT) {
                    const int t = row & (SEQ - 1); const int pos = (kind == 1) ? (t >> 6) : (t & 63);
                    const f32x4 t0 = *(const f32x4*)(e.rope + (pos * 16 + 4 * fq) * 2), t1 = *(const f32x4*)(e.rope + (pos * 16 + 4 * fq) * 2 + 4);
                    const float cs[4] = {t0[0], t0[2], t1[0], t1[2]}, sn[4] = {t0[1], t0[3], t1[1], t1[3]};
#pragma unroll
                    for (int j = 0; j < 4; ++j) { const float x1 = v0[j], x2 = v1[j]; v0[j] = x1 * cs[j] - x2 * sn[j]; v1[j] = x2 * cs[j] + x1 * sn[j]; }
                }
                bf16_t* rowp = e.O + (size_t)row * e.ldo + c;
                u32x2 w0, w1; w0.x = cvt_pk_bf16(v0[0], v0[1]); w0.y = cvt_pk_bf16(v0[2], v0[3]); w1.x = cvt_pk_bf16(v1[0], v1[1]); w1.y = cvt_pk_bf16(v1[2], v1[3]);
                const bool odd = (fq & 1) != 0;
                const unsigned sx = odd ? w0.x : w1.x, sy = odd ? w0.y : w1.y;
                const unsigned rx = (unsigned)__shfl_xor((int)sx, 16), ry = (unsigned)__shfl_xor((int)sy, 16);
                u32x4 w; if (odd) { w.x = rx; w.y = ry; w.z = w1.x; w.w = w1.y; } else { w.x = w0.x; w.y = w0.y; w.z = rx; w.w = ry; }
                *(u32x4*)(rowp + (odd ? 12 : 0)) = w;
            }
    }
}

__device__ __forceinline__ void gemm_phase(LAS unsigned char* lds, const GemmP g, const EpiP e) {
    const int tid = tid_opaque(), wid = __builtin_amdgcn_readfirstlane(tid >> 6), lane = tid & 63, wr = wid >> 2, wc = wid & 3, fr = lane & 15, fq = lane >> 4;
    unsigned voffA[2], voffB[2];
#pragma unroll
    for (int i = 0; i < 2; ++i) { int R, C; stage_rc(tid * 16 + i * 8192, R, C); const int rho = R & 31; const int Rb = (e.mode < 2) ? ((R & ~31) + 8 * ((rho & 15) >> 2) + 4 * (rho >> 4) + (rho & 3)) : R;
        voffA[i] = g.a_tiled ? (unsigned)((((R >> 4) * 2 + (C >> 5)) * 1024) + ((R & 15) * 4 + ((C >> 3) & 3)) * 16) : (unsigned)(R * g.lda + C) * 2u; voffB[i] = (unsigned)(Rb * g.ldb + C) * 2u; }
    const size_t kstepB = (size_t)(BK * 2), kstepA = g.a_tiled ? (size_t)32768 : (size_t)(BK * 2);
    const size_t hstepA = g.a_tiled ? (size_t)16384 : (size_t)HALF * g.lda * 2, hstepB = (size_t)HALF * g.ldb * 2;
    const size_t tstepA = g.a_tiled ? (size_t)(g.K / BK) * 32768 : 2 * hstepA, tstepB = 2 * hstepB;
    const unsigned ldsw = (unsigned)wid * 1024u;
    const int aoff = lds_byte(wr * 64 + fr, fq * 8), boff = lds_byte(wc * 32 + fr, fq * 8);
#define PG8_SA(b, h) (((b) * 2 + (h)) * HTB)
#define PG8_SB(b, h) ((4 + (b) * 2 + (h)) * HTB)
#define PG8_STAGE(bufoff, gbase, voff) do { _Pragma("unroll") for (int _i = 0; _i < 2; ++_i) \
        __builtin_amdgcn_global_load_lds((const unsigned*)((const char*)(gbase) + (voff)[_i]), (LAS unsigned*)(lds + (bufoff) + ldsw + _i * 8192), 16, 0, 0); } while (0)
#define PG8_LDA(dst, b, h) do { _Pragma("unroll") for (int m = 0; m < 4; ++m) _Pragma("unroll") for (int k = 0; k < 2; ++k) dst[m][k] = *(const LAS bf16x8*)(lds + PG8_SA(b, h) + aoff + m * 2048 + k * 1024); } while (0)
#define PG8_LDB(dst, b, h) do { _Pragma("unroll") for (int n = 0; n < 2; ++n) _Pragma("unroll") for (int k = 0; k < 2; ++k) dst[n][k] = *(const LAS bf16x8*)(lds + PG8_SB(b, h) + boff + n * 2048 + k * 1024); } while (0)
#define PG8_MMA(ai, bj, At, Bt) do { __builtin_amdgcn_s_setprio(1); _Pragma("unroll") for (int m = 0; m < 4; ++m) _Pragma("unroll") for (int n = 0; n < 2; ++n) _Pragma("unroll") for (int k = 0; k < 2; ++k) \
        acc[ai][bj][m][n] = __builtin_amdgcn_mfma_f32_16x16x32_bf16(Bt[n][k], At[m][k], acc[ai][bj][m][n], 0, 0, 0); __builtin_amdgcn_s_setprio(0); } while (0)
#define PG8_WAIT_V(n) asm volatile("s_waitcnt vmcnt(" #n ")" ::: "memory")
#define PG8_WAIT_L(n) asm volatile("s_waitcnt lgkmcnt(" #n ")" ::: "memory")
#define PG8_BAR __builtin_amdgcn_s_barrier()
#define PG8_SCHED __builtin_amdgcn_sched_barrier(0)
    Unit cur, nxt; int ui = 0;
    if (!unit_next(g, 0, cur)) return;
    f32x4 acc[2][2][4][2];
#pragma unroll
    for (int a = 0; a < 2; ++a)
#pragma unroll
        for (int b = 0; b < 2; ++b)
#pragma unroll
            for (int m = 0; m < 4; ++m)
#pragma unroll
                for (int n = 0; n < 2; ++n) acc[a][b][m][n] = (f32x4){0.f, 0.f, 0.f, 0.f};
    bf16x8 At[4][2], B0[2][2], B1[2][2];
    const size_t ksliceB = (size_t)(g.ksplit > 1 ? g.K / g.ksplit : 0) * 2;
    const size_t ksliceA = g.a_tiled ? (size_t)(g.ksplit > 1 ? g.K / g.ksplit / BK : 0) * 32768 : ksliceB;
#define UNIT_A(u_) ((const char*)g.A + (size_t)(u_).pm * tstepA + (size_t)(u_).pn * g.a_pn_off * 2 + ((u_).ks > 0 ? (u_).ks * ksliceA : 0))
#define UNIT_B(u_) ((const char*)g.Bt + (size_t)(u_).pn * tstepB + ((u_).ks > 0 ? (u_).ks * ksliceB : 0))
    const char* cA = UNIT_A(cur); const char* cB = UNIT_B(cur);
    PG8_STAGE(PG8_SB(0, 0), cB, voffB); PG8_STAGE(PG8_SB(0, 1), cB + hstepB, voffB); PG8_STAGE(PG8_SA(0, 0), cA, voffA); PG8_STAGE(PG8_SA(0, 1), cA + hstepA, voffA);
    if (wr == 1) PG8_BAR;
    PG8_WAIT_V(2); PG8_BAR;
    PG8_STAGE(PG8_SB(1, 0), cB + kstepB, voffB); PG8_STAGE(PG8_SA(1, 0), cA + kstepA, voffA); PG8_STAGE(PG8_SB(1, 1), cB + hstepB + kstepB, voffB);
    PG8_WAIT_V(6); PG8_BAR;
    for (;;) {
        const bool has_next = unit_next(g, ui + 1, nxt);
        const char* nA = has_next ? UNIT_A(nxt) : cA; const char* nB = has_next ? UNIT_B(nxt) : cB;
        const int nt = cur.nt;
        for (int t = 0; t < nt; t += 2) {
            const bool last = (t == nt - 2);
            const char* a1 = cA + (size_t)(t + 1) * kstepA;
            const char* a2 = last ? nA : cA + (size_t)(t + 2) * kstepA; const char* b2 = last ? nB : cB + (size_t)(t + 2) * kstepB;
            const char* a3 = a2 + kstepA; const char* b3 = b2 + kstepB;
            PG8_LDB(B0, 0, 0); PG8_LDB(B1, 0, 1); PG8_SCHED; PG8_LDA(At, 0, 0); PG8_STAGE(PG8_SA(1, 1), a1 + hstepA, voffA);
            PG8_WAIT_V(8); PG8_WAIT_L(0); PG8_BAR; PG8_MMA(0, 0, At, B0); PG8_MMA(0, 1, At, B1); PG8_BAR; PG8_SCHED;
            PG8_LDA(At, 0, 1); PG8_STAGE(PG8_SB(0, 0), b2, voffB); PG8_STAGE(PG8_SB(0, 1), b2 + hstepB, voffB); PG8_STAGE(PG8_SA(0, 0), a2, voffA);
            PG8_WAIT_V(8); PG8_WAIT_L(0); PG8_BAR; PG8_MMA(1, 0, At, B0); PG8_MMA(1, 1, At, B1); PG8_BAR; PG8_SCHED;
            PG8_LDB(B0, 1, 0); PG8_LDB(B1, 1, 1); PG8_SCHED; PG8_LDA(At, 1, 0); PG8_STAGE(PG8_SA(0, 1), a2 + hstepA, voffA);
            PG8_WAIT_V(8); PG8_WAIT_L(0); PG8_BAR; PG8_MMA(0, 0, At, B0); PG8_MMA(0, 1, At, B1); PG8_BAR; PG8_SCHED;
            PG8_LDA(At, 1, 1); PG8_STAGE(PG8_SB(1, 0), b3, voffB); PG8_STAGE(PG8_SB(1, 1), b3 + hstepB, voffB); PG8_STAGE(PG8_SA(1, 0), a3, voffA);
            PG8_WAIT_V(8); PG8_WAIT_L(0); PG8_BAR; PG8_MMA(1, 0, At, B0); PG8_MMA(1, 1, At, B1); PG8_BAR; PG8_SCHED;
        }
        if (wr == 0) PG8_BAR;
        epi_store(acc, cur, wr, wc, fr, fq, e);
        if (!has_next) break;
#pragma unroll
        for (int a = 0; a < 2; ++a)
#pragma unroll
            for (int b = 0; b < 2; ++b)
#pragma unroll
                for (int m = 0; m < 4; ++m)
#pragma unroll
                    for (int n = 0; n < 2; ++n) acc[a][b][m][n] = (f32x4){0.f, 0.f, 0.f, 0.f};
        cur = nxt; cA = nA; cB = nB; ++ui;
        if (wr == 1) PG8_BAR;
    }
    PG8_WAIT_V(0);
    PG8_BAR;
#undef UNIT_A
#undef UNIT_B
#undef PG8_SA
#undef PG8_SB
#undef PG8_STAGE
#undef PG8_LDA
#undef PG8_LDB
#undef PG8_MMA
#undef PG8_WAIT_V
#undef PG8_WAIT_L
#undef PG8_BAR
#undef PG8_SCHED
}

#define SBAR() __builtin_amdgcn_sched_barrier(0)
__device__ __forceinline__ int crow(int r, int hi) { return (r & 3) + 8 * (r >> 2) + 4 * hi; }
__device__ __forceinline__ int v_st(int k, int c) { const int kk = (k & ~0xC) | ((k & 4) << 1) | ((k & 8) >> 1); return ((kk >> 3) * 4 + (c >> 5)) * 512 + ((kk & 7) * 32 + (c & 31)) * 2; }
__device__ __forceinline__ int v_rd_base(int lane) { return ((lane & 3) << 3) | (((lane >> 2) & 3) << 6) | (((lane >> 4) & 1) << 5) | (((lane >> 5) & 1) << 8); }
constexpr int v_rd_off(int d0, int ks, int half) { return d0 * 512 + ks * 4096 + half * 2048; }
template <int OFF> __device__ __forceinline__ s16x4 tr_read(int vb) { s16x4 r; asm volatile("ds_read_b64_tr_b16 %0, %1 offset:%2" : "=&v"(r) : "v"(vb), "i"(OFF) : "memory"); return r; }
template <int D0> __device__ __forceinline__ void pv_one(f32x16& od, int vb, bf16x8 pa0, bf16x8 pa1, bf16x8 pa2, bf16x8 pa3) {
    const s16x4 l0 = tr_read<v_rd_off(D0, 0, 0)>(vb), h0 = tr_read<v_rd_off(D0, 0, 1)>(vb), l1 = tr_read<v_rd_off(D0, 1, 0)>(vb), h1 = tr_read<v_rd_off(D0, 1, 1)>(vb);
    const s16x4 l2 = tr_read<v_rd_off(D0, 2, 0)>(vb), h2 = tr_read<v_rd_off(D0, 2, 1)>(vb), l3 = tr_read<v_rd_off(D0, 3, 0)>(vb), h3 = tr_read<v_rd_off(D0, 3, 1)>(vb);
    asm volatile("s_waitcnt lgkmcnt(0)" ::: "memory"); SBAR();
#define PK(L, H) (bf16x8){L[0], L[1], L[2], L[3], H[0], H[1], H[2], H[3]}
    od = __builtin_amdgcn_mfma_f32_32x32x16_bf16(pa0, PK(l0, h0), od, 0, 0, 0);
    od = __builtin_amdgcn_mfma_f32_32x32x16_bf16(pa1, PK(l1, h1), od, 0, 0, 0);
    od = __builtin_amdgcn_mfma_f32_32x32x16_bf16(pa2, PK(l2, h2), od, 0, 0, 0);
    od = __builtin_amdgcn_mfma_f32_32x32x16_bf16(pa3, PK(l3, h3), od, 0, 0, 0);
#undef PK
}
__device__ __forceinline__ void pv_d0(f32x16* o, int vb, bf16x8 pa0, bf16x8 pa1, bf16x8 pa2, bf16x8 pa3) {
    pv_one<0>(o[0], vb, pa0, pa1, pa2, pa3); pv_one<1>(o[1], vb, pa0, pa1, pa2, pa3); pv_one<2>(o[2], vb, pa0, pa1, pa2, pa3); pv_one<3>(o[3], vb, pa0, pa1, pa2, pa3);
}
__device__ __forceinline__ void partialSM(f32x16& p0, f32x16& p1, float& m_reg, float& mn, float& alpha, const float C, const float thr) {
    float pmax = p0[0];
#pragma unroll
    for (int r = 1; r < 16; ++r) pmax = fmaxf(pmax, p0[r]);
#pragma unroll
    for (int r = 0; r < 16; ++r) pmax = fmaxf(pmax, p1[r]);
    { auto rr = __builtin_amdgcn_permlane32_swap(__float_as_uint(pmax), __float_as_uint(pmax), false, false);
      pmax = fmaxf(__uint_as_float(rr[0]), __uint_as_float(rr[1])); }
    if (__builtin_expect(__all(pmax - m_reg <= thr), 1)) { mn = m_reg; alpha = 1.f; }
    else { mn = fmaxf(m_reg, pmax); alpha = __builtin_amdgcn_exp2f((m_reg - mn) * C); m_reg = mn; }
    const float mnC = -mn * C;
#pragma unroll
    for (int r = 0; r < 16; ++r) p0[r] = fmaf(p0[r], C, mnC);
#pragma unroll
    for (int r = 0; r < 16; ++r) p1[r] = fmaf(p1[r], C, mnC);
#pragma unroll
    for (int r = 0; r < 16; ++r) p0[r] = __builtin_amdgcn_exp2f(p0[r]);
}
__device__ __forceinline__ void finishSM(f32x16& p0, f32x16& p1, float alpha, float& l_reg, bf16x8& pa0, bf16x8& pa1, bf16x8& pa2, bf16x8& pa3) {
#pragma unroll
    for (int r = 0; r < 16; ++r) p1[r] = __builtin_amdgcn_exp2f(p1[r]);
    float ps = 0;
#pragma unroll
    for (int r = 0; r < 16; ++r) ps += p0[r];
#pragma unroll
    for (int r = 0; r < 16; ++r) ps += p1[r];
    { auto rr = __builtin_amdgcn_permlane32_swap(__float_as_uint(ps), __float_as_uint(ps), false, false);
      ps = __uint_as_float(rr[0]) + __uint_as_float(rr[1]); }
    l_reg = l_reg * alpha + ps;
#define PK4(P, BASE, OUT) do { unsigned a0 = cvt_pk_bf16(P[BASE + 0], P[BASE + 1]), a1 = cvt_pk_bf16(P[BASE + 2], P[BASE + 3]);   \
    unsigned b0 = cvt_pk_bf16(P[BASE + 4], P[BASE + 5]), b1 = cvt_pk_bf16(P[BASE + 6], P[BASE + 7]);                              \
    auto r0 = __builtin_amdgcn_permlane32_swap(a0, b0, false, false); auto r1 = __builtin_amdgcn_permlane32_swap(a1, b1, false, false); \
    u32x4 w = {r0[0], r1[0], r0[1], r1[1]}; OUT = *reinterpret_cast<bf16x8*>(&w); } while (0)
    PK4(p0, 0, pa0); PK4(p0, 8, pa1); PK4(p1, 0, pa2); PK4(p1, 8, pa3);
#undef PK4
}

struct AttnArgs {
    const bf16_t* Q; int ldq;
    const bf16_t* Kn; int ldk;
    const bf16_t* Kr; int ldkr;
    const bf16_t* V; int ldv;
    int lat0, ctx0, nlat, NT;
    float C, thr;
};

template <int DQK, int DK1, int LDQ, int LDK, int LDKR, int LDV, int NQL, int SDEPTH>
__device__ __forceinline__ void attn_core(const AttnArgs& a, char* lds, f32x16 (&o)[4]) {
    constexpr int KP = DQK * 2, SHM_K = 64 * KP, SHM_V = 64 * 128 * 2, KCH = DQK / 64, CPR = DQK / 8, ND0 = DQK / 16;
    const int tid = tid_opaque(), wid = tid >> 6, lane = tid & 63, r32 = lane & 31, hi = lane >> 5;
    char* V_lds = lds; char* K_lds = lds + 2 * SHM_V;
    float* wsf = (float*)(lds + 2 * SHM_V + 2 * SHM_K) + wid * 64; float* li_l = wsf; float* al_l = wsf + 32;
    float m_reg = -1e30f, l_reg = 0.f;
#pragma unroll
    for (int d = 0; d < 4; ++d)
#pragma unroll
        for (int r = 0; r < 16; ++r) o[d][r] = 0.f;
    constexpr int NQR = ND0 - NQL;
    bf16x8 qr[NQR];
    char* QL = lds + 2 * SHM_V + 2 * SHM_K + 2048 + tid * 16;
    { const bf16_t* Qw = a.Q + (long)(wid * 32 + r32) * LDQ + hi * 8;
#pragma unroll
      for (int d0 = 0; d0 < NQR; ++d0) qr[d0] = *(const bf16x8*)(Qw + d0 * 16);
#pragma unroll
      for (int d0 = NQR; d0 < ND0; ++d0) *(bf16x8*)(QL + (d0 - NQR) * 8192) = *(const bf16x8*)(Qw + d0 * 16); }
    const int sr = tid >> 4, sc = (tid & 15) * 8, vst0 = v_st(sr, sc), vst1 = v_st(32 + sr, sc);
    const int vb0 = (int)(uintptr_t)V_lds + v_rd_base(lane);
    const bf16_t* kptr[KCH]; int kld[KCH], kwo[KCH];
#pragma unroll
    for (int c = 0; c < KCH; ++c) { const int idx = tid + c * 512, kr_ = idx / CPR, kc = (idx % CPR) * 8;
        if (kc < DK1) { kptr[c] = a.Kn + (long)kr_ * LDK + kc; kld[c] = LDK; } else { kptr[c] = a.Kr + (long)kr_ * LDKR + (kc - DK1); kld[c] = LDKR; }
        kwo[c] = kr_ * KP + ((kc * 2) ^ ((kr_ & 7) << 4)); }
    struct { bf16x8 vs0, vs1, ks[KCH]; } sr_[SDEPTH];
    int kb[4];
#pragma unroll
    for (int m = 0; m < 4; ++m) kb[m] = r32 * KP + ((m * 32 + hi * 16) ^ ((r32 & 7) << 4));
#define KROW(j) ((j) < a.nlat ? a.lat0 + 64 * (j) : a.ctx0 + 64 * ((j) - a.nlat))
#define SLOAD(i, j) do { const long rb_ = KROW(j); sr_[i].vs0 = *(const bf16x8*)(a.V + (rb_ + sr) * LDV + sc); sr_[i].vs1 = *(const bf16x8*)(a.V + (rb_ + 32 + sr) * LDV + sc); \
    _Pragma("unroll") for (int c_ = 0; c_ < KCH; ++c_) sr_[i].ks[c_] = *(const bf16x8*)(kptr[c_] + rb_ * kld[c_]); } while (0)
#define SWRITE(b, i) do { *(bf16x8*)(V_lds + (b) * SHM_V + vst0) = sr_[i].vs0; *(bf16x8*)(V_lds + (b) * SHM_V + vst1) = sr_[i].vs1; \
    _Pragma("unroll") for (int c_ = 0; c_ < KCH; ++c_) *(bf16x8*)(K_lds + (b) * SHM_K + kwo[c_]) = sr_[i].ks[c_]; } while (0)
#define RESC(al) do { if (__any((al) < 1.f)) { if (hi == 0) al_l[r32] = (al); asm volatile("s_waitcnt lgkmcnt(0)" ::: "memory"); \
    _Pragma("unroll") for (int d = 0; d < 4; ++d) _Pragma("unroll") for (int r = 0; r < 16; ++r) o[d][r] *= al_l[crow(r, hi)]; } } while (0)
#define QKT(P0, P1, KB) do { P0 = f32x16{}; P1 = f32x16{}; \
    _Pragma("unroll") for (int d0 = 0; d0 < ND0; ++d0) { \
      const bf16x8 b0 = *(const bf16x8*)((KB) + kb[d0 & 3] + (d0 >> 2) * 128); \
      const bf16x8 b1 = *(const bf16x8*)((KB) + kb[d0 & 3] + (d0 >> 2) * 128 + 32 * KP); \
      const bf16x8 qf = (d0 < NQR) ? qr[d0 < NQR ? d0 : 0] : *(const bf16x8*)(QL + (d0 - NQR) * 8192); \
      P0 = __builtin_amdgcn_mfma_f32_32x32x16_bf16(b0, qf, P0, 0, 0, 0); \
      P1 = __builtin_amdgcn_mfma_f32_32x32x16_bf16(b1, qf, P1, 0, 0, 0); } } while (0)
    f32x16 pA0, pA1, pB0, pB1; float mnA, mnB, alA, alB; bf16x8 pa0, pa1, pa2, pa3; const int NT = a.NT;
    constexpr int SE = 0, SO = SDEPTH - 1;
    SLOAD(SE, 0); asm volatile("s_waitcnt vmcnt(0)" ::: "memory"); SWRITE(0, SE); __syncthreads();
    QKT(pA0, pA1, K_lds); partialSM(pA0, pA1, m_reg, mnA, alA, a.C, a.thr);
    SLOAD(SO, 1); if (SDEPTH == 2 && 2 < NT) SLOAD(SE, 2);
    SWRITE(1, SO); __syncthreads();
    for (int j = 1; j + 1 < NT; j += 2) {
        SBAR(); QKT(pB0, pB1, K_lds + SHM_K);
        finishSM(pA0, pA1, alA, l_reg, pa0, pa1, pa2, pa3); SBAR();
        SLOAD(SO, j + SDEPTH); SBAR();
        pv_d0(o, vb0, pa0, pa1, pa2, pa3); partialSM(pB0, pB1, m_reg, mnB, alB, a.C, a.thr);
        __syncthreads(); SWRITE(0, SE);
        RESC(alB); __syncthreads();
        SBAR(); QKT(pA0, pA1, K_lds);
        finishSM(pB0, pB1, alB, l_reg, pa0, pa1, pa2, pa3); SBAR();
        if (SDEPTH == 1 || j + 3 < NT) SLOAD(SE, j + 1 + SDEPTH); SBAR();
        pv_d0(o, vb0 + SHM_V, pa0, pa1, pa2, pa3); partialSM(pA0, pA1, m_reg, mnA, alA, a.C, a.thr);
        __syncthreads(); SWRITE(1, SO);
        RESC(alA); __syncthreads();
    }
    SBAR(); QKT(pB0, pB1, K_lds + SHM_K);
    finishSM(pA0, pA1, alA, l_reg, pa0, pa1, pa2, pa3); SBAR();
    pv_d0(o, vb0, pa0, pa1, pa2, pa3); partialSM(pB0, pB1, m_reg, mnB, alB, a.C, a.thr);
    __syncthreads(); RESC(alB);
    finishSM(pB0, pB1, alB, l_reg, pa0, pa1, pa2, pa3); SBAR();
    pv_d0(o, vb0 + SHM_V, pa0, pa1, pa2, pa3);
    if (hi == 0) li_l[r32] = l_reg; asm volatile("s_waitcnt lgkmcnt(0)" ::: "memory");
#pragma unroll
    for (int r = 0; r < 16; ++r) { const float rl = __builtin_amdgcn_rcpf(li_l[crow(r, hi)]);
#pragma unroll
        for (int d = 0; d < 4; ++d) o[d][r] *= rl; }
    __syncthreads();
#undef KROW
#undef SLOAD
#undef SWRITE
#undef RESC
#undef QKT
}

__device__ __forceinline__ void phase_attn_mla(const Params& p, char* lds) {
    const bf16_t* T1 = (const bf16_t*)(p.ws + WS_T1); bf16_t* O = (bf16_t*)(p.ws + WS_H);
    const int tid = tid_opaque(), wid = tid >> 6, lane = tid & 63, r32 = lane & 31, hi = lane >> 5;
    const float scale = 0.07216878364870322f;
    for (int it = blockIdx.x; it < 1024 + 128; it += gridDim.x) {
        int b, h, row0; AttnArgs a;
        if (it < 1024) {
            int itm = it;
            if (gridDim.x == 256) { const int w = it & 255, rnd = it >> 8, xcd = w & 7, slot = w >> 3; itm = ((rnd * 32 + xcd * 4 + (slot >> 3)) << 3) | (slot & 7); }
            b = itm >> 6; h = (itm >> 3) & 7; const int qb = itm & 7; row0 = b * SEQ + qb * 256; a.nlat = 32; a.NT = 36; }
        else { const int i2 = it - 1024; b = i2 >> 3; h = i2 & 7; row0 = MLAT + b * CTXL; a.nlat = 0; a.NT = 4; }
        a.lat0 = b * SEQ; a.ctx0 = MLAT + b * CTXL;
        a.Q = T1 + T_Q + (size_t)row0 * 1536 + h * 192; a.ldq = 1536;
        a.Kn = T1 + T_KV + h * 256; a.ldk = 2048; a.Kr = T1 + T_KR; a.ldkr = 64;
        a.V = T1 + T_KV + h * 256 + 128; a.ldv = 2048;
        a.C = scale * 1.4426950408889634f; a.thr = 8.f / scale;
        f32x16 o[4];
        attn_core<192, 128, 1536, 2048, 64, 2048, MLA_NQL, 1>(a, lds, o);
        bf16_t* Ow = O + (size_t)(row0 + wid * 32 + 4 * hi) * 1024 + h * 128 + r32;
        asm volatile("" : "+v"(Ow));
#pragma unroll
        for (int r = 0; r < 16; ++r) { bf16_t* Or = Ow + (size_t)((r & 3) + 8 * (r >> 2)) * 1024;
#pragma unroll
            for (int d0 = 0; d0 < 4; ++d0) Or[d0 * 32] = (bf16_t)(cvt_pk_bf16(o[d0][r], 0.f) & 0xffffu); }
    }
}

__device__ __forceinline__ void phase_attn_diff(const Params& p, char* lds) {
    const bf16_t* T1 = (const bf16_t*)(p.ws + WS_T1); bf16_t* O = (bf16_t*)(p.ws + WS_H);
    const int tid = tid_opaque(), wid = tid >> 6, lane = tid & 63, r32 = lane & 31, hi = lane >> 5;
    float* scr0 = (float*)(p.ws + WS_SCR) + ((size_t)blockIdx.x * 512 + tid) * 64;
    const float scale = 0.125f;
    const float lam_init = 0.8f - 0.6f * 0.40656965974059917f;
    float lam;
    { const float* lv = p.diff_lambda; float s1 = 0.f, s2 = 0.f;
      for (int k = 0; k < 64; ++k) { s1 += lv[k] * lv[64 + k]; s2 += lv[128 + k] * lv[192 + k]; }
      lam = expf(s1) - expf(s2) + lam_init; }
    float gs[4];
#pragma unroll
    for (int d0 = 0; d0 < 4; ++d0) gs[d0] = p.diff_g_subln[d0 * 32 + r32] * (1.0f - lam_init);
    for (int it = blockIdx.x; it < 1024; it += gridDim.x) {
        int itm = it;
        if (gridDim.x == 256) { const int w = it & 255, rnd = it >> 8, xcd = w & 7, slot = w >> 3; itm = ((rnd * 32 + xcd * 4 + (slot >> 3)) << 3) | (slot & 7); }
        const int b = itm >> 6, h = (itm >> 3) & 7, qb = itm & 7, row0 = b * SEQ + qb * 256;
#pragma unroll 1
        for (int j = 0; j < 2; ++j) {
            AttnArgs a; a.nlat = 32; a.NT = 36; a.lat0 = b * SEQ; a.ctx0 = MLAT + b * CTXL;
            a.Q = T1 + (size_t)row0 * 3072 + h * 128 + j * 64; a.ldq = 3072;
            a.Kn = T1 + 1024 + h * 128 + j * 64; a.ldk = 3072; a.Kr = a.Kn; a.ldkr = 3072;
            a.V = T1 + 2048 + h * 128; a.ldv = 3072;
            a.C = scale * 1.4426950408889634f; a.thr = 8.f / scale;
            f32x16 o[4];
            attn_core<64, 64, 3072, 3072, 3072, 3072, 0, 2>(a, lds, o);
            float* scr = scr0; asm volatile("" : "+v"(scr));
            if (j == 0) {
#pragma unroll
                for (int r = 0; r < 16; ++r) { f32x4 t = {o[0][r], o[1][r], o[2][r], o[3][r]}; *(f32x4*)(scr + 4 * r) = t; }
            } else {
                bf16_t* Ow = O + (size_t)(row0 + wid * 32 + 4 * hi) * 1024 + h * 128 + r32;
                asm volatile("" : "+v"(Ow));
#pragma unroll
                for (int r = 0; r < 16; ++r) {
                    const f32x4 t = *(const f32x4*)(scr + 4 * r);
                    const float v0 = t[0] - lam * o[0][r], v1 = t[1] - lam * o[1][r], v2 = t[2] - lam * o[2][r], v3 = t[3] - lam * o[3][r];
                    float ss = v0 * v0 + v1 * v1 + v2 * v2 + v3 * v3;
#pragma unroll
                    for (int x = 16; x >= 1; x >>= 1) ss += __shfl_xor(ss, x);
                    const float rs = rsqrtf(ss * (1.0f / 128.0f) + EPS);
                    bf16_t* Or = Ow + (size_t)((r & 3) + 8 * (r >> 2)) * 1024;
                    Or[0] = (bf16_t)(cvt_pk_bf16(v0 * rs * gs[0], 0.f) & 0xffffu); Or[32] = (bf16_t)(cvt_pk_bf16(v1 * rs * gs[1], 0.f) & 0xffffu);
                    Or[64] = (bf16_t)(cvt_pk_bf16(v2 * rs * gs[2], 0.f) & 0xffffu); Or[96] = (bf16_t)(cvt_pk_bf16(v3 * rs * gs[3], 0.f) & 0xffffu);
                }
            }
        }
    }
}

__device__ __forceinline__ const float* xin_row(const Params& p, int row, bool from_input) {
    if (from_input) return row < MLAT ? p.x + (size_t)row * DM : p.ctx + (size_t)(row - MLAT) * DM;
    return row < MLAT ? p.out + (size_t)row * DM : (const float*)(p.ws + WS_XC) + (size_t)(row - MLAT) * DM;
}
__device__ __forceinline__ float* xout_row(const Params& p, int row) {
    return row < MLAT ? p.out + (size_t)row * DM : (float*)(p.ws + WS_XC) + (size_t)(row - MLAT) * DM;
}

__device__ __forceinline__ void phase_rn(const Params& p, int layer, int stage, const bf16_t* Y, int nrows, int npart) {
    const int tid = tid_opaque(), wid = tid >> 6, lane = tid & 63;
    const float* MOD = (const float*)(p.ws + WS_MOD); bf16_t* H = (bf16_t*)(p.ws + WS_H);
    const int gate_c = stage == 0 ? 2 : 5;
    const float* gA = p.norm_g + (layer * 4 + (stage == 0 ? 1 : 3)) * DM;
    const bool has_next = !(layer == 3 && stage == 1);
    const int nl = stage == 0 ? layer : layer + 1;
    const float* gB = p.norm_g + ((has_next ? nl : 0) * 4 + (stage == 0 ? 2 : 0)) * DM;
    const int sh_c = stage == 0 ? 3 : 0, sc_c = stage == 0 ? 4 : 1;
    const bool from_input = (layer == 0 && stage == 0);
    for (int row = (blockIdx.x * 8 + wid) * 2; row < nrows; row += gridDim.x * 16) {
        const int mr = modrow(row);
        const float* xi = xin_row(p, row, from_input); float* xo = xout_row(p, row);
        const bool lat = row < MLAT, xin_bf = lat && !from_input, xout_bf = lat && has_next;
        bf16_t* xb = (bf16_t*)p.out + (size_t)(lat ? row : 0) * 2048;
        const bf16_t* y = Y + (size_t)row * DM;
        const float* mg = MOD + ((size_t)layer * 17 + mr) * 6144 + gate_c * DM;
        u32x2 yw[2][4]; f32x4 xx[2][4], gg[4], gt[4];
#pragma unroll
        for (int q = 0; q < 2; ++q)
#pragma unroll
            for (int i = 0; i < 4; ++i) { yw[q][i] = *(const u32x2*)(y + q * DM + i * 256 + lane * 4); if (xin_bf) { float t4[4]; load_bf4(xb + q * 2048 + i * 256 + lane * 4, t4); xx[q][i] = (f32x4){t4[0], t4[1], t4[2], t4[3]}; } else xx[q][i] = *(const f32x4*)(xi + q * DM + i * 256 + lane * 4); }
#pragma unroll
        for (int i = 0; i < 4; ++i) { gg[i] = *(const f32x4*)(gA + i * 256 + lane * 4); gt[i] = *(const f32x4*)(mg + i * 256 + lane * 4); }
        float yv[2][16]; float ss[2] = {0.f, 0.f};
#pragma unroll
        for (int q = 0; q < 2; ++q)
#pragma unroll
            for (int i = 0; i < 4; ++i) { yv[q][4 * i] = bf_lo(yw[q][i].x); yv[q][4 * i + 1] = bf_hi(yw[q][i].x); yv[q][4 * i + 2] = bf_lo(yw[q][i].y); yv[q][4 * i + 3] = bf_hi(yw[q][i].y); }
        if (npart > 1 && row >= MLAT) {
            const bf16_t* yp = (const bf16_t*)(p.ws + WS_SCR) + (size_t)(row - MLAT) * DM;
#pragma unroll
            for (int q = 0; q < 2; ++q)
#pragma unroll
                for (int i = 0; i < 4; ++i) { float a4[4] = {0.f, 0.f, 0.f, 0.f};
                    for (int k = 0; k < npart; ++k) { float t4[4]; load_bf4(yp + (size_t)k * MCTX * DM + q * DM + i * 256 + lane * 4, t4); a4[0] += t4[0]; a4[1] += t4[1]; a4[2] += t4[2]; a4[3] += t4[3]; }
                    yv[q][4 * i] = a4[0]; yv[q][4 * i + 1] = a4[1]; yv[q][4 * i + 2] = a4[2]; yv[q][4 * i + 3] = a4[3]; }
        }
#pragma unroll
        for (int q = 0; q < 2; ++q)
#pragma unroll
            for (int i = 0; i < 16; ++i) ss[q] += yv[q][i] * yv[q][i];
#pragma unroll
        for (int o = 32; o >= 1; o >>= 1) { ss[0] += __shfl_xor(ss[0], o); ss[1] += __shfl_xor(ss[1], o); }
        float ss2[2] = {0.f, 0.f};
#pragma unroll
        for (int q = 0; q < 2; ++q) { const float r1 = rsqrtf(ss[q] * (1.0f / DM) + EPS);
#pragma unroll
            for (int i = 0; i < 4; ++i) { f32x4 xn;
#pragma unroll
                for (int j = 0; j < 4; ++j) { xn[j] = xx[q][i][j] + gt[i][j] * (yv[q][4 * i + j] * r1 * gg[i][j]); ss2[q] += xn[j] * xn[j]; }
                xx[q][i] = xn; if (xout_bf) store_bf4(xb + q * 2048 + i * 256 + lane * 4, xn[0], xn[1], xn[2], xn[3]); else *(f32x4*)(xo + q * DM + i * 256 + lane * 4) = xn; } }
        if (has_next) {
            const float* msh = MOD + ((size_t)nl * 17 + mr) * 6144 + sh_c * DM; const float* msc = MOD + ((size_t)nl * 17 + mr) * 6144 + sc_c * DM;
            f32x4 gb[4], sh[4], sc[4];
#pragma unroll
            for (int i = 0; i < 4; ++i) { gb[i] = *(const f32x4*)(gB + i * 256 + lane * 4); sh[i] = *(const f32x4*)(msh + i * 256 + lane * 4); sc[i] = *(const f32x4*)(msc + i * 256 + lane * 4); }
#pragma unroll
            for (int o = 32; o >= 1; o >>= 1) { ss2[0] += __shfl_xor(ss2[0], o); ss2[1] += __shfl_xor(ss2[1], o); }
#pragma unroll
            for (int q = 0; q < 2; ++q) { const float r2 = rsqrtf(ss2[q] * (1.0f / DM) + EPS);
#pragma unroll
                for (int i = 0; i < 4; ++i) { float hv[4];
#pragma unroll
                    for (int j = 0; j < 4; ++j) hv[j] = (xx[q][i][j] * r2 * gb[i][j]) * (1.0f + sc[i][j]) + sh[i][j];
                    store_bf4(H + (size_t)(row + q) * DM + i * 256 + lane * 4, hv[0], hv[1], hv[2], hv[3]); } }
        }
    }
}

template <int I> __device__ __forceinline__ void poold_group(const float* xb, const float* RSs, int t0, int len, int lane, const float* g0, const float* msc, bf16_t* Hrow0) {
    constexpr int W = 2 << I, LO = W / 2, HI = W - 1 - LO, NR = 8 + W - 1;
    const int col = I * 256 + lane * 4;
    f32x4 xs[NR];
#pragma unroll
    for (int k = 0; k < NR; ++k) { const int tt = t0 - LO + k; const bool ok = (tt >= 0 && tt < len); const int tc = ok ? tt : t0;
        const f32x4 xx = *(const f32x4*)(xb + (size_t)tc * DM + col); const float rs = ok ? RSs[tc] : 0.f; xs[k] = xx * rs; }
    const f32x4 gg = *(const f32x4*)(g0 + col), sc = *(const f32x4*)(msc + col);
    f32x4 gm;
#pragma unroll
    for (int j = 0; j < 4; ++j) gm[j] = gg[j] * (1.0f + sc[j]);
    f32x4 S = xs[0];
#pragma unroll
    for (int k = 1; k < W; ++k) S += xs[k];
#pragma unroll
    for (int r = 0; r < 8; ++r) {
        const int t = t0 + r; const int ta = max(t - LO, 0), tb = min(t + HI + 1, len); const float inv = 1.0f / (float)(tb - ta);
        const f32x4 d = (S * inv - xs[r + LO]) * gm;
        store_bf4(Hrow0 + (size_t)r * DM + col, d[0], d[1], d[2], d[3]);
        if (r < 7) S += xs[r + W] - xs[r];
    }
}
__device__ __forceinline__ void phase_poold(const Params& p) {
    const int tid = tid_opaque(), wid = tid >> 6, lane = tid & 63;
    const float* MOD = (const float*)(p.ws + WS_MOD); const float* RS = (const float*)(p.ws + WS_RS); bf16_t* H = (bf16_t*)(p.ws + WS_H);
    const float* g0 = p.norm_g;
    for (int row = (blockIdx.x * 8 + wid) * 8; row < MALL; row += gridDim.x * 64) {
        const int mr = modrow(row);
        const int s0 = row < MLAT ? (row & ~(SEQ - 1)) : MLAT + ((row - MLAT) & ~(CTXL - 1)); const int len = row < MLAT ? SEQ : CTXL; const int t0 = row - s0;
        const float* xb = row < MLAT ? p.x + (size_t)s0 * DM : p.ctx + (size_t)(s0 - MLAT) * DM;
        const float* msc = MOD + ((size_t)0 * 17 + mr) * 6144 + 1 * DM;
        bf16_t* Hr = H + (size_t)row * DM;
        poold_group<0>(xb, RS + s0, t0, len, lane, g0, msc, Hr);
        poold_group<1>(xb, RS + s0, t0, len, lane, g0, msc, Hr);
        poold_group<2>(xb, RS + s0, t0, len, lane, g0, msc, Hr);
        poold_group<3>(xb, RS + s0, t0, len, lane, g0, msc, Hr);
    }
}

__device__ __forceinline__ void phase_conv(const Params& p) {
    const int tid = tid_opaque(), wid = tid >> 6, lane = tid & 63;
    const bf16_t* T1 = (const bf16_t*)(p.ws + WS_T1); bf16_t* H = (bf16_t*)(p.ws + WS_H);
    for (int row = (blockIdx.x * 8 + wid) * 8; row < MALL; row += gridDim.x * 64) {
        const int s0 = row < MLAT ? (row & ~(SEQ - 1)) : MLAT + ((row - MLAT) & ~(CTXL - 1)); const int len = row < MLAT ? SEQ : CTXL; const int t0 = row - s0;
#pragma unroll 1
        for (int i = 0; i < 4; ++i) {
            const int col = i * 256 + lane * 4;
            u32x2 cw[10], vw[10], bw[8];
#pragma unroll
            for (int k = 0; k < 10; ++k) { const int tt = t0 - 1 + k; const bool ok = (tt >= 0 && tt < len); const int tc = ok ? tt : t0;
                const bf16_t* rp = T1 + (size_t)(s0 + tc) * 3072; cw[k] = *(const u32x2*)(rp + 1024 + col); vw[k] = *(const u32x2*)(rp + 2048 + col);
                if (!ok) { cw[k].x = 0u; cw[k].y = 0u; } }
#pragma unroll
            for (int r = 0; r < 8; ++r) bw[r] = *(const u32x2*)(T1 + (size_t)(row + r) * 3072 + col);
            const f32x4 w0 = *(const f32x4*)(p.conv_w + col), w1 = *(const f32x4*)(p.conv_w + DM + col), w2 = *(const f32x4*)(p.conv_w + 2 * DM + col);
            f32x4 u[10];
#pragma unroll
            for (int k = 0; k < 10; ++k) { u[k][0] = bf_lo(cw[k].x) * bf_lo(vw[k].x); u[k][1] = bf_hi(cw[k].x) * bf_hi(vw[k].x); u[k][2] = bf_lo(cw[k].y) * bf_lo(vw[k].y); u[k][3] = bf_hi(cw[k].y) * bf_hi(vw[k].y); }
#pragma unroll
            for (int r = 0; r < 8; ++r) { const f32x4 z = u[r] * w0 + u[r + 1] * w1 + u[r + 2] * w2;
                store_bf4(H + (size_t)(row + r) * DM + col, bf_lo(bw[r].x) * z[0], bf_hi(bw[r].x) * z[1], bf_lo(bw[r].y) * z[2], bf_hi(bw[r].y) * z[3]); }
        }
    }
}

__device__ __forceinline__ void phase_mlaprep(const Params& p) {
    const int tid = tid_opaque(), wid = tid >> 6, lane = tid & 63;
    bf16_t* T1 = (bf16_t*)(p.ws + WS_T1); bf16_t* CKV = (bf16_t*)(p.ws + WS_H); const float* rope = (const float*)(p.ws + WS_ROPE);
    for (int row = blockIdx.x * 8 + wid; row < MALL; row += gridDim.x * 8) {
        const bf16_t* ar = T1 + T_AB + (size_t)row * 768;
        float v[12]; float sq = 0.f, skv = 0.f;
#pragma unroll
        for (int i = 0; i < 3; ++i) { const int col = i * 256 + lane * 4; load_bf4(ar + col, v + 4 * i);
            const float s = v[4 * i] * v[4 * i] + v[4 * i + 1] * v[4 * i + 1] + v[4 * i + 2] * v[4 * i + 2] + v[4 * i + 3] * v[4 * i + 3];
            if (col < 384) sq += s; else if (col < 640) skv += s; }
        sq = wave_sum(sq); skv = wave_sum(skv);
        const float rq = rsqrtf(sq * (1.0f / 384.0f) + EPS), rkv = rsqrtf(skv * (1.0f / 256.0f) + EPS);
#pragma unroll
        for (int i = 0; i < 3; ++i) { const int col = i * 256 + lane * 4;
            if (col < 384) { const f32x4 g = *(const f32x4*)(p.mla_g_q + col);
                store_bf4(T1 + T_CQ + (size_t)row * 384 + col, v[4 * i] * rq * g[0], v[4 * i + 1] * rq * g[1], v[4 * i + 2] * rq * g[2], v[4 * i + 3] * rq * g[3]); }
            else if (col < 640) { const int c2 = col - 384; const f32x4 g = *(const f32x4*)(p.mla_g_kv + c2);
                store_bf4(CKV + (size_t)row * 256 + c2, v[4 * i] * rkv * g[0], v[4 * i + 1] * rkv * g[1], v[4 * i + 2] * rkv * g[2], v[4 * i + 3] * rkv * g[3]); }
        }
        {
            float pv[4];
#pragma unroll
            for (int j = 0; j < 4; ++j) pv[j] = __shfl_xor(v[8 + j], 4);
            if (lane >= 32 && lane < 48) {
                const int k = lane - 32; float ov[4];
                if (row < MLAT) {
                    const int t = row & (SEQ - 1); const int pos = (k < 8) ? (t >> 6) : (t & 63);
                    const f32x4 t0 = *(const f32x4*)(rope + (pos * 16 + 4 * (k & 3)) * 2), t1 = *(const f32x4*)(rope + (pos * 16 + 4 * (k & 3)) * 2 + 4);
                    const float cs[4] = {t0[0], t0[2], t1[0], t1[2]}, sn[4] = {t0[1], t0[3], t1[1], t1[3]};
#pragma unroll
                    for (int j = 0; j < 4; ++j) ov[j] = (k & 4) ? (v[8 + j] * cs[j] + pv[j] * sn[j]) : (v[8 + j] * cs[j] - pv[j] * sn[j]);
                } else {
#pragma unroll
                    for (int j = 0; j < 4; ++j) ov[j] = v[8 + j];
                }
                store_bf4(T1 + T_KR + (size_t)row * 64 + 4 * k, ov[0], ov[1], ov[2], ov[3]);
            }
        }
    }
}

__device__ __forceinline__ void conv_wt(const float* src, int K, int N, int Npad, bf16_t* dst, float* tile, int rot) {
    const int tid = tid_opaque(), G = gridDim.x;
    const int ntn = Npad / 64, ntk = K / 64, ntiles = ntn * ntk;
    for (int u = (blockIdx.x + G - (rot % G)) % G; u < ntiles; u += G) {
        const int kt = u / ntn, nt_ = u % ntn, k0 = kt * 64, n0 = nt_ * 64;
        const int r = tid >> 4, c4 = (tid & 15) * 4;
#pragma unroll
        for (int pss = 0; pss < 2; ++pss) { const int rr = r + pss * 32; f32x4 v = {0.f, 0.f, 0.f, 0.f};
            if (n0 + c4 < N) v = *(const f32x4*)(src + (size_t)(k0 + rr) * N + n0 + c4);
            tile[rr * 65 + c4 + 0] = v[0]; tile[rr * 65 + c4 + 1] = v[1]; tile[rr * 65 + c4 + 2] = v[2]; tile[rr * 65 + c4 + 3] = v[3]; }
        __syncthreads();
        { const int n = tid >> 3, k8 = (tid & 7) * 8; float t[8];
#pragma unroll
          for (int j = 0; j < 8; ++j) t[j] = tile[(k8 + j) * 65 + n];
          u32x4 w; w.x = cvt_pk_bf16(t[0], t[1]); w.y = cvt_pk_bf16(t[2], t[3]); w.z = cvt_pk_bf16(t[4], t[5]); w.w = cvt_pk_bf16(t[6], t[7]);
          *(u32x4*)(dst + (size_t)(n0 + n) * K + k0 + k8) = w; }
        __syncthreads();
    }
}

__device__ __forceinline__ void phase_prep(const Params& p, char* lds) {
    const int tid = tid_opaque(), wid = tid >> 6, lane = tid & 63, G = gridDim.x;
    float* fl = (float*)lds;
    if (blockIdx.x < 96) {
        { f32x4 cvv[9];
#pragma unroll
          for (int q = 0; q < 9; ++q) { const int idx = tid + q * NTHREADS; const int r = idx >> 8, k4 = (idx & 255) * 4; cvv[q] = (idx < 17 * 256) ? *(const f32x4*)(r < 16 ? p.c + r * 1024 + k4 : p.c_ctx + k4) : (f32x4){0.f, 0.f, 0.f, 0.f}; }
#pragma unroll
          for (int q = 0; q < 9; ++q) { const int idx = tid + q * NTHREADS; const int r = idx >> 8, k4 = (idx & 255) * 4;
              if (idx < 17 * 256) {
#pragma unroll
                  for (int j = 0; j < 4; ++j) fl[(k4 + j) * 17 + r] = cvv[q][j] / (1.0f + expf(-cvv[q][j])); } } }
        __syncthreads();
        float* MOD = (float*)(p.ws + WS_MOD);
        for (int u = blockIdx.x; u < 96; u += G) {
            const int layer = u / 24, cb = u % 24, col0 = cb * 256 + wid * 32 + (lane & 7) * 4, kq = lane >> 3;
            float acc[17][4];
#pragma unroll
            for (int r = 0; r < 17; ++r)
#pragma unroll
                for (int j = 0; j < 4; ++j) acc[r][j] = 0.f;
            const float* W = p.ada_w + (size_t)layer * 1024 * 6144 + col0;
#pragma unroll 8
            for (int itk = 0; itk < 128; ++itk) { const int k = kq + 8 * itk; const f32x4 w = *(const f32x4*)(W + (size_t)k * 6144);
#pragma unroll
                for (int r = 0; r < 17; ++r) { const float s = fl[k * 17 + r];
#pragma unroll
                    for (int j = 0; j < 4; ++j) acc[r][j] += s * w[j]; } }
#pragma unroll
            for (int r = 0; r < 17; ++r)
#pragma unroll
                for (int j = 0; j < 4; ++j) { float v = acc[r][j]; v += __shfl_xor(v, 8); v += __shfl_xor(v, 16); v += __shfl_xor(v, 32); acc[r][j] = v; }
            if (kq == 0) { const f32x4 bb = *(const f32x4*)(p.ada_b + layer * 6144 + col0);
#pragma unroll
                for (int r = 0; r < 17; ++r) { f32x4 o = {acc[r][0] + bb[0], acc[r][1] + bb[1], acc[r][2] + bb[2], acc[r][3] + bb[3]}; *(f32x4*)(MOD + ((size_t)layer * 17 + r) * 6144 + col0) = o; } }
        }
        __syncthreads();
    }
    if (blockIdx.x == G - 1) {
        float* rt = (float*)(p.ws + WS_ROPE);
        for (int idx = tid; idx < 1024; idx += NTHREADS) { const int pos = idx >> 4, f = idx & 15; const float inv = powf(10000.0f, -(float)f / 16.0f); const float ang = (float)pos * inv;
            rt[idx * 2] = cosf(ang); rt[idx * 2 + 1] = sinf(ang); }
    }
    { float* RS = (float*)(p.ws + WS_RS);
      for (int row = (blockIdx.x * 8 + wid) * 4; row < MALL; row += G * 32) { const float* xi = xin_row(p, row, true); f32x4 xx[4][4];
#pragma unroll
          for (int q = 0; q < 4; ++q)
#pragma unroll
              for (int i = 0; i < 4; ++i) xx[q][i] = *(const f32x4*)(xi + q * DM + i * 256 + lane * 4);
          float ss[4] = {0.f, 0.f, 0.f, 0.f};
#pragma unroll
          for (int q = 0; q < 4; ++q)
#pragma unroll
              for (int i = 0; i < 4; ++i) ss[q] += xx[q][i][0] * xx[q][i][0] + xx[q][i][1] * xx[q][i][1] + xx[q][i][2] * xx[q][i][2] + xx[q][i][3] * xx[q][i][3];
#pragma unroll
          for (int o = 32; o >= 1; o >>= 1) { ss[0] += __shfl_xor(ss[0], o); ss[1] += __shfl_xor(ss[1], o); ss[2] += __shfl_xor(ss[2], o); ss[3] += __shfl_xor(ss[3], o); }
          if (lane < 4) RS[row + lane] = rsqrtf((lane == 0 ? ss[0] : lane == 1 ? ss[1] : lane == 2 ? ss[2] : ss[3]) * (1.0f / DM) + EPS); } }
    bf16_t* W = (bf16_t*)(p.ws + WS_W);
    int rot = 96;
    for (int l = 0; l < 4; ++l) {
        conv_wt(p.ffn_w1 + (size_t)l * 1024 * 4096, 1024, 4096, 4096, W + W_FFN + (size_t)l * 8388608, fl, rot); rot += 1024;
        conv_wt(p.ffn_w2 + (size_t)l * 4096 * 1024, 4096, 1024, 1024, W + W_FFN + (size_t)l * 8388608 + 4194304, fl, rot); rot += 1024;
    }
    for (int g = 0; g < 4; ++g) { conv_wt(p.pool_w + (size_t)g * 65536, 256, 256, 256, W + W_POOL + (size_t)g * 65536, fl, rot); rot += 16; }
    conv_wt(p.conv_in_w, 1024, 3072, 3072, W + W_CIN, fl, rot); rot += 768;
    conv_wt(p.conv_out_w, 1024, 1024, 1024, W + W_COUT, fl, rot); rot += 256;
    conv_wt(p.mla_w_down, 1024, 704, 768, W + W_DOWN, fl, rot); rot += 192;
    conv_wt(p.mla_w_uq, 384, 1536, 1536, W + W_UQ, fl, rot); rot += 144;
    conv_wt(p.mla_w_ukv, 256, 2048, 2048, W + W_UKV, fl, rot); rot += 128;
    conv_wt(p.mla_w_o, 1024, 1024, 1024, W + W_MO, fl, rot); rot += 256;
    conv_wt(p.diff_w_qkv, 1024, 3072, 3072, W + W_DQKV, fl, rot); rot += 768;
    conv_wt(p.diff_w_o, 1024, 1024, 1024, W + W_DO, fl, rot);
}

__device__ __forceinline__ void grid_barrier(unsigned* cnt, unsigned target) {
    asm volatile("s_waitcnt vmcnt(0) lgkmcnt(0)" ::: "memory");
    __syncthreads();
    if (threadIdx.x < 64) {
        if (threadIdx.x == 0) {
            __builtin_amdgcn_fence(__ATOMIC_RELEASE, "agent");
            asm volatile("s_waitcnt vmcnt(0)" ::: "memory");
            __hip_atomic_fetch_add(cnt, 1u, __ATOMIC_RELAXED, __HIP_MEMORY_SCOPE_AGENT);
            while (__hip_atomic_load(cnt, __ATOMIC_RELAXED, __HIP_MEMORY_SCOPE_AGENT) < target) __builtin_amdgcn_s_sleep(1);
        }
        __builtin_amdgcn_fence(__ATOMIC_ACQUIRE, "agent");
        asm volatile("s_waitcnt vmcnt(0)" ::: "memory");
    }
    __syncthreads();
}

enum { T_PREP = 0, T_POOLD, T_GEMM, T_RN, T_CONV, T_MLAPREP, T_ATTN_MLA, T_ATTN_DIFF };
constexpr int N_PHASES = 31;

__global__ void __launch_bounds__(NTHREADS, 2) mk_fwd(Params p_arg) {
    extern __shared__ __attribute__((aligned(16))) unsigned char shm[];
    LAS unsigned char* ldsl = (LAS unsigned char*)shm; char* ldsg = (char*)shm;
    const int ph_lo = p_arg.ph_lo, ph_hi = p_arg.ph_hi; unsigned char* const wsb = p_arg.ws;
    bf16_t* H = (bf16_t*)(wsb + WS_H); bf16_t* T1 = (bf16_t*)(wsb + WS_T1); const bf16_t* W = (const bf16_t*)(wsb + WS_W);
    const float* rope = (const float*)(wsb + WS_ROPE);
    unsigned nbar = 0; unsigned* barcnt = (unsigned*)(wsb + WS_BAR);
    for (int ph = ph_lo; ph < ph_hi; ++ph) {
        const Params* pp = (const Params*)__builtin_amdgcn_kernarg_segment_ptr(); asm volatile("" : "+s"(pp));
        const Params& p = *pp;
        int type = T_GEMM, sync = 1, layer = 0, stage = 0, nrows = MALL, npart = 1; const bf16_t* Y = T1;
        GemmP g; g.A = H; g.Bt = W; g.lda = 1024; g.ldb = 1024; g.K = 1024; g.nM = 144; g.nN = 4; g.a_pn_off = 0; g.ksplit = 1; g.a_tiled = 0; g.rev = 0; g.magicN = 16384;
        EpiP e; e.O = T1; e.ldo = 1024; e.mode = 0; e.colscale = nullptr; e.rope = rope; e.Opart = (bf16_t*)(wsb + WS_SCR);
        switch (ph) {
        case 0: type = T_PREP; break;
        case 1: type = T_POOLD; break;
        case 2: g.Bt = W + W_POOL; g.ldb = 256; g.K = 256; g.a_pn_off = 256; e.colscale = p.pool_scale; break;
        case 3: type = T_RN; layer = 0; stage = 0; Y = T1; break;
        case 4: case 11: case 21: case 28: { const int l = ph == 4 ? 0 : ph == 11 ? 1 : ph == 21 ? 2 : 3;
            g.Bt = W + W_FFN + (size_t)l * 8388608; g.nN = 16; g.magicN = 4096; g.nM = l == 3 ? 128 : 144; e.ldo = 4096; e.mode = 1; } break;
        case 5: case 12: case 22: case 29: { const int l = ph == 5 ? 0 : ph == 12 ? 1 : ph == 22 ? 2 : 3;
            g.A = T1; g.lda = 4096; g.Bt = W + W_FFN + (size_t)l * 8388608 + 4194304; g.ldb = 4096; g.K = 4096; g.nM = l == 3 ? 128 : 144; g.ksplit = l == 3 ? 1 : 4; g.a_tiled = 1; e.O = H; } break;
        case 6: type = T_RN; layer = 0; stage = 1; Y = H; npart = 4; break;
        case 7: g.Bt = W + W_CIN; g.nN = 12; g.magicN = 5462; e.ldo = 3072; break;
        case 8: type = T_CONV; break;
        case 9: g.Bt = W + W_COUT; g.ksplit = 4; break;
        case 10: type = T_RN; layer = 1; stage = 0; Y = T1; npart = 4; break;
        case 13: type = T_RN; layer = 1; stage = 1; Y = H; npart = 4; break;
        case 14: g.Bt = W + W_DOWN; g.nN = 3; g.magicN = 21846; e.O = T1 + T_AB; e.ldo = 768; break;
        case 15: type = T_MLAPREP; break;
        case 16: g.A = T1 + T_CQ; g.lda = 384; g.Bt = W + W_UQ; g.ldb = 384; g.K = 384; g.nN = 6; g.magicN = 10923; e.O = T1 + T_Q; e.ldo = 1536; e.mode = 3; break;
        case 17: sync = 0; g.rev = 1; g.A = H; g.lda = 256; g.Bt = W + W_UKV; g.ldb = 256; g.K = 256; g.nN = 8; g.magicN = 8192; e.O = T1 + T_KV; e.ldo = 2048; break;
        case 18: type = T_ATTN_MLA; break;
        case 19: g.Bt = W + W_MO; g.ksplit = 4; break;
        case 20: type = T_RN; layer = 2; stage = 0; Y = T1; npart = 4; break;
        case 23: type = T_RN; layer = 2; stage = 1; Y = H; npart = 4; break;
        case 24: g.Bt = W + W_DQKV; g.nN = 12; g.magicN = 5462; e.ldo = 3072; e.mode = 2; break;
        case 25: type = T_ATTN_DIFF; break;
        case 26: g.Bt = W + W_DO; g.nM = 128; break;
        case 27: type = T_RN; layer = 3; stage = 0; Y = T1; nrows = MLAT; break;
        case 30: type = T_RN; layer = 3; stage = 1; Y = H; nrows = MLAT; break;
        default: break;
        }
        if (ph > ph_lo && sync) { if (ph_hi > N_PHASES) cg::this_grid().sync(); else { ++nbar; grid_barrier(barcnt, nbar * gridDim.x); } }
#ifdef REPEAT_MASK
        for (int rep_ = 0; rep_ < (((REPEAT_MASK) >> ph) & 1 ? 2 : 1); ++rep_) {
        if (rep_) cg::this_grid().sync();
#endif
        switch (type) {
#ifndef PH_MASK
#define PH_MASK 0xff
#endif
#if PH_MASK & 1
        case T_PREP: phase_prep(p, ldsg); break;
#endif
#if PH_MASK & 2
        case T_POOLD: phase_poold(p); break;
#endif
#if PH_MASK & 4
        case T_GEMM: gemm_phase(ldsl, g, e); break;
#endif
#if PH_MASK & 8
        case T_RN: phase_rn(p, layer, stage, Y, nrows, npart); break;
#endif
#if PH_MASK & 16
        case T_CONV: phase_conv(p); break;
#endif
#if PH_MASK & 32
        case T_MLAPREP: phase_mlaprep(p); break;
#endif
#if PH_MASK & 64
        case T_ATTN_MLA: phase_attn_mla(p, ldsg); break;
#endif
#if PH_MASK & 128
        case T_ATTN_DIFF: phase_attn_diff(p, ldsg); break;
#endif
        }
#ifdef REPEAT_MASK
        }
#endif
    }
}

extern "C" void kernel_launch(void* const* d_in, const int* in_sizes, int n_in, void* d_out, int out_size, void* d_ws, size_t ws_size, hipStream_t stream) {
    static int grid = 0;
    if (grid == 0) {
        if (n_in != 24 || out_size != MLAT * DM || ws_size < WS_END) { fprintf(stderr, "kernel_launch: unexpected shapes (n_in %d out %d ws %zu need %zu)\n", n_in, out_size, ws_size, (size_t)WS_END); grid = -1; return; }
        if (hipFuncSetAttribute((const void*)mk_fwd, hipFuncAttributeMaxDynamicSharedMemorySize, LDS_BYTES) != hipSuccess) { fprintf(stderr, "kernel_launch: hipFuncSetAttribute failed\n"); grid = -1; return; }
        int dev = 0, cus = 0, per_cu = 0;
        (void)hipGetDevice(&dev); (void)hipDeviceGetAttribute(&cus, hipDeviceAttributeMultiprocessorCount, dev);
        (void)hipOccupancyMaxActiveBlocksPerMultiprocessor(&per_cu, (const void*)mk_fwd, NTHREADS, LDS_BYTES);
        if (per_cu < 1) { fprintf(stderr, "kernel_launch: occupancy query says %d blocks per CU\n", per_cu); per_cu = 1; }
        (void)hipGetLastError();
        grid = cus * 1;
        if (grid > 256) grid = 256;
    }
    if (grid < 0) return;
    Params p{};
    const float** pp = (const float**)&p;
    for (int i = 0; i < 24; ++i) pp[i] = (const float*)d_in[i];
    p.out = (float*)d_out; p.ws = (unsigned char*)d_ws;
#if MK_ONE_LAUNCH
    (void)hipMemsetAsync((char*)d_ws + WS_BAR, 0, 256, stream);
    p.ph_lo = 0; p.ph_hi = N_PHASES;
    void* args[] = {&p};
    hipError_t e = hipLaunchCooperativeKernel((const void*)mk_fwd, dim3(grid), dim3(NTHREADS), args, LDS_BYTES, stream);
    if (e != hipSuccess) fprintf(stderr, "cooperative launch failed: %s (grid %d)\n", hipGetErrorString(e), grid);
#else
    for (int ph = 0; ph < N_PHASES; ++ph) {
        p.ph_lo = ph; p.ph_hi = ph + 1;
        hipLaunchKernelGGL(mk_fwd, dim3(grid), dim3(NTHREADS), LDS_BYTES, stream, p);
    }
#endif
}
```

```cpp
#include <hip/hip_runtime.h>
#include <hip/hip_cooperative_groups.h>
#include <cstdio>
#include <cstdint>
namespace cg = cooperative_groups;

#ifndef MK_ONE_LAUNCH
#define MK_ONE_LAUNCH 1
#endif

#define LAS __attribute__((address_space(3)))
typedef unsigned short bf16_t;
typedef short bf16x8 __attribute__((ext_vector_type(8)));
typedef short s16x4 __attribute__((ext_vector_type(4)));
typedef float f32x4 __attribute__((ext_vector_type(4)));
typedef float f32x16 __attribute__((ext_vector_type(16)));
typedef unsigned u32x4 __attribute__((ext_vector_type(4)));
typedef unsigned u32x2 __attribute__((ext_vector_type(2)));

constexpr int DM = 1024, NB = 16, SEQ = 2048, CTXL = 256, MLAT = NB * SEQ, MCTX = NB * CTXL, MALL = MLAT + MCTX;
constexpr float EPS = 1e-6f;
constexpr int NTHREADS = 512;
#ifndef MLA_NQL
#define MLA_NQL 4
#endif
constexpr int LDS_BYTES = (32768 + 49152 + 2048 + MLA_NQL * 8192) > 131072 ? (32768 + 49152 + 2048 + MLA_NQL * 8192) : 131072;

constexpr size_t WS_XC = 0;
constexpr size_t WS_H = WS_XC + (size_t)MCTX * DM * 4;
constexpr size_t WS_T1 = WS_H + (size_t)MALL * DM * 2;
constexpr size_t WS_W = WS_T1 + (size_t)MALL * 4096 * 2;
constexpr size_t W_ELTS = 45154304;
constexpr size_t WS_MOD = WS_W + W_ELTS * 2;
constexpr size_t WS_RS = WS_MOD + (size_t)4 * 17 * 6144 * 4;
constexpr size_t WS_ROPE = WS_RS + (size_t)MALL * 4;
constexpr size_t WS_SCR = WS_ROPE + 8192;
constexpr size_t WS_BAR = WS_SCR + (size_t)256 * 64 * 512 * 4;
constexpr size_t WS_END = WS_BAR + 256 + 8 * 256;
static_assert(WS_SCR % 256 == 0 && WS_MOD % 256 == 0 && WS_RS % 256 == 0 && WS_ROPE % 256 == 0, "align");
static_assert(WS_END <= 536870912ull, "workspace budget");
constexpr size_t W_FFN = 0;
constexpr size_t W_POOL = 33554432;
constexpr size_t W_CIN = W_POOL + 262144;
constexpr size_t W_COUT = W_CIN + 3145728;
constexpr size_t W_DOWN = W_COUT + 1048576;
constexpr size_t W_UQ = W_DOWN + 786432;
constexpr size_t W_UKV = W_UQ + 589824;
constexpr size_t W_MO = W_UKV + 524288;
constexpr size_t W_DQKV = W_MO + 1048576;
constexpr size_t W_DO = W_DQKV + 3145728;
static_assert(W_DO + 1048576 == W_ELTS, "weights");
constexpr size_t T_Q = 0;
constexpr size_t T_KV = T_Q + (size_t)MALL * 1536;
constexpr size_t T_CQ = T_KV + (size_t)MALL * 2048;
constexpr size_t T_KR = T_CQ + (size_t)MALL * 384;
constexpr size_t T_AB = T_KV;
static_assert(T_KR + (size_t)MALL * 64 <= (size_t)MALL * 4096, "arena");

struct Params {
    const float *x, *c, *ctx, *c_ctx, *ada_w, *ada_b, *norm_g, *ffn_w1, *ffn_w2, *pool_w, *pool_scale, *conv_in_w, *conv_w, *conv_out_w,
        *mla_w_down, *mla_g_q, *mla_g_kv, *mla_w_uq, *mla_w_ukv, *mla_w_o, *diff_w_qkv, *diff_lambda, *diff_g_subln, *diff_w_o;
    float* out; unsigned char* ws; int ph_lo, ph_hi;
};

__device__ __forceinline__ int vwg() { extern __shared__ __attribute__((aligned(16))) unsigned char shm_[]; return __builtin_amdgcn_readfirstlane(*(const LAS int*)((LAS unsigned char*)shm_ + LDS_BYTES)); }
__device__ __forceinline__ int tid_opaque() { int t = threadIdx.x; asm volatile("" : "+v"(t)); return t; }
__device__ __forceinline__ unsigned cvt_pk_bf16(float lo, float hi) { unsigned r; asm volatile("v_cvt_pk_bf16_f32 %0, %1, %2" : "=v"(r) : "v"(lo), "v"(hi)); return r; }
__device__ __forceinline__ float bf_lo(unsigned w) { return __uint_as_float(w << 16); }
__device__ __forceinline__ float bf_hi(unsigned w) { return __uint_as_float(w & 0xffff0000u); }
__device__ __forceinline__ float wave_sum(float v) {
#pragma unroll
    for (int o = 32; o >= 1; o >>= 1) v += __shfl_xor(v, o);
    return v;
}
__device__ __forceinline__ int modrow(int row) { return row < MLAT ? (row >> 11) : NB; }
__device__ __forceinline__ void load_bf4(const bf16_t* p, float* v) { const u32x2 w = *(const u32x2*)p; v[0] = bf_lo(w.x); v[1] = bf_hi(w.x); v[2] = bf_lo(w.y); v[3] = bf_hi(w.y); }
__device__ __forceinline__ void store_bf4(bf16_t* p, float a, float b, float c, float d) { u32x2 w; w.x = cvt_pk_bf16(a, b); w.y = cvt_pk_bf16(c, d); *(u32x2*)p = w; }

constexpr int BM = 256, BK = 64, HALF = 128, HTB = HALF * BK * 2;
__device__ __forceinline__ int lds_byte(int r, int c) { const int st = (r >> 4) * 2 + (c >> 5), rr = r & 15, cc = c & 31, ob = rr * 64 + cc * 2; return st * 1024 + (ob ^ (((ob >> 9) & 1) << 5)); }
__device__ __forceinline__ void stage_rc(int b, int& R, int& C) { const int st = b / 1024, sb = b % 1024, swz = sb ^ (((sb >> 9) & 1) << 5); R = (st >> 1) * 16 + swz / 64; C = (st & 1) * 32 + (swz % 64) / 2; }

struct Unit { int pm, pn, ks, nt; };
struct GemmP { const bf16_t* A; const bf16_t* Bt; int lda, ldb, K, nM, nN, a_pn_off, ksplit, a_tiled, rev, magicN; };
struct EpiP { bf16_t* O; int ldo; int mode; const float* colscale; const float* rope; bf16_t* Opart; };

__device__ __forceinline__ bool unit_next(const GemmP& g, int i, Unit& u) {
    const int nMf = g.ksplit > 1 ? 128 : g.nM;
    const int nwg = nMf * g.nN; const int vb = vwg(); const int L = i * (int)gridDim.x + (g.rev ? (int)gridDim.x - 1 - vb : vb);
    if (L >= nwg) {
        if (g.ksplit <= 1) return false;
        const int idx = L - nwg; if (idx >= (g.nM - nMf) * 16) return false;
        u.pm = nMf + (idx >> 4); const int r = idx & 15; u.pn = r >> 2; u.ks = r & 3; u.nt = g.K >> 8; return true;
    }
    int wgid = L; { const int q = nwg >> 3, xcd = wgid & 7, off = wgid >> 3; wgid = xcd * q + off; }
    const int w8 = wgid >> 3, gid = (w8 * g.magicN) >> 16, rem = wgid - gid * 8 * g.nN;
    u.pm = gid * 8 + (rem & 7); u.pn = rem >> 3; u.ks = -1; u.nt = g.K >> 6; return true;
}

__device__ __forceinline__ void epi_store(const f32x4 (&acc)[2][2][4][2], const Unit& u, int wr, int wc, int fr, int fq, const EpiP& e) {
    const int row0 = u.pm * BM + wr * 64 + fr;
    if (e.mode < 2) {
        const int col0 = u.pn * BM + wc * 32 + 8 * fq;
#pragma unroll
        for (int bj = 0; bj < 2; ++bj) {
            const int c = col0 + bj * HALF;
            f32x4 cs0 = {1.f, 1.f, 1.f, 1.f}, cs1 = {1.f, 1.f, 1.f, 1.f};
            if (e.mode == 0 && e.colscale) { cs0 = *(const f32x4*)(e.colscale + c); cs1 = *(const f32x4*)(e.colscale + c + 4); }
#pragma unroll
            for (int ai = 0; ai < 2; ++ai)
#pragma unroll
                for (int m = 0; m < 4; ++m) {
                    const int row = row0 + ai * HALF + m * 16;
                    f32x4 v0 = acc[ai][bj][m][0], v1 = acc[ai][bj][m][1];
                    if (e.mode == 1) {
#pragma unroll
                        for (int j = 0; j < 4; ++j) { const float a = fmaxf(v0[j], 0.f), b = fmaxf(v1[j], 0.f); v0[j] = a * a; v1[j] = b * b; }
                    } else { v0 *= cs0; v1 *= cs1; }
                    bf16_t* rowp = (u.ks < 0 ? e.O + (size_t)row * e.ldo : e.Opart + ((size_t)u.ks * MCTX + (row - MLAT)) * 1024) + c;
                    if (e.mode == 1)
                        rowp = (bf16_t*)((char*)e.O + ((size_t)(u.pm * 64 + u.pn * 4 + bj * 2 + (wc >> 1))) * 32768 + ai * 16384 + (((wr * 4 + m) * 2 + (wc & 1)) * 1024) + (fr * 4 + fq) * 16);
                    u32x4 w; w.x = cvt_pk_bf16(v0[0], v0[1]); w.y = cvt_pk_bf16(v0[2], v0[3]); w.z = cvt_pk_bf16(v1[0], v1[1]); w.w = cvt_pk_bf16(v1[2], v1[3]);
                    *(u32x4*)rowp = w;
                }
        }
        return;
    }
    const int col0 = u.pn * BM + wc * 32 + 4 * fq;
#pragma unroll
    for (int bj = 0; bj < 2; ++bj) {
        const int c = col0 + bj * HALF;
        int kind = 0;
        if (e.mode == 2) { if (c < 2048) kind = ((c >> 5) & 1) ? 2 : 1; }
        else { const int d = c % 192; if (d >= 128) kind = (d >= 160) ? 2 : 1; }
#pragma unroll
        for (int ai = 0; ai < 2; ++ai)
#pragma unroll
            for (int m = 0; m < 4; ++m) {
                const int row = row0 + ai * HALF + m * 16;
                f32x4 v0 = acc[ai][bj][m][0], v1 = acc[ai][bj][m][1];
                if (kind != 0 && row < MLAT) {
                    const int t = row & (SEQ - 1); const int pos = (kind == 1) ? (t >> 6) : (t & 63);
                    const f32x4 t0 = *(const f32x4*)(e.rope + (pos * 16 + 4 * fq) * 2), t1 = *(const f32x4*)(e.rope + (pos * 16 + 4 * fq) * 2 + 4);
                    const float cs[4] = {t0[0], t0[2], t1[0], t1[2]}, sn[4] = {t0[1], t0[3], t1[1], t1[3]};
#pragma unroll
                    for (int j = 0; j < 4; ++j) { const float x1 = v0[j], x2 = v1[j]; v0[j] = x1 * cs[j] - x2 * sn[j]; v1[j] = x2 * cs[j] + x1 * sn[j]; }
                }
                bf16_t* rowp = e.O + (size_t)row * e.ldo + c;
                u32x2 w0, w1; w0.x = cvt_pk_bf16(v0[0], v0[1]); w0.y = cvt_pk_bf16(v0[2], v0[3]); w1.x = cvt_pk_bf16(v1[0], v1[1]); w1.y = cvt_pk_bf16(v1[2], v1[3]);
                const bool odd = (fq & 1) != 0;
                const unsigned sx = odd ? w0.x : w1.x, sy = odd ? w0.y : w1.y;
                const unsigned rx = (unsigned)__shfl_xor((int)sx, 16), ry = (unsigned)__shfl_xor((int)sy, 16);
                u32x4 w; if (odd) { w.x = rx; w.y = ry; w.z = w1.x; w.w = w1.y; } else { w.x = w0.x; w.y = w0.y; w.z = rx; w.w = ry; }
                *(u32x4*)(rowp + (odd ? 12 : 0)) = w;
            }
    }
}

__device__ __forceinline__ void gemm_phase(LAS unsigned char* lds, const GemmP g, const EpiP e) {
    const int tid = tid_opaque(), wid = __builtin_amdgcn_readfirstlane(tid >> 6), lane = tid & 63, wr = wid >> 2, wc = wid & 3, fr = lane & 15, fq = lane >> 4;
    unsigned voffA[2], voffB[2];
#pragma unroll
    for (int i = 0; i < 2; ++i) { int R, C; stage_rc(tid * 16 + i * 8192, R, C); const int rho = R & 31; const int Rb = (e.mode < 2) ? ((R & ~31) + 8 * ((rho & 15) >> 2) + 4 * (rho >> 4) + (rho & 3)) : R;
        voffA[i] = g.a_tiled ? (unsigned)((((R >> 4) * 2 + (C >> 5)) * 1024) + ((R & 15) * 4 + ((C >> 3) & 3)) * 16) : (unsigned)(R * g.lda + C) * 2u; voffB[i] = (unsigned)(Rb * g.ldb + C) * 2u; }
    const size_t kstepB = (size_t)(BK * 2), kstepA = g.a_tiled ? (size_t)32768 : (size_t)(BK * 2);
    const size_t hstepA = g.a_tiled ? (size_t)16384 : (size_t)HALF * g.lda * 2, hstepB = (size_t)HALF * g.ldb * 2;
    const size_t tstepA = g.a_tiled ? (size_t)(g.K / BK) * 32768 : 2 * hstepA, tstepB = 2 * hstepB;
    const unsigned ldsw = (unsigned)wid * 1024u;
    const int aoff = lds_byte(wr * 64 + fr, fq * 8), boff = lds_byte(wc * 32 + fr, fq * 8);
#define PG8_SA(b, h) (((b) * 2 + (h)) * HTB)
#define PG8_SB(b, h) ((4 + (b) * 2 + (h)) * HTB)
#define PG8_STAGE(bufoff, gbase, voff) do { _Pragma("unroll") for (int _i = 0; _i < 2; ++_i) \
        __builtin_amdgcn_global_load_lds((const unsigned*)((const char*)(gbase) + (voff)[_i]), (LAS unsigned*)(lds + (bufoff) + ldsw + _i * 8192), 16, 0, 0); } while (0)
#define PG8_LDA(dst, b, h) do { _Pragma("unroll") for (int m = 0; m < 4; ++m) _Pragma("unroll") for (int k = 0; k < 2; ++k) dst[m][k] = *(const LAS bf16x8*)(lds + PG8_SA(b, h) + aoff + m * 2048 + k * 1024); } while (0)
#define PG8_LDB(dst, b, h) do { _Pragma("unroll") for (int n = 0; n < 2; ++n) _Pragma("unroll") for (int k = 0; k < 2; ++k) dst[n][k] = *(const LAS bf16x8*)(lds + PG8_SB(b, h) + boff + n * 2048 + k * 1024); } while (0)
#define PG8_MMA(ai, bj, At, Bt) do { __builtin_amdgcn_s_setprio(1); _Pragma("unroll") for (int m = 0; m < 4; ++m) _Pragma("unroll") for (int n = 0; n < 2; ++n) _Pragma("unroll") for (int k = 0; k < 2; ++k) \
        acc[ai][bj][m][n] = __builtin_amdgcn_mfma_f32_16x16x32_bf16(Bt[n][k], At[m][k], acc[ai][bj][m][n], 0, 0, 0); __builtin_amdgcn_s_setprio(0); } while (0)
#define PG8_WAIT_V(n) asm volatile("s_waitcnt vmcnt(" #n ")" ::: "memory")
#define PG8_WAIT_L(n) asm volatile("s_waitcnt lgkmcnt(" #n ")" ::: "memory")
#define PG8_BAR __builtin_amdgcn_s_barrier()
#define PG8_SCHED __builtin_amdgcn_sched_barrier(0)
    Unit cur, nxt; int ui = 0;
    if (!unit_next(g, 0, cur)) return;
    f32x4 acc[2][2][4][2];
#pragma unroll
    for (int a = 0; a < 2; ++a)
#pragma unroll
        for (int b = 0; b < 2; ++b)
#pragma unroll
            for (int m = 0; m < 4; ++m)
#pragma unroll
                for (int n = 0; n < 2; ++n) acc[a][b][m][n] = (f32x4){0.f, 0.f, 0.f, 0.f};
    bf16x8 At[4][2], B0[2][2], B1[2][2];
    const size_t ksliceB = (size_t)(g.ksplit > 1 ? g.K / g.ksplit : 0) * 2;
    const size_t ksliceA = g.a_tiled ? (size_t)(g.ksplit > 1 ? g.K / g.ksplit / BK : 0) * 32768 : ksliceB;
#define UNIT_A(u_) ((const char*)g.A + (size_t)(u_).pm * tstepA + (size_t)(u_).pn * g.a_pn_off * 2 + ((u_).ks > 0 ? (u_).ks * ksliceA : 0))
#define UNIT_B(u_) ((const char*)g.Bt + (size_t)(u_).pn * tstepB + ((u_).ks > 0 ? (u_).ks * ksliceB : 0))
    const char* cA = UNIT_A(cur); const char* cB = UNIT_B(cur);
    PG8_STAGE(PG8_SB(0, 0), cB, voffB); PG8_STAGE(PG8_SB(0, 1), cB + hstepB, voffB); PG8_STAGE(PG8_SA(0, 0), cA, voffA); PG8_STAGE(PG8_SA(0, 1), cA + hstepA, voffA);
    if (wr == 1) PG8_BAR;
    PG8_WAIT_V(2); PG8_BAR;
    PG8_STAGE(PG8_SB(1, 0), cB + kstepB, voffB); PG8_STAGE(PG8_SA(1, 0), cA + kstepA, voffA); PG8_STAGE(PG8_SB(1, 1), cB + hstepB + kstepB, voffB);
    PG8_WAIT_V(6); PG8_BAR;
    for (;;) {
        const bool has_next = unit_next(g, ui + 1, nxt);
        const char* nA = has_next ? UNIT_A(nxt) : cA; const char* nB = has_next ? UNIT_B(nxt) : cB;
        const int nt = cur.nt;
        for (int t = 0; t < nt; t += 2) {
            const bool last = (t == nt - 2);
            const char* a1 = cA + (size_t)(t + 1) * kstepA;
            const char* a2 = last ? nA : cA + (size_t)(t + 2) * kstepA; const char* b2 = last ? nB : cB + (size_t)(t + 2) * kstepB;
            const char* a3 = a2 + kstepA; const char* b3 = b2 + kstepB;
            PG8_LDB(B0, 0, 0); PG8_LDB(B1, 0, 1); PG8_SCHED; PG8_LDA(At, 0, 0); PG8_STAGE(PG8_SA(1, 1), a1 + hstepA, voffA);
            PG8_WAIT_V(8); PG8_WAIT_L(0); PG8_BAR; PG8_MMA(0, 0, At, B0); PG8_MMA(0, 1, At, B1); PG8_BAR; PG8_SCHED;
            PG8_LDA(At, 0, 1); PG8_STAGE(PG8_SB(0, 0), b2, voffB); PG8_STAGE(PG8_SB(0, 1), b2 + hstepB, voffB); PG8_STAGE(PG8_SA(0, 0), a2, voffA);
            PG8_WAIT_V(8); PG8_WAIT_L(0); PG8_BAR; PG8_MMA(1, 0, At, B0); PG8_MMA(1, 1, At, B1); PG8_BAR; PG8_SCHED;
            PG8_LDB(B0, 1, 0); PG8_LDB(B1, 1, 1); PG8_SCHED; PG8_LDA(At, 1, 0); PG8_STAGE(PG8_SA(0, 1), a2 + hstepA, voffA);
            PG8_WAIT_V(8); PG8_WAIT_L(0); PG8_BAR; PG8_MMA(0, 0, At, B0); PG8_MMA(0, 1, At, B1); PG8_BAR; PG8_SCHED;
            PG8_LDA(At, 1, 1); PG8_STAGE(PG8_SB(1, 0), b3, voffB); PG8_STAGE(PG8_SB(1, 1), b3 + hstepB, voffB); PG8_STAGE(PG8_SA(1, 0), a3, voffA);
            PG8_WAIT_V(8); PG8_WAIT_L(0); PG8_BAR; PG8_MMA(1, 0, At, B0); PG8_MMA(1, 1, At, B1); PG8_BAR; PG8_SCHED;
        }
        if (wr == 0) PG8_BAR;
        epi_store(acc, cur, wr, wc, fr, fq, e);
        if (!has_next) break;
#pragma unroll
        for (int a = 0; a < 2; ++a)
#pragma unroll
            for (int b = 0; b < 2; ++b)
#pragma unroll
                for (int m = 0; m < 4; ++m)
#pragma unroll
                    for (int n = 0; n < 2; ++n) acc[a][b][m][n] = (f32x4){0.f, 0.f, 0.f, 0.f};
        cur = nxt; cA = nA; cB = nB; ++ui;
        if (wr == 1) PG8_BAR;
    }
    PG8_WAIT_V(0);
    PG8_BAR;
#undef UNIT_A
#undef UNIT_B
#undef PG8_SA
#undef PG8_SB
#undef PG8_STAGE
#undef PG8_LDA
#undef PG8_LDB
#undef PG8_MMA
#undef PG8_WAIT_V
#undef PG8_WAIT_L
#undef PG8_BAR
#undef PG8_SCHED
}

#define SBAR() __builtin_amdgcn_sched_barrier(0)
__device__ __forceinline__ int crow(int r, int hi) { return (r & 3) + 8 * (r >> 2) + 4 * hi; }
__device__ __forceinline__ int v_st(int k, int c) { const int kk = (k & ~0xC) | ((k & 4) << 1) | ((k & 8) >> 1); return ((kk >> 3) * 4 + (c >> 5)) * 512 + ((kk & 7) * 32 + (c & 31)) * 2; }
__device__ __forceinline__ int v_rd_base(int lane) { return ((lane & 3) << 3) | (((lane >> 2) & 3) << 6) | (((lane >> 4) & 1) << 5) | (((lane >> 5) & 1) << 8); }
constexpr int v_rd_off(int d0, int ks, int half) { return d0 * 512 + ks * 4096 + half * 2048; }
template <int OFF> __device__ __forceinline__ s16x4 tr_read(int vb) { s16x4 r; asm volatile("ds_read_b64_tr_b16 %0, %1 offset:%2" : "=&v"(r) : "v"(vb), "i"(OFF) : "memory"); return r; }
template <int D0> __device__ __forceinline__ void pv_one(f32x16& od, int vb, bf16x8 pa0, bf16x8 pa1, bf16x8 pa2, bf16x8 pa3) {
    const s16x4 l0 = tr_read<v_rd_off(D0, 0, 0)>(vb), h0 = tr_read<v_rd_off(D0, 0, 1)>(vb), l1 = tr_read<v_rd_off(D0, 1, 0)>(vb), h1 = tr_read<v_rd_off(D0, 1, 1)>(vb);
    const s16x4 l2 = tr_read<v_rd_off(D0, 2, 0)>(vb), h2 = tr_read<v_rd_off(D0, 2, 1)>(vb), l3 = tr_read<v_rd_off(D0, 3, 0)>(vb), h3 = tr_read<v_rd_off(D0, 3, 1)>(vb);
    asm volatile("s_waitcnt lgkmcnt(0)" ::: "memory"); SBAR();
#define PK(L, H) (bf16x8){L[0], L[1], L[2], L[3], H[0], H[1], H[2], H[3]}
    od = __builtin_amdgcn_mfma_f32_32x32x16_bf16(pa0, PK(l0, h0), od, 0, 0, 0);
    od = __builtin_amdgcn_mfma_f32_32x32x16_bf16(pa1, PK(l1, h1), od, 0, 0, 0);
    od = __builtin_amdgcn_mfma_f32_32x32x16_bf16(pa2, PK(l2, h2), od, 0, 0, 0);
    od = __builtin_amdgcn_mfma_f32_32x32x16_bf16(pa3, PK(l3, h3), od, 0, 0, 0);
#undef PK
}
__device__ __forceinline__ void pv_d0(f32x16* o, int vb, bf16x8 pa0, bf16x8 pa1, bf16x8 pa2, bf16x8 pa3) {
    pv_one<0>(o[0], vb, pa0, pa1, pa2, pa3); pv_one<1>(o[1], vb, pa0, pa1, pa2, pa3); pv_one<2>(o[2], vb, pa0, pa1, pa2, pa3); pv_one<3>(o[3], vb, pa0, pa1, pa2, pa3);
}
__device__ __forceinline__ void partialSM(f32x16& p0, f32x16& p1, float& m_reg, float& mn, float& alpha, const float C, const float thr) {
    float pmax = p0[0];
#pragma unroll
    for (int r = 1; r < 16; ++r) pmax = fmaxf(pmax, p0[r]);
#pragma unroll
    for (int r = 0; r < 16; ++r) pmax = fmaxf(pmax, p1[r]);
    { auto rr = __builtin_amdgcn_permlane32_swap(__float_as_uint(pmax), __float_as_uint(pmax), false, false);
      pmax = fmaxf(__uint_as_float(rr[0]), __uint_as_float(rr[1])); }
    if (__builtin_expect(__all(pmax - m_reg <= thr), 1)) { mn = m_reg; alpha = 1.f; }
    else { mn = fmaxf(m_reg, pmax); alpha = __builtin_amdgcn_exp2f((m_reg - mn) * C); m_reg = mn; }
    const float mnC = -mn * C;
#pragma unroll
    for (int r = 0; r < 16; ++r) p0[r] = fmaf(p0[r], C, mnC);
#pragma unroll
    for (int r = 0; r < 16; ++r) p1[r] = fmaf(p1[r], C, mnC);
#pragma unroll
    for (int r = 0; r < 16; ++r) p0[r] = __builtin_amdgcn_exp2f(p0[r]);
}
__device__ __forceinline__ void finishSM(f32x16& p0, f32x16& p1, float alpha, float& l_reg, bf16x8& pa0, bf16x8& pa1, bf16x8& pa2, bf16x8& pa3) {
#pragma unroll
    for (int r = 0; r < 16; ++r) p1[r] = __builtin_amdgcn_exp2f(p1[r]);
    float ps = 0;
#pragma unroll
    for (int r = 0; r < 16; ++r) ps += p0[r];
#pragma unroll
    for (int r = 0; r < 16; ++r) ps += p1[r];
    { auto rr = __builtin_amdgcn_permlane32_swap(__float_as_uint(ps), __float_as_uint(ps), false, false);
      ps = __uint_as_float(rr[0]) + __uint_as_float(rr[1]); }
    l_reg = l_reg * alpha + ps;
#define PK4(P, BASE, OUT) do { unsigned a0 = cvt_pk_bf16(P[BASE + 0], P[BASE + 1]), a1 = cvt_pk_bf16(P[BASE + 2], P[BASE + 3]);   \
    unsigned b0 = cvt_pk_bf16(P[BASE + 4], P[BASE + 5]), b1 = cvt_pk_bf16(P[BASE + 6], P[BASE + 7]);                              \
    auto r0 = __builtin_amdgcn_permlane32_swap(a0, b0, false, false); auto r1 = __builtin_amdgcn_permlane32_swap(a1, b1, false, false); \
    u32x4 w = {r0[0], r1[0], r0[1], r1[1]}; OUT = *reinterpret_cast<bf16x8*>(&w); } while (0)
    PK4(p0, 0, pa0); PK4(p0, 8, pa1); PK4(p1, 0, pa2); PK4(p1, 8, pa3);
#undef PK4
}

struct AttnArgs {
    const bf16_t* Q; int ldq;
    const bf16_t* Kn; int ldk;
    const bf16_t* Kr; int ldkr;
    const bf16_t* V; int ldv;
    int lat0, ctx0, nlat, NT;
    float C, thr;
};

template <int DQK, int DK1, int LDQ, int LDK, int LDKR, int LDV, int NQL, int SDEPTH>
__device__ __forceinline__ void attn_core(const AttnArgs& a, char* lds, f32x16 (&o)[4]) {
    constexpr int KP = DQK * 2, SHM_K = 64 * KP, SHM_V = 64 * 128 * 2, KCH = DQK / 64, CPR = DQK / 8, ND0 = DQK / 16;
    const int tid = tid_opaque(), wid = tid >> 6, lane = tid & 63, r32 = lane & 31, hi = lane >> 5;
    char* V_lds = lds; char* K_lds = lds + 2 * SHM_V;
    float* wsf = (float*)(lds + 2 * SHM_V + 2 * SHM_K) + wid * 64; float* li_l = wsf; float* al_l = wsf + 32;
    float m_reg = -1e30f, l_reg = 0.f;
#pragma unroll
    for (int d = 0; d < 4; ++d)
#pragma unroll
        for (int r = 0; r < 16; ++r) o[d][r] = 0.f;
    constexpr int NQR = ND0 - NQL;
    bf16x8 qr[NQR];
    char* QL = lds + 2 * SHM_V + 2 * SHM_K + 2048 + tid * 16;
    { const bf16_t* Qw = a.Q + (long)(wid * 32 + r32) * LDQ + hi * 8;
#pragma unroll
      for (int d0 = 0; d0 < NQR; ++d0) qr[d0] = *(const bf16x8*)(Qw + d0 * 16);
#pragma unroll
      for (int d0 = NQR; d0 < ND0; ++d0) *(bf16x8*)(QL + (d0 - NQR) * 8192) = *(const bf16x8*)(Qw + d0 * 16); }
    const int sr = tid >> 4, sc = (tid & 15) * 8, vst0 = v_st(sr, sc), vst1 = v_st(32 + sr, sc);
    const int vb0 = (int)(uintptr_t)V_lds + v_rd_base(lane);
    const bf16_t* kptr[KCH]; int kld[KCH], kwo[KCH];
#pragma unroll
    for (int c = 0; c < KCH; ++c) { const int idx = tid + c * 512, kr_ = idx / CPR, kc = (idx % CPR) * 8;
        if (kc < DK1) { kptr[c] = a.Kn + (long)kr_ * LDK + kc; kld[c] = LDK; } else { kptr[c] = a.Kr + (long)kr_ * LDKR + (kc - DK1); kld[c] = LDKR; }
        kwo[c] = kr_ * KP + ((kc * 2) ^ ((kr_ & 7) << 4)); }
    struct { bf16x8 vs0, vs1, ks[KCH]; } sr_[SDEPTH];
    int kb[4];
#pragma unroll
    for (int m = 0; m < 4; ++m) kb[m] = r32 * KP + ((m * 32 + hi * 16) ^ ((r32 & 7) << 4));
#define KROW(j) ((j) < a.nlat ? a.lat0 + 64 * (j) : a.ctx0 + 64 * ((j) - a.nlat))
#define SLOAD(i, j) do { const long rb_ = KROW(j); sr_[i].vs0 = *(const bf16x8*)(a.V + (rb_ + sr) * LDV + sc); sr_[i].vs1 = *(const bf16x8*)(a.V + (rb_ + 32 + sr) * LDV + sc); \
    _Pragma("unroll") for (int c_ = 0; c_ < KCH; ++c_) sr_[i].ks[c_] = *(const bf16x8*)(kptr[c_] + rb_ * kld[c_]); } while (0)
#define SWRITE(b, i) do { *(bf16x8*)(V_lds + (b) * SHM_V + vst0) = sr_[i].vs0; *(bf16x8*)(V_lds + (b) * SHM_V + vst1) = sr_[i].vs1; \
    _Pragma("unroll") for (int c_ = 0; c_ < KCH; ++c_) *(bf16x8*)(K_lds + (b) * SHM_K + kwo[c_]) = sr_[i].ks[c_]; } while (0)
#define RESC(al) do { if (__any((al) < 1.f)) { if (hi == 0) al_l[r32] = (al); asm volatile("s_waitcnt lgkmcnt(0)" ::: "memory"); \
    _Pragma("unroll") for (int d = 0; d < 4; ++d) _Pragma("unroll") for (int r = 0; r < 16; ++r) o[d][r] *= al_l[crow(r, hi)]; } } while (0)
#define QKT(P0, P1, KB) do { P0 = f32x16{}; P1 = f32x16{}; \
    _Pragma("unroll") for (int d0 = 0; d0 < ND0; ++d0) { \
      const bf16x8 b0 = *(const bf16x8*)((KB) + kb[d0 & 3] + (d0 >> 2) * 128); \
      const bf16x8 b1 = *(const bf16x8*)((KB) + kb[d0 & 3] + (d0 >> 2) * 128 + 32 * KP); \
      const bf16x8 qf = (d0 < NQR) ? qr[d0 < NQR ? d0 : 0] : *(const bf16x8*)(QL + (d0 - NQR) * 8192); \
      P0 = __builtin_amdgcn_mfma_f32_32x32x16_bf16(b0, qf, P0, 0, 0, 0); \
      P1 = __builtin_amdgcn_mfma_f32_32x32x16_bf16(b1, qf, P1, 0, 0, 0); } } while (0)
    f32x16 pA0, pA1, pB0, pB1; float mnA, mnB, alA, alB; bf16x8 pa0, pa1, pa2, pa3; const int NT = a.NT;
    constexpr int SE = 0, SO = SDEPTH - 1;
    SLOAD(SE, 0); asm volatile("s_waitcnt vmcnt(0)" ::: "memory"); SWRITE(0, SE); __syncthreads();
    QKT(pA0, pA1, K_lds); partialSM(pA0, pA1, m_reg, mnA, alA, a.C, a.thr);
    SLOAD(SO, 1); if (SDEPTH == 2 && 2 < NT) SLOAD(SE, 2);
    SWRITE(1, SO); __syncthreads();
    for (int j = 1; j + 1 < NT; j += 2) {
        SBAR(); QKT(pB0, pB1, K_lds + SHM_K);
        finishSM(pA0, pA1, alA, l_reg, pa0, pa1, pa2, pa3); SBAR();
        SLOAD(SO, j + SDEPTH); SBAR();
        pv_d0(o, vb0, pa0, pa1, pa2, pa3); partialSM(pB0, pB1, m_reg, mnB, alB, a.C, a.thr);
        __syncthreads(); SWRITE(0, SE);
        RESC(alB); __syncthreads();
        SBAR(); QKT(pA0, pA1, K_lds);
        finishSM(pB0, pB1, alB, l_reg, pa0, pa1, pa2, pa3); SBAR();
        if (SDEPTH == 1 || j + 3 < NT) SLOAD(SE, j + 1 + SDEPTH); SBAR();
        pv_d0(o, vb0 + SHM_V, pa0, pa1, pa2, pa3); partialSM(pA0, pA1, m_reg, mnA, alA, a.C, a.thr);
        __syncthreads(); SWRITE(1, SO);
        RESC(alA); __syncthreads();
    }
    SBAR(); QKT(pB0, pB1, K_lds + SHM_K);
    finishSM(pA0, pA1, alA, l_reg, pa0, pa1, pa2, pa3); SBAR();
    pv_d0(o, vb0, pa0, pa1, pa2, pa3); partialSM(pB0, pB1, m_reg, mnB, alB, a.C, a.thr);
    __syncthreads(); RESC(alB);
    finishSM(pB0, pB1, alB, l_reg, pa0, pa1, pa2, pa3); SBAR();
    pv_d0(o, vb0 + SHM_V, pa0, pa1, pa2, pa3);
    if (hi == 0) li_l[r32] = l_reg; asm volatile("s_waitcnt lgkmcnt(0)" ::: "memory");
#pragma unroll
    for (int r = 0; r < 16; ++r) { const float rl = __builtin_amdgcn_rcpf(li_l[crow(r, hi)]);
#pragma unroll
        for (int d = 0; d < 4; ++d) o[d][r] *= rl; }
    __syncthreads();
#undef KROW
#undef SLOAD
#undef SWRITE
#undef RESC
#undef QKT
}

__device__ __forceinline__ void phase_attn_mla(const Params& p, char* lds) {
    const bf16_t* T1 = (const bf16_t*)(p.ws + WS_T1); bf16_t* O = (bf16_t*)(p.ws + WS_H);
    const int tid = tid_opaque(), wid = tid >> 6, lane = tid & 63, r32 = lane & 31, hi = lane >> 5;
    const float scale = 0.07216878364870322f;
    for (int it = vwg(); it < 1024 + 128; it += gridDim.x) {
        int b, h, row0; AttnArgs a;
        if (it < 1024) {
            int itm = it;
            if (gridDim.x == 256) { const int w = it & 255, rnd = it >> 8, xcd = w & 7, slot = w >> 3; itm = ((rnd * 32 + xcd * 4 + (slot >> 3)) << 3) | (slot & 7); }
            b = itm >> 6; h = (itm >> 3) & 7; const int qb = itm & 7; row0 = b * SEQ + qb * 256; a.nlat = 32; a.NT = 36; }
        else { const int i2 = it - 1024; b = i2 >> 3; h = i2 & 7; row0 = MLAT + b * CTXL; a.nlat = 0; a.NT = 4; }
        a.lat0 = b * SEQ; a.ctx0 = MLAT + b * CTXL;
        a.Q = T1 + T_Q + (size_t)row0 * 1536 + h * 192; a.ldq = 1536;
        a.Kn = T1 + T_KV + h * 256; a.ldk = 2048; a.Kr = T1 + T_KR; a.ldkr = 64;
        a.V = T1 + T_KV + h * 256 + 128; a.ldv = 2048;
        a.C = scale * 1.4426950408889634f; a.thr = 8.f / scale;
        f32x16 o[4];
        attn_core<192, 128, 1536, 2048, 64, 2048, MLA_NQL, 1>(a, lds, o);
        bf16_t* Ow = O + (size_t)(row0 + wid * 32 + 4 * hi) * 1024 + h * 128 + r32;
        asm volatile("" : "+v"(Ow));
#pragma unroll
        for (int r = 0; r < 16; ++r) { bf16_t* Or = Ow + (size_t)((r & 3) + 8 * (r >> 2)) * 1024;
#pragma unroll
            for (int d0 = 0; d0 < 4; ++d0) Or[d0 * 32] = (bf16_t)(cvt_pk_bf16(o[d0][r], 0.f) & 0xffffu); }
    }
}

__device__ __forceinline__ void phase_attn_diff(const Params& p, char* lds) {
    const bf16_t* T1 = (const bf16_t*)(p.ws + WS_T1); bf16_t* O = (bf16_t*)(p.ws + WS_H);
    const int tid = tid_opaque(), wid = tid >> 6, lane = tid & 63, r32 = lane & 31, hi = lane >> 5;
    float* scr0 = (float*)(p.ws + WS_SCR) + ((size_t)blockIdx.x * 512 + tid) * 64;
    const float scale = 0.125f;
    const float lam_init = 0.8f - 0.6f * 0.40656965974059917f;
    float lam;
    { const float* lv = p.diff_lambda; float s1 = 0.f, s2 = 0.f;
      for (int k = 0; k < 64; ++k) { s1 += lv[k] * lv[64 + k]; s2 += lv[128 + k] * lv[192 + k]; }
      lam = expf(s1) - expf(s2) + lam_init; }
    float gs[4];
#pragma unroll
    for (int d0 = 0; d0 < 4; ++d0) gs[d0] = p.diff_g_subln[d0 * 32 + r32] * (1.0f - lam_init);
    for (int it = vwg(); it < 1024; it += gridDim.x) {
        int itm = it;
        if (gridDim.x == 256) { const int w = it & 255, rnd = it >> 8, xcd = w & 7, slot = w >> 3; itm = ((rnd * 32 + xcd * 4 + (slot >> 3)) << 3) | (slot & 7); }
        const int b = itm >> 6, h = (itm >> 3) & 7, qb = itm & 7, row0 = b * SEQ + qb * 256;
#pragma unroll 1
        for (int j = 0; j < 2; ++j) {
            AttnArgs a; a.nlat = 32; a.NT = 36; a.lat0 = b * SEQ; a.ctx0 = MLAT + b * CTXL;
            a.Q = T1 + (size_t)row0 * 3072 + h * 128 + j * 64; a.ldq = 3072;
            a.Kn = T1 + 1024 + h * 128 + j * 64; a.ldk = 3072; a.Kr = a.Kn; a.ldkr = 3072;
            a.V = T1 + 2048 + h * 128; a.ldv = 3072;
            a.C = scale * 1.4426950408889634f; a.thr = 8.f / scale;
            f32x16 o[4];
            attn_core<64, 64, 3072, 3072, 3072, 3072, 0, 2>(a, lds, o);
            float* scr = scr0; asm volatile("" : "+v"(scr));
            if (j == 0) {
#pragma unroll
                for (int r = 0; r < 16; ++r) { f32x4 t = {o[0][r], o[1][r], o[2][r], o[3][r]}; *(f32x4*)(scr + 4 * r) = t; }
            } else {
                bf16_t* Ow = O + (size_t)(row0 + wid * 32 + 4 * hi) * 1024 + h * 128 + r32;
                asm volatile("" : "+v"(Ow));
#pragma unroll
                for (int r = 0; r < 16; ++r) {
                    const f32x4 t = *(const f32x4*)(scr + 4 * r);
                    const float v0 = t[0] - lam * o[0][r], v1 = t[1] - lam * o[1][r], v2 = t[2] - lam * o[2][r], v3 = t[3] - lam * o[3][r];
                    float ss = v0 * v0 + v1 * v1 + v2 * v2 + v3 * v3;
#pragma unroll
                    for (int x = 16; x >= 1; x >>= 1) ss += __shfl_xor(ss, x);
                    const float rs = rsqrtf(ss * (1.0f / 128.0f) + EPS);
                    bf16_t* Or = Ow + (size_t)((r & 3) + 8 * (r >> 2)) * 1024;
                    Or[0] = (bf16_t)(cvt_pk_bf16(v0 * rs * gs[0], 0.f) & 0xffffu); Or[32] = (bf16_t)(cvt_pk_bf16(v1 * rs * gs[1], 0.f) & 0xffffu);
                    Or[64] = (bf16_t)(cvt_pk_bf16(v2 * rs * gs[2], 0.f) & 0xffffu); Or[96] = (bf16_t)(cvt_pk_bf16(v3 * rs * gs[3], 0.f) & 0xffffu);
                }
            }
        }
    }
}

__device__ __forceinline__ const float* xin_row(const Params& p, int row, bool from_input) {
    if (from_input) return row < MLAT ? p.x + (size_t)row * DM : p.ctx + (size_t)(row - MLAT) * DM;
    return row < MLAT ? p.out + (size_t)row * DM : (const float*)(p.ws + WS_XC) + (size_t)(row - MLAT) * DM;
}
__device__ __forceinline__ float* xout_row(const Params& p, int row) {
    return row < MLAT ? p.out + (size_t)row * DM : (float*)(p.ws + WS_XC) + (size_t)(row - MLAT) * DM;
}

__device__ __forceinline__ void phase_rn(const Params& p, int layer, int stage, const bf16_t* Y, int nrows, int npart) {
    const int tid = tid_opaque(), wid = tid >> 6, lane = tid & 63;
    const float* MOD = (const float*)(p.ws + WS_MOD); bf16_t* H = (bf16_t*)(p.ws + WS_H);
    const int gate_c = stage == 0 ? 2 : 5;
    const float* gA = p.norm_g + (layer * 4 + (stage == 0 ? 1 : 3)) * DM;
    const bool has_next = !(layer == 3 && stage == 1);
    const int nl = stage == 0 ? layer : layer + 1;
    const float* gB = p.norm_g + ((has_next ? nl : 0) * 4 + (stage == 0 ? 2 : 0)) * DM;
    const int sh_c = stage == 0 ? 3 : 0, sc_c = stage == 0 ? 4 : 1;
    const bool from_input = (layer == 0 && stage == 0);
    for (int row = (blockIdx.x * 8 + wid) * 2; row < nrows; row += gridDim.x * 16) {
        const int mr = modrow(row);
        const float* xi = xin_row(p, row, from_input); float* xo = xout_row(p, row);
        const bf16_t* y = Y + (size_t)row * DM;
        const float* mg = MOD + ((size_t)layer * 17 + mr) * 6144 + gate_c * DM;
        u32x2 yw[2][4]; f32x4 xx[2][4], gg[4], gt[4];
#pragma unroll
        for (int q = 0; q < 2; ++q)
#pragma unroll
            for (int i = 0; i < 4; ++i) { yw[q][i] = *(const u32x2*)(y + q * DM + i * 256 + lane * 4); xx[q][i] = *(const f32x4*)(xi + q * DM + i * 256 + lane * 4); }
#pragma unroll
        for (int i = 0; i < 4; ++i) { gg[i] = *(const f32x4*)(gA + i * 256 + lane * 4); gt[i] = *(const f32x4*)(mg + i * 256 + lane * 4); }
        float yv[2][16]; float ss[2] = {0.f, 0.f};
#pragma unroll
        for (int q = 0; q < 2; ++q)
#pragma unroll
            for (int i = 0; i < 4; ++i) { yv[q][4 * i] = bf_lo(yw[q][i].x); yv[q][4 * i + 1] = bf_hi(yw[q][i].x); yv[q][4 * i + 2] = bf_lo(yw[q][i].y); yv[q][4 * i + 3] = bf_hi(yw[q][i].y); }
        if (npart > 1 && row >= MLAT) {
            const bf16_t* yp = (const bf16_t*)(p.ws + WS_SCR) + (size_t)(row - MLAT) * DM;
#pragma unroll
            for (int q = 0; q < 2; ++q)
#pragma unroll
                for (int i = 0; i < 4; ++i) { float a4[4] = {0.f, 0.f, 0.f, 0.f};
                    for (int k = 0; k < npart; ++k) { float t4[4]; load_bf4(yp + (size_t)k * MCTX * DM + q * DM + i * 256 + lane * 4, t4); a4[0] += t4[0]; a4[1] += t4[1]; a4[2] += t4[2]; a4[3] += t4[3]; }
                    yv[q][4 * i] = a4[0]; yv[q][4 * i + 1] = a4[1]; yv[q][4 * i + 2] = a4[2]; yv[q][4 * i + 3] = a4[3]; }
        }
#pragma unroll
        for (int q = 0; q < 2; ++q)
#pragma unroll
            for (int i = 0; i < 16; ++i) ss[q] += yv[q][i] * yv[q][i];
#pragma unroll
        for (int o = 32; o >= 1; o >>= 1) { ss[0] += __shfl_xor(ss[0], o); ss[1] += __shfl_xor(ss[1], o); }
        float ss2[2] = {0.f, 0.f};
#pragma unroll
        for (int q = 0; q < 2; ++q) { const float r1 = rsqrtf(ss[q] * (1.0f / DM) + EPS);
#pragma unroll
            for (int i = 0; i < 4; ++i) { f32x4 xn;
#pragma unroll
                for (int j = 0; j < 4; ++j) { xn[j] = xx[q][i][j] + gt[i][j] * (yv[q][4 * i + j] * r1 * gg[i][j]); ss2[q] += xn[j] * xn[j]; }
                xx[q][i] = xn; *(f32x4*)(xo + q * DM + i * 256 + lane * 4) = xn; } }
        if (has_next) {
            const float* msh = MOD + ((size_t)nl * 17 + mr) * 6144 + sh_c * DM; const float* msc = MOD + ((size_t)nl * 17 + mr) * 6144 + sc_c * DM;
            f32x4 gb[4], sh[4], sc[4];
#pragma unroll
            for (int i = 0; i < 4; ++i) { gb[i] = *(const f32x4*)(gB + i * 256 + lane * 4); sh[i] = *(const f32x4*)(msh + i * 256 + lane * 4); sc[i] = *(const f32x4*)(msc + i * 256 + lane * 4); }
#pragma unroll
            for (int o = 32; o >= 1; o >>= 1) { ss2[0] += __shfl_xor(ss2[0], o); ss2[1] += __shfl_xor(ss2[1], o); }
#pragma unroll
            for (int q = 0; q < 2; ++q) { const float r2 = rsqrtf(ss2[q] * (1.0f / DM) + EPS);
#pragma unroll
                for (int i = 0; i < 4; ++i) { float hv[4];
#pragma unroll
                    for (int j = 0; j < 4; ++j) hv[j] = (xx[q][i][j] * r2 * gb[i][j]) * (1.0f + sc[i][j]) + sh[i][j];
                    store_bf4(H + (size_t)(row + q) * DM + i * 256 + lane * 4, hv[0], hv[1], hv[2], hv[3]); } }
        }
    }
}

template <int I> __device__ __forceinline__ void poold_group(const float* xb, const float* RSs, int t0, int len, int lane, const float* g0, const float* msc, bf16_t* Hrow0) {
    constexpr int W = 2 << I, LO = W / 2, HI = W - 1 - LO, NR = 8 + W - 1;
    const int col = I * 256 + lane * 4;
    f32x4 xs[NR];
#pragma unroll
    for (int k = 0; k < NR; ++k) { const int tt = t0 - LO + k; const bool ok = (tt >= 0 && tt < len); const int tc = ok ? tt : t0;
        const f32x4 xx = *(const f32x4*)(xb + (size_t)tc * DM + col); const float rs = ok ? RSs[tc] : 0.f; xs[k] = xx * rs; }
    const f32x4 gg = *(const f32x4*)(g0 + col), sc = *(const f32x4*)(msc + col);
    f32x4 gm;
#pragma unroll
    for (int j = 0; j < 4; ++j) gm[j] = gg[j] * (1.0f + sc[j]);
    f32x4 S = xs[0];
#pragma unroll
    for (int k = 1; k < W; ++k) S += xs[k];
#pragma unroll
    for (int r = 0; r < 8; ++r) {
        const int t = t0 + r; const int ta = max(t - LO, 0), tb = min(t + HI + 1, len); const float inv = 1.0f / (float)(tb - ta);
        const f32x4 d = (S * inv - xs[r + LO]) * gm;
        store_bf4(Hrow0 + (size_t)r * DM + col, d[0], d[1], d[2], d[3]);
        if (r < 7) S += xs[r + W] - xs[r];
    }
}
__device__ __forceinline__ void phase_poold(const Params& p) {
    const int tid = tid_opaque(), wid = tid >> 6, lane = tid & 63;
    const float* MOD = (const float*)(p.ws + WS_MOD); const float* RS = (const float*)(p.ws + WS_RS); bf16_t* H = (bf16_t*)(p.ws + WS_H);
    const float* g0 = p.norm_g;
    for (int row = (blockIdx.x * 8 + wid) * 8; row < MALL; row += gridDim.x * 64) {
        const int mr = modrow(row);
        const int s0 = row < MLAT ? (row & ~(SEQ - 1)) : MLAT + ((row - MLAT) & ~(CTXL - 1)); const int len = row < MLAT ? SEQ : CTXL; const int t0 = row - s0;
        const float* xb = row < MLAT ? p.x + (size_t)s0 * DM : p.ctx + (size_t)(s0 - MLAT) * DM;
        const float* msc = MOD + ((size_t)0 * 17 + mr) * 6144 + 1 * DM;
        bf16_t* Hr = H + (size_t)row * DM;
        poold_group<0>(xb, RS + s0, t0, len, lane, g0, msc, Hr);
        poold_group<1>(xb, RS + s0, t0, len, lane, g0, msc, Hr);
        poold_group<2>(xb, RS + s0, t0, len, lane, g0, msc, Hr);
        poold_group<3>(xb, RS + s0, t0, len, lane, g0, msc, Hr);
    }
}

__device__ __forceinline__ void phase_conv(const Params& p) {
    const int tid = tid_opaque(), wid = tid >> 6, lane = tid & 63;
    const bf16_t* T1 = (const bf16_t*)(p.ws + WS_T1); bf16_t* H = (bf16_t*)(p.ws + WS_H);
    for (int row = (blockIdx.x * 8 + wid) * 8; row < MALL; row += gridDim.x * 64) {
        const int s0 = row < MLAT ? (row & ~(SEQ - 1)) : MLAT + ((row - MLAT) & ~(CTXL - 1)); const int len = row < MLAT ? SEQ : CTXL; const int t0 = row - s0;
#pragma unroll 1
        for (int i = 0; i < 4; ++i) {
            const int col = i * 256 + lane * 4;
            u32x2 cw[10], vw[10], bw[8];
#pragma unroll
            for (int k = 0; k < 10; ++k) { const int tt = t0 - 1 + k; const bool ok = (tt >= 0 && tt < len); const int tc = ok ? tt : t0;
                const bf16_t* rp = T1 + (size_t)(s0 + tc) * 3072; cw[k] = *(const u32x2*)(rp + 1024 + col); vw[k] = *(const u32x2*)(rp + 2048 + col);
                if (!ok) { cw[k].x = 0u; cw[k].y = 0u; } }
#pragma unroll
            for (int r = 0; r < 8; ++r) bw[r] = *(const u32x2*)(T1 + (size_t)(row + r) * 3072 + col);
            const f32x4 w0 = *(const f32x4*)(p.conv_w + col), w1 = *(const f32x4*)(p.conv_w + DM + col), w2 = *(const f32x4*)(p.conv_w + 2 * DM + col);
            f32x4 u[10];
#pragma unroll
            for (int k = 0; k < 10; ++k) { u[k][0] = bf_lo(cw[k].x) * bf_lo(vw[k].x); u[k][1] = bf_hi(cw[k].x) * bf_hi(vw[k].x); u[k][2] = bf_lo(cw[k].y) * bf_lo(vw[k].y); u[k][3] = bf_hi(cw[k].y) * bf_hi(vw[k].y); }
#pragma unroll
            for (int r = 0; r < 8; ++r) { const f32x4 z = u[r] * w0 + u[r + 1] * w1 + u[r + 2] * w2;
                store_bf4(H + (size_t)(row + r) * DM + col, bf_lo(bw[r].x) * z[0], bf_hi(bw[r].x) * z[1], bf_lo(bw[r].y) * z[2], bf_hi(bw[r].y) * z[3]); }
        }
    }
}

__device__ __forceinline__ void phase_mlaprep(const Params& p) {
    const int tid = tid_opaque(), wid = tid >> 6, lane = tid & 63;
    bf16_t* T1 = (bf16_t*)(p.ws + WS_T1); bf16_t* CKV = (bf16_t*)(p.ws + WS_H); const float* rope = (const float*)(p.ws + WS_ROPE);
    for (int row = blockIdx.x * 8 + wid; row < MALL; row += gridDim.x * 8) {
        const bf16_t* ar = T1 + T_AB + (size_t)row * 768;
        float v[12]; float sq = 0.f, skv = 0.f;
#pragma unroll
        for (int i = 0; i < 3; ++i) { const int col = i * 256 + lane * 4; load_bf4(ar + col, v + 4 * i);
            const float s = v[4 * i] * v[4 * i] + v[4 * i + 1] * v[4 * i + 1] + v[4 * i + 2] * v[4 * i + 2] + v[4 * i + 3] * v[4 * i + 3];
            if (col < 384) sq += s; else if (col < 640) skv += s; }
        sq = wave_sum(sq); skv = wave_sum(skv);
        const float rq = rsqrtf(sq * (1.0f / 384.0f) + EPS), rkv = rsqrtf(skv * (1.0f / 256.0f) + EPS);
#pragma unroll
        for (int i = 0; i < 3; ++i) { const int col = i * 256 + lane * 4;
            if (col < 384) { const f32x4 g = *(const f32x4*)(p.mla_g_q + col);
                store_bf4(T1 + T_CQ + (size_t)row * 384 + col, v[4 * i] * rq * g[0], v[4 * i + 1] * rq * g[1], v[4 * i + 2] * rq * g[2], v[4 * i + 3] * rq * g[3]); }
            else if (col < 640) { const int c2 = col - 384; const f32x4 g = *(const f32x4*)(p.mla_g_kv + c2);
                store_bf4(CKV + (size_t)row * 256 + c2, v[4 * i] * rkv * g[0], v[4 * i + 1] * rkv * g[1], v[4 * i + 2] * rkv * g[2], v[4 * i + 3] * rkv * g[3]); }
        }
        {
            float pv[4];
#pragma unroll
            for (int j = 0; j < 4; ++j) pv[j] = __shfl_xor(v[8 + j], 4);
            if (lane >= 32 && lane < 48) {
                const int k = lane - 32; float ov[4];
                if (row < MLAT) {
                    const int t = row & (SEQ - 1); const int pos = (k < 8) ? (t >> 6) : (t & 63);
                    const f32x4 t0 = *(const f32x4*)(rope + (pos * 16 + 4 * (k & 3)) * 2), t1 = *(const f32x4*)(rope + (pos * 16 + 4 * (k & 3)) * 2 + 4);
                    const float cs[4] = {t0[0], t0[2], t1[0], t1[2]}, sn[4] = {t0[1], t0[3], t1[1], t1[3]};
#pragma unroll
                    for (int j = 0; j < 4; ++j) ov[j] = (k & 4) ? (v[8 + j] * cs[j] + pv[j] * sn[j]) : (v[8 + j] * cs[j] - pv[j] * sn[j]);
                } else {
#pragma unroll
                    for (int j = 0; j < 4; ++j) ov[j] = v[8 + j];
                }
                store_bf4(T1 + T_KR + (size_t)row * 64 + 4 * k, ov[0], ov[1], ov[2], ov[3]);
            }
        }
    }
}

__device__ __forceinline__ void conv_wt(const float* src, int K, int N, int Npad, bf16_t* dst, float* tile, int rot) {
    const int tid = tid_opaque(), G = gridDim.x;
    const int ntn = Npad / 64, ntk = K / 64, ntiles = ntn * ntk;
    for (int u = (blockIdx.x + G - (rot % G)) % G; u < ntiles; u += G) {
        const int kt = u / ntn, nt_ = u % ntn, k0 = kt * 64, n0 = nt_ * 64;
        const int r = tid >> 4, c4 = (tid & 15) * 4;
#pragma unroll
        for (int pss = 0; pss < 2; ++pss) { const int rr = r + pss * 32; f32x4 v = {0.f, 0.f, 0.f, 0.f};
            if (n0 + c4 < N) v = *(const f32x4*)(src + (size_t)(k0 + rr) * N + n0 + c4);
            tile[rr * 65 + c4 + 0] = v[0]; tile[rr * 65 + c4 + 1] = v[1]; tile[rr * 65 + c4 + 2] = v[2]; tile[rr * 65 + c4 + 3] = v[3]; }
        __syncthreads();
        { const int n = tid >> 3, k8 = (tid & 7) * 8; float t[8];
#pragma unroll
          for (int j = 0; j < 8; ++j) t[j] = tile[(k8 + j) * 65 + n];
          u32x4 w; w.x = cvt_pk_bf16(t[0], t[1]); w.y = cvt_pk_bf16(t[2], t[3]); w.z = cvt_pk_bf16(t[4], t[5]); w.w = cvt_pk_bf16(t[6], t[7]);
          *(u32x4*)(dst + (size_t)(n0 + n) * K + k0 + k8) = w; }
        __syncthreads();
    }
}

__device__ __forceinline__ void phase_prep(const Params& p, char* lds) {
    const int tid = tid_opaque(), wid = tid >> 6, lane = tid & 63, G = gridDim.x;
    float* fl = (float*)lds;
    if (blockIdx.x < 96) {
        { f32x4 cvv[9];
#pragma unroll
          for (int q = 0; q < 9; ++q) { const int idx = tid + q * NTHREADS; const int r = idx >> 8, k4 = (idx & 255) * 4; cvv[q] = (idx < 17 * 256) ? *(const f32x4*)(r < 16 ? p.c + r * 1024 + k4 : p.c_ctx + k4) : (f32x4){0.f, 0.f, 0.f, 0.f}; }
#pragma unroll
          for (int q = 0; q < 9; ++q) { const int idx = tid + q * NTHREADS; const int r = idx >> 8, k4 = (idx & 255) * 4;
              if (idx < 17 * 256) {
#pragma unroll
                  for (int j = 0; j < 4; ++j) fl[(k4 + j) * 17 + r] = cvv[q][j] / (1.0f + expf(-cvv[q][j])); } } }
        __syncthreads();
        float* MOD = (float*)(p.ws + WS_MOD);
        for (int u = blockIdx.x; u < 96; u += G) {
            const int layer = u / 24, cb = u % 24, col0 = cb * 256 + wid * 32 + (lane & 7) * 4, kq = lane >> 3;
            float acc[17][4];
#pragma unroll
            for (int r = 0; r < 17; ++r)
#pragma unroll
                for (int j = 0; j < 4; ++j) acc[r][j] = 0.f;
            const float* W = p.ada_w + (size_t)layer * 1024 * 6144 + col0;
#pragma unroll 8
            for (int itk = 0; itk < 128; ++itk) { const int k = kq + 8 * itk; const f32x4 w = *(const f32x4*)(W + (size_t)k * 6144);
#pragma unroll
                for (int r = 0; r < 17; ++r) { const float s = fl[k * 17 + r];
#pragma unroll
                    for (int j = 0; j < 4; ++j) acc[r][j] += s * w[j]; } }
#pragma unroll
            for (int r = 0; r < 17; ++r)
#pragma unroll
                for (int j = 0; j < 4; ++j) { float v = acc[r][j]; v += __shfl_xor(v, 8); v += __shfl_xor(v, 16); v += __shfl_xor(v, 32); acc[r][j] = v; }
            if (kq == 0) { const f32x4 bb = *(const f32x4*)(p.ada_b + layer * 6144 + col0);
#pragma unroll
                for (int r = 0; r < 17; ++r) { f32x4 o = {acc[r][0] + bb[0], acc[r][1] + bb[1], acc[r][2] + bb[2], acc[r][3] + bb[3]}; *(f32x4*)(MOD + ((size_t)layer * 17 + r) * 6144 + col0) = o; } }
        }
        __syncthreads();
    }
    if (blockIdx.x == G - 1) {
        float* rt = (float*)(p.ws + WS_ROPE);
        for (int idx = tid; idx < 1024; idx += NTHREADS) { const int pos = idx >> 4, f = idx & 15; const float inv = powf(10000.0f, -(float)f / 16.0f); const float ang = (float)pos * inv;
            rt[idx * 2] = cosf(ang); rt[idx * 2 + 1] = sinf(ang); }
    }
    { float* RS = (float*)(p.ws + WS_RS);
      for (int row = (blockIdx.x * 8 + wid) * 4; row < MALL; row += G * 32) { const float* xi = xin_row(p, row, true); f32x4 xx[4][4];
#pragma unroll
          for (int q = 0; q < 4; ++q)
#pragma unroll
              for (int i = 0; i < 4; ++i) xx[q][i] = *(const f32x4*)(xi + q * DM + i * 256 + lane * 4);
          float ss[4] = {0.f, 0.f, 0.f, 0.f};
#pragma unroll
          for (int q = 0; q < 4; ++q)
#pragma unroll
              for (int i = 0; i < 4; ++i) ss[q] += xx[q][i][0] * xx[q][i][0] + xx[q][i][1] * xx[q][i][1] + xx[q][i][2] * xx[q][i][2] + xx[q][i][3] * xx[q][i][3];
#pragma unroll
          for (int o = 32; o >= 1; o >>= 1) { ss[0] += __shfl_xor(ss[0], o); ss[1] += __shfl_xor(ss[1], o); ss[2] += __shfl_xor(ss[2], o); ss[3] += __shfl_xor(ss[3], o); }
          if (lane < 4) RS[row + lane] = rsqrtf((lane == 0 ? ss[0] : lane == 1 ? ss[1] : lane == 2 ? ss[2] : ss[3]) * (1.0f / DM) + EPS); } }
    bf16_t* W = (bf16_t*)(p.ws + WS_W);
    int rot = 96;
    for (int l = 0; l < 4; ++l) {
        conv_wt(p.ffn_w1 + (size_t)l * 1024 * 4096, 1024, 4096, 4096, W + W_FFN + (size_t)l * 8388608, fl, rot); rot += 1024;
        conv_wt(p.ffn_w2 + (size_t)l * 4096 * 1024, 4096, 1024, 1024, W + W_FFN + (size_t)l * 8388608 + 4194304, fl, rot); rot += 1024;
    }
    for (int g = 0; g < 4; ++g) { conv_wt(p.pool_w + (size_t)g * 65536, 256, 256, 256, W + W_POOL + (size_t)g * 65536, fl, rot); rot += 16; }
    conv_wt(p.conv_in_w, 1024, 3072, 3072, W + W_CIN, fl, rot); rot += 768;
    conv_wt(p.conv_out_w, 1024, 1024, 1024, W + W_COUT, fl, rot); rot += 256;
    conv_wt(p.mla_w_down, 1024, 704, 768, W + W_DOWN, fl, rot); rot += 192;
    conv_wt(p.mla_w_uq, 384, 1536, 1536, W + W_UQ, fl, rot); rot += 144;
    conv_wt(p.mla_w_ukv, 256, 2048, 2048, W + W_UKV, fl, rot); rot += 128;
    conv_wt(p.mla_w_o, 1024, 1024, 1024, W + W_MO, fl, rot); rot += 256;
    conv_wt(p.diff_w_qkv, 1024, 3072, 3072, W + W_DQKV, fl, rot); rot += 768;
    conv_wt(p.diff_w_o, 1024, 1024, 1024, W + W_DO, fl, rot);
}

__device__ __forceinline__ void grid_barrier(unsigned* cnt, unsigned target) {
    asm volatile("s_waitcnt vmcnt(0) lgkmcnt(0)" ::: "memory");
    __syncthreads();
    if (threadIdx.x < 64) {
        if (threadIdx.x == 0) {
            __builtin_amdgcn_fence(__ATOMIC_RELEASE, "agent");
            asm volatile("s_waitcnt vmcnt(0)" ::: "memory");
            __hip_atomic_fetch_add(cnt, 1u, __ATOMIC_RELAXED, __HIP_MEMORY_SCOPE_AGENT);
            while (__hip_atomic_load(cnt, __ATOMIC_RELAXED, __HIP_MEMORY_SCOPE_AGENT) < target) __builtin_amdgcn_s_sleep(1);
        }
        __builtin_amdgcn_fence(__ATOMIC_ACQUIRE, "agent");
        asm volatile("s_waitcnt vmcnt(0)" ::: "memory");
    }
    __syncthreads();
}

enum { T_PREP = 0, T_POOLD, T_GEMM, T_RN, T_CONV, T_MLAPREP, T_ATTN_MLA, T_ATTN_DIFF };
constexpr int N_PHASES = 31;

__global__ void __launch_bounds__(NTHREADS, 2) mk_fwd(Params p_arg) {
    extern __shared__ __attribute__((aligned(16))) unsigned char shm[];
    LAS unsigned char* ldsl = (LAS unsigned char*)shm; char* ldsg = (char*)shm;
    const int ph_lo = p_arg.ph_lo, ph_hi = p_arg.ph_hi; unsigned char* const wsb = p_arg.ws;
    bf16_t* H = (bf16_t*)(wsb + WS_H); bf16_t* T1 = (bf16_t*)(wsb + WS_T1); const bf16_t* W = (const bf16_t*)(wsb + WS_W);
    const float* rope = (const float*)(wsb + WS_ROPE);
    unsigned nbar = 0; unsigned* barcnt = (unsigned*)(wsb + WS_BAR);
    if (ph_hi - ph_lo > 1) {
        LAS int* vslot = (LAS int*)(ldsl + LDS_BYTES);
        unsigned* census = barcnt + 64;
        int xcc = 0, slot = 0;
        if (threadIdx.x == 0) { xcc = (int)(__builtin_amdgcn_s_getreg((3 << 11) | 20) & 0xFu) & 7; slot = (int)__hip_atomic_fetch_add(census + 64 * xcc, 1u, __ATOMIC_RELAXED, __HIP_MEMORY_SCOPE_AGENT); }
        ++nbar; grid_barrier(barcnt, nbar * gridDim.x);
        if (threadIdx.x == 0) { bool ok = (gridDim.x & 7) == 0;
            for (int j = 0; j < 8; ++j) ok = ok && (__hip_atomic_load(census + 64 * j, __ATOMIC_RELAXED, __HIP_MEMORY_SCOPE_AGENT) == gridDim.x / 8);
            vslot[0] = ok ? slot * 8 + xcc : (int)blockIdx.x; }
        __syncthreads();
    } else { if (threadIdx.x == 0) *(LAS int*)(ldsl + LDS_BYTES) = (int)blockIdx.x; __syncthreads(); }
    for (int ph = ph_lo; ph < ph_hi; ++ph) {
        const Params* pp = (const Params*)__builtin_amdgcn_kernarg_segment_ptr(); asm volatile("" : "+s"(pp));
        const Params& p = *pp;
        int type = T_GEMM, sync = 1, layer = 0, stage = 0, nrows = MALL, npart = 1; const bf16_t* Y = T1;
        GemmP g; g.A = H; g.Bt = W; g.lda = 1024; g.ldb = 1024; g.K = 1024; g.nM = 144; g.nN = 4; g.a_pn_off = 0; g.ksplit = 1; g.a_tiled = 0; g.rev = 0; g.magicN = 16384;
        EpiP e; e.O = T1; e.ldo = 1024; e.mode = 0; e.colscale = nullptr; e.rope = rope; e.Opart = (bf16_t*)(wsb + WS_SCR);
        switch (ph) {
        case 0: type = T_PREP; break;
        case 1: type = T_POOLD; break;
        case 2: g.Bt = W + W_POOL; g.ldb = 256; g.K = 256; g.a_pn_off = 256; e.colscale = p.pool_scale; break;
        case 3: type = T_RN; layer = 0; stage = 0; Y = T1; break;
        case 4: case 11: case 21: case 28: { const int l = ph == 4 ? 0 : ph == 11 ? 1 : ph == 21 ? 2 : 3;
            g.Bt = W + W_FFN + (size_t)l * 8388608; g.nN = 16; g.magicN = 4096; g.nM = l == 3 ? 128 : 144; e.ldo = 4096; e.mode = 1; } break;
        case 5: case 12: case 22: case 29: { const int l = ph == 5 ? 0 : ph == 12 ? 1 : ph == 22 ? 2 : 3;
            g.A = T1; g.lda = 4096; g.Bt = W + W_FFN + (size_t)l * 8388608 + 4194304; g.ldb = 4096; g.K = 4096; g.nM = l == 3 ? 128 : 144; g.ksplit = l == 3 ? 1 : 4; g.a_tiled = 1; e.O = H; } break;
        case 6: type = T_RN; layer = 0; stage = 1; Y = H; npart = 4; break;
        case 7: g.Bt = W + W_CIN; g.nN = 12; g.magicN = 5462; e.ldo = 3072; break;
        case 8: type = T_CONV; break;
        case 9: g.Bt = W + W_COUT; g.ksplit = 4; break;
        case 10: type = T_RN; layer = 1; stage = 0; Y = T1; npart = 4; break;
        case 13: type = T_RN; layer = 1; stage = 1; Y = H; npart = 4; break;
        case 14: g.Bt = W + W_DOWN; g.nN = 3; g.magicN = 21846; e.O = T1 + T_AB; e.ldo = 768; break;
        case 15: type = T_MLAPREP; break;
        case 16: g.A = T1 + T_CQ; g.lda = 384; g.Bt = W + W_UQ; g.ldb = 384; g.K = 384; g.nN = 6; g.magicN = 10923; e.O = T1 + T_Q; e.ldo = 1536; e.mode = 3; break;
        case 17: sync = 0; g.rev = 1; g.A = H; g.lda = 256; g.Bt = W + W_UKV; g.ldb = 256; g.K = 256; g.nN = 8; g.magicN = 8192; e.O = T1 + T_KV; e.ldo = 2048; break;
        case 18: type = T_ATTN_MLA; break;
        case 19: g.Bt = W + W_MO; g.ksplit = 4; break;
        case 20: type = T_RN; layer = 2; stage = 0; Y = T1; npart = 4; break;
        case 23: type = T_RN; layer = 2; stage = 1; Y = H; npart = 4; break;
        case 24: g.Bt = W + W_DQKV; g.nN = 12; g.magicN = 5462; e.ldo = 3072; e.mode = 2; break;
        case 25: type = T_ATTN_DIFF; break;
        case 26: g.Bt = W + W_DO; g.nM = 128; break;
        case 27: type = T_RN; layer = 3; stage = 0; Y = T1; nrows = MLAT; break;
        case 30: type = T_RN; layer = 3; stage = 1; Y = H; nrows = MLAT; break;
        default: break;
        }
        if (ph > ph_lo && sync) { if (ph_hi > N_PHASES) cg::this_grid().sync(); else { ++nbar; grid_barrier(barcnt, nbar * gridDim.x); } }
#ifdef REPEAT_MASK
        for (int rep_ = 0; rep_ < (((REPEAT_MASK) >> ph) & 1 ? 2 : 1); ++rep_) {
        if (rep_) cg::this_grid().sync();
#endif
        switch (type) {
#ifndef PH_MASK
#define PH_MASK 0xff
#endif
#if PH_MASK & 1
        case T_PREP: phase_prep(p, ldsg); break;
#endif
#if PH_MASK & 2
        case T_POOLD: phase_poold(p); break;
#endif
#if PH_MASK & 4
        case T_GEMM: gemm_phase(ldsl, g, e); break;
#endif
#if PH_MASK & 8
        case T_RN: phase_rn(p, layer, stage, Y, nrows, npart); break;
#endif
#if PH_MASK & 16
        case T_CONV: phase_conv(p); break;
#endif
#if PH_MASK & 32
        case T_MLAPREP: phase_mlaprep(p); break;
#endif
#if PH_MASK & 64
        case T_ATTN_MLA: phase_attn_mla(p, ldsg); break;
#endif
#if PH_MASK & 128
        case T_ATTN_DIFF: phase_attn_diff(p, ldsg); break;
#endif
        }
#ifdef REPEAT_MASK
        }
#endif
    }
}

extern "C" void kernel_launch(void* const* d_in, const int* in_sizes, int n_in, void* d_out, int out_size, void* d_ws, size_t ws_size, hipStream_t stream) {
    static int grid = 0;
    if (grid == 0) {
        if (n_in != 24 || out_size != MLAT * DM || ws_size < WS_END) { fprintf(stderr, "kernel_launch: unexpected shapes (n_in %d out %d ws %zu need %zu)\n", n_in, out_size, ws_size, (size_t)WS_END); grid = -1; return; }
        if (hipFuncSetAttribute((const void*)mk_fwd, hipFuncAttributeMaxDynamicSharedMemorySize, LDS_BYTES + 16) != hipSuccess) { fprintf(stderr, "kernel_launch: hipFuncSetAttribute failed\n"); grid = -1; return; }
        int dev = 0, cus = 0, per_cu = 0;
        (void)hipGetDevice(&dev); (void)hipDeviceGetAttribute(&cus, hipDeviceAttributeMultiprocessorCount, dev);
        (void)hipOccupancyMaxActiveBlocksPerMultiprocessor(&per_cu, (const void*)mk_fwd, NTHREADS, LDS_BYTES + 16);
        if (per_cu < 1) { fprintf(stderr, "kernel_launch: occupancy query says %d blocks per CU\n", per_cu); per_cu = 1; }
        (void)hipGetLastError();
        grid = cus * 1;
        if (grid > 256) grid = 256;
    }
    if (grid < 0) return;
    Params p{};
    const float** pp = (const float**)&p;
    for (int i = 0; i < 24; ++i) pp[i] = (const float*)d_in[i];
    p.out = (float*)d_out; p.ws = (unsigned char*)d_ws;
#if MK_ONE_LAUNCH
    (void)hipMemsetAsync((char*)d_ws + WS_BAR, 0, 256 + 8 * 256, stream);
    p.ph_lo = 0; p.ph_hi = N_PHASES;
    void* args[] = {&p};
    hipError_t e = hipLaunchCooperativeKernel((const void*)mk_fwd, dim3(grid), dim3(NTHREADS), args, LDS_BYTES + 16, stream);
    if (e != hipSuccess) fprintf(stderr, "cooperative launch failed: %s (grid %d)\n", hipGetErrorString(e), grid);
#else
    for (int ph = 0; ph < N_PHASES; ++ph) {
        p.ph_lo = ph; p.ph_hi = ph + 1;
        hipLaunchKernelGGL(mk_fwd, dim3(grid), dim3(NTHREADS), LDS_BYTES + 16, stream, p);
    }
#endif
}
```

```cpp
#include <hip/hip_runtime.h>
#include <hip/hip_cooperative_groups.h>
#include <cstdio>
#include <cstdint>
namespace cg = cooperative_groups;

#ifndef MK_ONE_LAUNCH
#define MK_ONE_LAUNCH 1
#endif

#define LAS __attribute__((address_space(3)))
typedef unsigned short bf16_t;
typedef short bf16x8 __attribute__((ext_vector_type(8)));
typedef short s16x4 __attribute__((ext_vector_type(4)));
typedef float f32x4 __attribute__((ext_vector_type(4)));
typedef float f32x16 __attribute__((ext_vector_type(16)));
typedef unsigned u32x4 __attribute__((ext_vector_type(4)));
typedef unsigned u32x2 __attribute__((ext_vector_type(2)));

constexpr int DM = 1024, NB = 16, SEQ = 2048, CTXL = 256, MLAT = NB * SEQ, MCTX = NB * CTXL, MALL = MLAT + MCTX;
constexpr float EPS = 1e-6f;
constexpr int NTHREADS = 512;
#ifndef MLA_NQL
#define MLA_NQL 4
#endif
constexpr int LDS_BYTES = (32768 + 49152 + 2048 + MLA_NQL * 8192) > 131072 ? (32768 + 49152 + 2048 + MLA_NQL * 8192) : 131072;

constexpr size_t WS_XC = 0;
constexpr size_t WS_H = WS_XC + (size_t)MCTX * DM * 4;
constexpr size_t WS_T1 = WS_H + (size_t)MALL * DM * 2;
constexpr size_t WS_W = WS_T1 + (size_t)MALL * 4096 * 2;
constexpr size_t W_ELTS = 45154304;
constexpr size_t WS_MOD = WS_W + W_ELTS * 2;
constexpr size_t WS_RS = WS_MOD + (size_t)4 * 17 * 6144 * 4;
constexpr size_t WS_ROPE = WS_RS + (size_t)MALL * 4;
constexpr size_t WS_SCR = WS_ROPE + 8192;
constexpr size_t WS_BAR = WS_SCR + (size_t)256 * 64 * 512 * 4;
constexpr size_t WS_END = WS_BAR + 256;
static_assert(WS_SCR % 256 == 0 && WS_MOD % 256 == 0 && WS_RS % 256 == 0 && WS_ROPE % 256 == 0, "align");
static_assert(WS_END <= 536870912ull, "workspace budget");
constexpr size_t W_FFN = 0;
constexpr size_t W_POOL = 33554432;
constexpr size_t W_CIN = W_POOL + 262144;
constexpr size_t W_COUT = W_CIN + 3145728;
constexpr size_t W_DOWN = W_COUT + 1048576;
constexpr size_t W_UQ = W_DOWN + 786432;
constexpr size_t W_UKV = W_UQ + 589824;
constexpr size_t W_MO = W_UKV + 524288;
constexpr size_t W_DQKV = W_MO + 1048576;
constexpr size_t W_DO = W_DQKV + 3145728;
static_assert(W_DO + 1048576 == W_ELTS, "weights");
constexpr size_t T_Q = 0;
constexpr size_t T_KV = T_Q + (size_t)MALL * 1536;
constexpr size_t T_CQ = T_KV + (size_t)MALL * 2048;
constexpr size_t T_KR = T_CQ + (size_t)MALL * 384;
constexpr size_t T_AB = T_KV;
static_assert(T_KR + (size_t)MALL * 64 <= (size_t)MALL * 4096, "arena");

struct Params {
    const float *x, *c, *ctx, *c_ctx, *ada_w, *ada_b, *norm_g, *ffn_w1, *ffn_w2, *pool_w, *pool_scale, *conv_in_w, *conv_w, *conv_out_w,
        *mla_w_down, *mla_g_q, *mla_g_kv, *mla_w_uq, *mla_w_ukv, *mla_w_o, *diff_w_qkv, *diff_lambda, *diff_g_subln, *diff_w_o;
    float* out; unsigned char* ws; int ph_lo, ph_hi;
};

__device__ __forceinline__ int tid_opaque() { int t = threadIdx.x; asm volatile("" : "+v"(t)); return t; }
__device__ __forceinline__ unsigned cvt_pk_bf16(float lo, float hi) { unsigned r; asm volatile("v_cvt_pk_bf16_f32 %0, %1, %2" : "=v"(r) : "v"(lo), "v"(hi)); return r; }
__device__ __forceinline__ float bf_lo(unsigned w) { return __uint_as_float(w << 16); }
__device__ __forceinline__ float bf_hi(unsigned w) { return __uint_as_float(w & 0xffff0000u); }
__device__ __forceinline__ float wave_sum(float v) {
#pragma unroll
    for (int o = 32; o >= 1; o >>= 1) v += __shfl_xor(v, o);
    return v;
}
__device__ __forceinline__ int modrow(int row) { return row < MLAT ? (row >> 11) : NB; }
__device__ __forceinline__ void load_bf4(const bf16_t* p, float* v) { const u32x2 w = *(const u32x2*)p; v[0] = bf_lo(w.x); v[1] = bf_hi(w.x); v[2] = bf_lo(w.y); v[3] = bf_hi(w.y); }
__device__ __forceinline__ void store_bf4(bf16_t* p, float a, float b, float c, float d) { u32x2 w; w.x = cvt_pk_bf16(a, b); w.y = cvt_pk_bf16(c, d); *(u32x2*)p = w; }

constexpr int BM = 256, BK = 64, HALF = 128, HTB = HALF * BK * 2;
__device__ __forceinline__ int lds_byte(int r, int c) { const int st = (r >> 4) * 2 + (c >> 5), rr = r & 15, cc = c & 31, ob = rr * 64 + cc * 2; return st * 1024 + (ob ^ (((ob >> 9) & 1) << 5)); }
__device__ __forceinline__ void stage_rc(int b, int& R, int& C) { const int st = b / 1024, sb = b % 1024, swz = sb ^ (((sb >> 9) & 1) << 5); R = (st >> 1) * 16 + swz / 64; C = (st & 1) * 32 + (swz % 64) / 2; }

struct Unit { int pm, pn, ks, nt; };
struct GemmP { const bf16_t* A; const bf16_t* Bt; int lda, ldb, K, nM, nN, a_pn_off, ksplit, a_tiled, rev, magicN; };
struct EpiP { bf16_t* O; int ldo; int mode; const float* colscale; const float* rope; bf16_t* Opart; };

__device__ __forceinline__ bool unit_next(const GemmP& g, int i, Unit& u) {
    const int nMf = g.ksplit > 1 ? 128 : g.nM;
    const int nwg = nMf * g.nN; const int L = i * (int)gridDim.x + (g.rev ? (int)gridDim.x - 1 - (int)blockIdx.x : (int)blockIdx.x);
    if (L >= nwg) {
        if (g.ksplit <= 1) return false;
        const int idx = L - nwg; if (idx >= (g.nM - nMf) * 16) return false;
        u.pm = nMf + (idx >> 4); const int r = idx & 15; u.pn = r >> 2; u.ks = r & 3; u.nt = g.K >> 8; return true;
    }
    int wgid = L; { const int q = nwg >> 3, xcd = wgid & 7, off = wgid >> 3; wgid = xcd * q + off; }
    const int w8 = wgid >> 3, gid = (w8 * g.magicN) >> 16, rem = wgid - gid * 8 * g.nN;
    u.pm = gid * 8 + (rem & 7); u.pn = rem >> 3; u.ks = -1; u.nt = g.K >> 6; return true;
}

__device__ __forceinline__ void epi_store(const f32x4 (&acc)[2][2][4][2], const Unit& u, int wr, int wc, int fr, int fq, const EpiP& e) {
    const int row0 = u.pm * BM + wr * 64 + fr;
    if (e.mode < 2) {
        const int col0 = u.pn * BM + wc * 32 + 8 * fq;
#pragma unroll
        for (int bj = 0; bj < 2; ++bj) {
            const int c = col0 + bj * HALF;
            f32x4 cs0 = {1.f, 1.f, 1.f, 1.f}, cs1 = {1.f, 1.f, 1.f, 1.f};
            if (e.mode == 0 && e.colscale) { cs0 = *(const f32x4*)(e.colscale + c); cs1 = *(const f32x4*)(e.colscale + c + 4); }
#pragma unroll
            for (int ai = 0; ai < 2; ++ai)
#pragma unroll
                for (int m = 0; m < 4; ++m) {
                    const int row = row0 + ai * HALF + m * 16;
                    f32x4 v0 = acc[ai][bj][m][0], v1 = acc[ai][bj][m][1];
                    if (e.mode == 1) {
#pragma unroll
                        for (int j = 0; j < 4; ++j) { const float a = fmaxf(v0[j], 0.f), b = fmaxf(v1[j], 0.f); v0[j] = a * a; v1[j] = b * b; }
                    } else { v0 *= cs0; v1 *= cs1; }
                    bf16_t* rowp = (u.ks < 0 ? e.O + (size_t)row * e.ldo : e.Opart + ((size_t)u.ks * MCTX + (row - MLAT)) * 1024) + c;
                    if (e.mode == 1)
                        rowp = (bf16_t*)((char*)e.O + ((size_t)(u.pm * 64 + u.pn * 4 + bj * 2 + (wc >> 1))) * 32768 + ai * 16384 + (((wr * 4 + m) * 2 + (wc & 1)) * 1024) + (fr * 4 + fq) * 16);
                    u32x4 w; w.x = cvt_pk_bf16(v0[0], v0[1]); w.y = cvt_pk_bf16(v0[2], v0[3]); w.z = cvt_pk_bf16(v1[0], v1[1]); w.w = cvt_pk_bf16(v1[2], v1[3]);
                    *(u32x4*)rowp = w;
                }
        }
        return;
    }
    const int col0 = u.pn * BM + wc * 32 + 4 * fq;
#pragma unroll
    for (int bj = 0; bj < 2; ++bj) {
        const int c = col0 + bj * HALF;
        int kind = 0;
        if (e.mode == 2) { if (c < 2048) kind = ((c >> 5) & 1) ? 2 : 1; }
        else { const int d = c % 192; if (d >= 128) kind = (d >= 160) ? 2 : 1; }
#pragma unroll
        for (int ai = 0; ai < 2; ++ai)
#pragma unroll
            for (int m = 0; m < 4; ++m) {
                const int row = row0 + ai * HALF + m * 16;
                f32x4 v0 = acc[ai][bj][m][0], v1 = acc[ai][bj][m][1];
                if (kind != 0 && row < MLAT) {
                    const int t = row & (SEQ - 1); const int pos = (kind == 1) ? (t >> 6) : (t & 63);
                    const f32x4 t0 = *(const f32x4*)(e.rope + (pos * 16 + 4 * fq) * 2), t1 = *(const f32x4*)(e.rope + (pos * 16 + 4 * fq) * 2 + 4);
                    const float cs[4] = {t0[0], t0[2], t1[0], t1[2]}, sn[4] = {t0[1], t0[3], t1[1], t1[3]};
#pragma unroll
                    for (int j = 0; j < 4; ++j) { const float x1 = v0[j], x2 = v1[j]; v0[j] = x1 * cs[j] - x2 * sn[j]; v1[j] = x2 * cs[j] + x1 * sn[j]; }
                }
                bf16_t* rowp = e.O + (size_t)row * e.ldo + c;
                u32x2 w0, w1; w0.x = cvt_pk_bf16(v0[0], v0[1]); w0.y = cvt_pk_bf16(v0[2], v0[3]); w1.x = cvt_pk_bf16(v1[0], v1[1]); w1.y = cvt_pk_bf16(v1[2], v1[3]);
                const bool odd = (fq & 1) != 0;
                const unsigned sx = odd ? w0.x : w1.x, sy = odd ? w0.y : w1.y;
                const unsigned rx = (unsigned)__shfl_xor((int)sx, 16), ry = (unsigned)__shfl_xor((int)sy, 16);
                u32x4 w; if (odd) { w.x = rx; w.y = ry; w.z = w1.x; w.w = w1.y; } else { w.x = w0.x; w.y = w0.y; w.z = rx; w.w = ry; }
                *(u32x4*)(rowp + (odd ? 12 : 0)) = w;
            }
    }
}

__device__ __forceinline__ void gemm_phase(LAS unsigned char* lds, const GemmP g, const EpiP e) {
    const int tid = tid_opaque(), wid = __builtin_amdgcn_readfirstlane(tid >> 6), lane = tid & 63, wr = wid >> 2, wc = wid & 3, fr = lane & 15, fq = lane >> 4;
    unsigned voffA[2], voffB[2];
#pragma unroll
    for (int i = 0; i < 2; ++i) { int R, C; stage_rc(tid * 16 + i * 8192, R, C); const int rho = R & 31; const int Rb = (e.mode < 2) ? ((R & ~31) + 8 * ((rho & 15) >> 2) + 4 * (rho >> 4) + (rho & 3)) : R;
        voffA[i] = g.a_tiled ? (unsigned)((((R >> 4) * 2 + (C >> 5)) * 1024) + ((R & 15) * 4 + ((C >> 3) & 3)) * 16) : (unsigned)(R * g.lda + C) * 2u; voffB[i] = (unsigned)(Rb * g.ldb + C) * 2u; }
    const size_t kstepB = (size_t)(BK * 2), kstepA = g.a_tiled ? (size_t)32768 : (size_t)(BK * 2);
    const size_t hstepA = g.a_tiled ? (size_t)16384 : (size_t)HALF * g.lda * 2, hstepB = (size_t)HALF * g.ldb * 2;
    const size_t tstepA = g.a_tiled ? (size_t)(g.K / BK) * 32768 : 2 * hstepA, tstepB = 2 * hstepB;
    const unsigned ldsw = (unsigned)wid * 1024u;
    const int aoff = lds_byte(wr * 64 + fr, fq * 8), boff = lds_byte(wc * 32 + fr, fq * 8);
#define PG8_SA(b, h) (((b) * 2 + (h)) * HTB)
#define PG8_SB(b, h) ((4 + (b) * 2 + (h)) * HTB)
#define PG8_STAGE(bufoff, gbase, voff) do { _Pragma("unroll") for (int _i = 0; _i < 2; ++_i) \
        __builtin_amdgcn_global_load_lds((const unsigned*)((const char*)(gbase) + (voff)[_i]), (LAS unsigned*)(lds + (bufoff) + ldsw + _i * 8192), 16, 0, 0); } while (0)
#define PG8_LDA(dst, b, h) do { _Pragma("unroll") for (int m = 0; m < 4; ++m) _Pragma("unroll") for (int k = 0; k < 2; ++k) dst[m][k] = *(const LAS bf16x8*)(lds + PG8_SA(b, h) + aoff + m * 2048 + k * 1024); } while (0)
#define PG8_LDB(dst, b, h) do { _Pragma("unroll") for (int n = 0; n < 2; ++n) _Pragma("unroll") for (int k = 0; k < 2; ++k) dst[n][k] = *(const LAS bf16x8*)(lds + PG8_SB(b, h) + boff + n * 2048 + k * 1024); } while (0)
#define PG8_MMA(ai, bj, At, Bt) do { __builtin_amdgcn_s_setprio(1); _Pragma("unroll") for (int m = 0; m < 4; ++m) _Pragma("unroll") for (int n = 0; n < 2; ++n) _Pragma("unroll") for (int k = 0; k < 2; ++k) \
        acc[ai][bj][m][n] = __builtin_amdgcn_mfma_f32_16x16x32_bf16(Bt[n][k], At[m][k], acc[ai][bj][m][n], 0, 0, 0); __builtin_amdgcn_s_setprio(0); } while (0)
#define PG8_WAIT_V(n) asm volatile("s_waitcnt vmcnt(" #n ")" ::: "memory")
#define PG8_WAIT_L(n) asm volatile("s_waitcnt lgkmcnt(" #n ")" ::: "memory")
#define PG8_BAR __builtin_amdgcn_s_barrier()
#define PG8_SCHED __builtin_amdgcn_sched_barrier(0)
    Unit cur, nxt; int ui = 0;
    if (!unit_next(g, 0, cur)) return;
    f32x4 acc[2][2][4][2];
#pragma unroll
    for (int a = 0; a < 2; ++a)
#pragma unroll
        for (int b = 0; b < 2; ++b)
#pragma unroll
            for (int m = 0; m < 4; ++m)
#pragma unroll
                for (int n = 0; n < 2; ++n) acc[a][b][m][n] = (f32x4){0.f, 0.f, 0.f, 0.f};
    bf16x8 At[4][2], B0[2][2], B1[2][2];
    const size_t ksliceB = (size_t)(g.ksplit > 1 ? g.K / g.ksplit : 0) * 2;
    const size_t ksliceA = g.a_tiled ? (size_t)(g.ksplit > 1 ? g.K / g.ksplit / BK : 0) * 32768 : ksliceB;
#define UNIT_A(u_) ((const char*)g.A + (size_t)(u_).pm * tstepA + (size_t)(u_).pn * g.a_pn_off * 2 + ((u_).ks > 0 ? (u_).ks * ksliceA : 0))
#define UNIT_B(u_) ((const char*)g.Bt + (size_t)(u_).pn * tstepB + ((u_).ks > 0 ? (u_).ks * ksliceB : 0))
    const char* cA = UNIT_A(cur); const char* cB = UNIT_B(cur);
    PG8_STAGE(PG8_SB(0, 0), cB, voffB); PG8_STAGE(PG8_SB(0, 1), cB + hstepB, voffB); PG8_STAGE(PG8_SA(0, 0), cA, voffA); PG8_STAGE(PG8_SA(0, 1), cA + hstepA, voffA);
    if (wr == 1) PG8_BAR;
    PG8_WAIT_V(2); PG8_BAR;
    PG8_STAGE(PG8_SB(1, 0), cB + kstepB, voffB); PG8_STAGE(PG8_SA(1, 0), cA + kstepA, voffA); PG8_STAGE(PG8_SB(1, 1), cB + hstepB + kstepB, voffB);
    PG8_WAIT_V(6); PG8_BAR;
    for (;;) {
        const bool has_next = unit_next(g, ui + 1, nxt);
        const char* nA = has_next ? UNIT_A(nxt) : cA; const char* nB = has_next ? UNIT_B(nxt) : cB;
        const int nt = cur.nt;
        for (int t = 0; t < nt; t += 2) {
            const bool last = (t == nt - 2);
            const char* a1 = cA + (size_t)(t + 1) * kstepA;
            const char* a2 = last ? nA : cA + (size_t)(t + 2) * kstepA; const char* b2 = last ? nB : cB + (size_t)(t + 2) * kstepB;
            const char* a3 = a2 + kstepA; const char* b3 = b2 + kstepB;
            PG8_LDB(B0, 0, 0); PG8_LDB(B1, 0, 1); PG8_SCHED; PG8_LDA(At, 0, 0); PG8_STAGE(PG8_SA(1, 1), a1 + hstepA, voffA);
            PG8_WAIT_V(8); PG8_WAIT_L(0); PG8_BAR; PG8_MMA(0, 0, At, B0); PG8_MMA(0, 1, At, B1); PG8_BAR; PG8_SCHED;
            PG8_LDA(At, 0, 1); PG8_STAGE(PG8_SB(0, 0), b2, voffB); PG8_STAGE(PG8_SB(0, 1), b2 + hstepB, voffB); PG8_STAGE(PG8_SA(0, 0), a2, voffA);
            PG8_WAIT_V(8); PG8_WAIT_L(0); PG8_BAR; PG8_MMA(1, 0, At, B0); PG8_MMA(1, 1, At, B1); PG8_BAR; PG8_SCHED;
            PG8_LDB(B0, 1, 0); PG8_LDB(B1, 1, 1); PG8_SCHED; PG8_LDA(At, 1, 0); PG8_STAGE(PG8_SA(0, 1), a2 + hstepA, voffA);
            PG8_WAIT_V(8); PG8_WAIT_L(0); PG8_BAR; PG8_MMA(0, 0, At, B0); PG8_MMA(0, 1, At, B1); PG8_BAR; PG8_SCHED;
            PG8_LDA(At, 1, 1); PG8_STAGE(PG8_SB(1, 0), b3, voffB); PG8_STAGE(PG8_SB(1, 1), b3 + hstepB, voffB); PG8_STAGE(PG8_SA(1, 0), a3, voffA);
            PG8_WAIT_V(8); PG8_WAIT_L(0); PG8_BAR; PG8_MMA(1, 0, At, B0); PG8_MMA(1, 1, At, B1); PG8_BAR; PG8_SCHED;
        }
        if (wr == 0) PG8_BAR;
        epi_store(acc, cur, wr, wc, fr, fq, e);
        if (!has_next) break;
#pragma unroll
        for (int a = 0; a < 2; ++a)
#pragma unroll
            for (int b = 0; b < 2; ++b)
#pragma unroll
                for (int m = 0; m < 4; ++m)
#pragma unroll
                    for (int n = 0; n < 2; ++n) acc[a][b][m][n] = (f32x4){0.f, 0.f, 0.f, 0.f};
        cur = nxt; cA = nA; cB = nB; ++ui;
        if (wr == 1) PG8_BAR;
    }
    PG8_WAIT_V(0);
    PG8_BAR;
#undef UNIT_A
#undef UNIT_B
#undef PG8_SA
#undef PG8_SB
#undef PG8_STAGE
#undef PG8_LDA
#undef PG8_LDB
#undef PG8_MMA
#undef PG8_WAIT_V
#undef PG8_WAIT_L
#undef PG8_BAR
#undef PG8_SCHED
}

#define SBAR() __builtin_amdgcn_sched_barrier(0)
__device__ __forceinline__ int crow(int r, int hi) { return (r & 3) + 8 * (r >> 2) + 4 * hi; }
__device__ __forceinline__ int v_st(int k, int c) { const int kk = (k & ~0xC) | ((k & 4) << 1) | ((k & 8) >> 1); return ((kk >> 3) * 4 + (c >> 5)) * 512 + ((kk & 7) * 32 + (c & 31)) * 2; }
__device__ __forceinline__ int v_rd_base(int lane) { return ((lane & 3) << 3) | (((lane >> 2) & 3) << 6) | (((lane >> 4) & 1) << 5) | (((lane >> 5) & 1) << 8); }
constexpr int v_rd_off(int d0, int ks, int half) { return d0 * 512 + ks * 4096 + half * 2048; }
template <int OFF> __device__ __forceinline__ s16x4 tr_read(int vb) { s16x4 r; asm volatile("ds_read_b64_tr_b16 %0, %1 offset:%2" : "=&v"(r) : "v"(vb), "i"(OFF) : "memory"); return r; }
template <int D0> __device__ __forceinline__ void pv_one(f32x16& od, int vb, bf16x8 pa0, bf16x8 pa1, bf16x8 pa2, bf16x8 pa3) {
    const s16x4 l0 = tr_read<v_rd_off(D0, 0, 0)>(vb), h0 = tr_read<v_rd_off(D0, 0, 1)>(vb), l1 = tr_read<v_rd_off(D0, 1, 0)>(vb), h1 = tr_read<v_rd_off(D0, 1, 1)>(vb);
    const s16x4 l2 = tr_read<v_rd_off(D0, 2, 0)>(vb), h2 = tr_read<v_rd_off(D0, 2, 1)>(vb), l3 = tr_read<v_rd_off(D0, 3, 0)>(vb), h3 = tr_read<v_rd_off(D0, 3, 1)>(vb);
    asm volatile("s_waitcnt lgkmcnt(0)" ::: "memory"); SBAR();
#define PK(L, H) (bf16x8){L[0], L[1], L[2], L[3], H[0], H[1], H[2], H[3]}
    od = __builtin_amdgcn_mfma_f32_32x32x16_bf16(pa0, PK(l0, h0), od, 0, 0, 0);
    od = __builtin_amdgcn_mfma_f32_32x32x16_bf16(pa1, PK(l1, h1), od, 0, 0, 0);
    od = __builtin_amdgcn_mfma_f32_32x32x16_bf16(pa2, PK(l2, h2), od, 0, 0, 0);
    od = __builtin_amdgcn_mfma_f32_32x32x16_bf16(pa3, PK(l3, h3), od, 0, 0, 0);
#undef PK
}
__device__ __forceinline__ void pv_d0(f32x16* o, int vb, bf16x8 pa0, bf16x8 pa1, bf16x8 pa2, bf16x8 pa3) {
    pv_one<0>(o[0], vb, pa0, pa1, pa2, pa3); pv_one<1>(o[1], vb, pa0, pa1, pa2, pa3); pv_one<2>(o[2], vb, pa0, pa1, pa2, pa3); pv_one<3>(o[3], vb, pa0, pa1, pa2, pa3);
}
__device__ __forceinline__ void partialSM(f32x16& p0, f32x16& p1, float& m_reg, float& mn, float& alpha, const float C, const float thr) {
    float pmax = p0[0];
#pragma unroll
    for (int r = 1; r < 16; ++r) pmax = fmaxf(pmax, p0[r]);
#pragma unroll
    for (int r = 0; r < 16; ++r) pmax = fmaxf(pmax, p1[r]);
    { auto rr = __builtin_amdgcn_permlane32_swap(__float_as_uint(pmax), __float_as_uint(pmax), false, false);
      pmax = fmaxf(__uint_as_float(rr[0]), __uint_as_float(rr[1])); }
    if (__builtin_expect(__all(pmax - m_reg <= thr), 1)) { mn = m_reg; alpha = 1.f; }
    else { mn = fmaxf(m_reg, pmax); alpha = __builtin_amdgcn_exp2f((m_reg - mn) * C); m_reg = mn; }
    const float mnC = -mn * C;
#pragma unroll
    for (int r = 0; r < 16; ++r) p0[r] = fmaf(p0[r], C, mnC);
#pragma unroll
    for (int r = 0; r < 16; ++r) p1[r] = fmaf(p1[r], C, mnC);
#pragma unroll
    for (int r = 0; r < 16; ++r) p0[r] = __builtin_amdgcn_exp2f(p0[r]);
}
__device__ __forceinline__ void finishSM(f32x16& p0, f32x16& p1, float alpha, float& l_reg, bf16x8& pa0, bf16x8& pa1, bf16x8& pa2, bf16x8& pa3) {
#pragma unroll
    for (int r = 0; r < 16; ++r) p1[r] = __builtin_amdgcn_exp2f(p1[r]);
    float ps = 0;
#pragma unroll
    for (int r = 0; r < 16; ++r) ps += p0[r];
#pragma unroll
    for (int r = 0; r < 16; ++r) ps += p1[r];
    { auto rr = __builtin_amdgcn_permlane32_swap(__float_as_uint(ps), __float_as_uint(ps), false, false);
      ps = __uint_as_float(rr[0]) + __uint_as_float(rr[1]); }
    l_reg = l_reg * alpha + ps;
#define PK4(P, BASE, OUT) do { unsigned a0 = cvt_pk_bf16(P[BASE + 0], P[BASE + 1]), a1 = cvt_pk_bf16(P[BASE + 2], P[BASE + 3]);   \
    unsigned b0 = cvt_pk_bf16(P[BASE + 4], P[BASE + 5]), b1 = cvt_pk_bf16(P[BASE + 6], P[BASE + 7]);                              \
    auto r0 = __builtin_amdgcn_permlane32_swap(a0, b0, false, false); auto r1 = __builtin_amdgcn_permlane32_swap(a1, b1, false, false); \
    u32x4 w = {r0[0], r1[0], r0[1], r1[1]}; OUT = *reinterpret_cast<bf16x8*>(&w); } while (0)
    PK4(p0, 0, pa0); PK4(p0, 8, pa1); PK4(p1, 0, pa2); PK4(p1, 8, pa3);
#undef PK4
}

struct AttnArgs {
    const bf16_t* Q; int ldq;
    const bf16_t* Kn; int ldk;
    const bf16_t* Kr; int ldkr;
    const bf16_t* V; int ldv;
    int lat0, ctx0, nlat, NT;
    float C, thr;
};

template <int DQK, int DK1, int LDQ, int LDK, int LDKR, int LDV, int NQL, int SDEPTH>
__device__ __forceinline__ void attn_core(const AttnArgs& a, char* lds, f32x16 (&o)[4]) {
    constexpr int KP = DQK * 2, SHM_K = 64 * KP, SHM_V = 64 * 128 * 2, KCH = DQK / 64, CPR = DQK / 8, ND0 = DQK / 16;
    const int tid = tid_opaque(), wid = tid >> 6, lane = tid & 63, r32 = lane & 31, hi = lane >> 5;
    char* V_lds = lds; char* K_lds = lds + 2 * SHM_V;
    float* wsf = (float*)(lds + 2 * SHM_V + 2 * SHM_K) + wid * 64; float* li_l = wsf; float* al_l = wsf + 32;
    float m_reg = -1e30f, l_reg = 0.f;
#pragma unroll
    for (int d = 0; d < 4; ++d)
#pragma unroll
        for (int r = 0; r < 16; ++r) o[d][r] = 0.f;
    constexpr int NQR = ND0 - NQL;
    bf16x8 qr[NQR];
    char* QL = lds + 2 * SHM_V + 2 * SHM_K + 2048 + tid * 16;
    { const bf16_t* Qw = a.Q + (long)(wid * 32 + r32) * LDQ + hi * 8;
#pragma unroll
      for (int d0 = 0; d0 < NQR; ++d0) qr[d0] = *(const bf16x8*)(Qw + d0 * 16);
#pragma unroll
      for (int d0 = NQR; d0 < ND0; ++d0) *(bf16x8*)(QL + (d0 - NQR) * 8192) = *(const bf16x8*)(Qw + d0 * 16); }
    const int sr = tid >> 4, sc = (tid & 15) * 8, vst0 = v_st(sr, sc), vst1 = v_st(32 + sr, sc);
    const int vb0 = (int)(uintptr_t)V_lds + v_rd_base(lane);
    const bf16_t* kptr[KCH]; int kld[KCH], kwo[KCH];
#pragma unroll
    for (int c = 0; c < KCH; ++c) { const int idx = tid + c * 512, kr_ = idx / CPR, kc = (idx % CPR) * 8;
        if (kc < DK1) { kptr[c] = a.Kn + (long)kr_ * LDK + kc; kld[c] = LDK; } else { kptr[c] = a.Kr + (long)kr_ * LDKR + (kc - DK1); kld[c] = LDKR; }
        kwo[c] = kr_ * KP + ((kc * 2) ^ ((kr_ & 7) << 4)); }
    struct { bf16x8 vs0, vs1, ks[KCH]; } sr_[SDEPTH];
    int kb[4];
#pragma unroll
    for (int m = 0; m < 4; ++m) kb[m] = r32 * KP + ((m * 32 + hi * 16) ^ ((r32 & 7) << 4));
#define KROW(j) ((j) < a.nlat ? a.lat0 + 64 * (j) : a.ctx0 + 64 * ((j) - a.nlat))
#define SLOAD(i, j) do { const long rb_ = KROW(j); sr_[i].vs0 = *(const bf16x8*)(a.V + (rb_ + sr) * LDV + sc); sr_[i].vs1 = *(const bf16x8*)(a.V + (rb_ + 32 + sr) * LDV + sc); \
    _Pragma("unroll") for (int c_ = 0; c_ < KCH; ++c_) sr_[i].ks[c_] = *(const bf16x8*)(kptr[c_] + rb_ * kld[c_]); } while (0)
#define SWRITE(b, i) do { *(bf16x8*)(V_lds + (b) * SHM_V + vst0) = sr_[i].vs0; *(bf16x8*)(V_lds + (b) * SHM_V + vst1) = sr_[i].vs1; \
    _Pragma("unroll") for (int c_ = 0; c_ < KCH; ++c_) *(bf16x8*)(K_lds + (b) * SHM_K + kwo[c_]) = sr_[i].ks[c_]; } while (0)
#define RESC(al) do { if (__any((al) < 1.f)) { if (hi == 0) al_l[r32] = (al); asm volatile("s_waitcnt lgkmcnt(0)" ::: "memory"); \
    _Pragma("unroll") for (int d = 0; d < 4; ++d) _Pragma("unroll") for (int r = 0; r < 16; ++r) o[d][r] *= al_l[crow(r, hi)]; } } while (0)
#define QKT(P0, P1, KB) do { P0 = f32x16{}; P1 = f32x16{}; \
    _Pragma("unroll") for (int d0 = 0; d0 < ND0; ++d0) { \
      const bf16x8 b0 = *(const bf16x8*)((KB) + kb[d0 & 3] + (d0 >> 2) * 128); \
      const bf16x8 b1 = *(const bf16x8*)((KB) + kb[d0 & 3] + (d0 >> 2) * 128 + 32 * KP); \
      const bf16x8 qf = (d0 < NQR) ? qr[d0 < NQR ? d0 : 0] : *(const bf16x8*)(QL + (d0 - NQR) * 8192); \
      P0 = __builtin_amdgcn_mfma_f32_32x32x16_bf16(b0, qf, P0, 0, 0, 0); \
      P1 = __builtin_amdgcn_mfma_f32_32x32x16_bf16(b1, qf, P1, 0, 0, 0); } } while (0)
    f32x16 pA0, pA1, pB0, pB1; float mnA, mnB, alA, alB; bf16x8 pa0, pa1, pa2, pa3; const int NT = a.NT;
    constexpr int SE = 0, SO = SDEPTH - 1;
    SLOAD(SE, 0); asm volatile("s_waitcnt vmcnt(0)" ::: "memory"); SWRITE(0, SE); __syncthreads();
    QKT(pA0, pA1, K_lds); partialSM(pA0, pA1, m_reg, mnA, alA, a.C, a.thr);
    SLOAD(SO, 1); if (SDEPTH == 2 && 2 < NT) SLOAD(SE, 2);
    SWRITE(1, SO); __syncthreads();
    for (int j = 1; j + 1 < NT; j += 2) {
        SBAR(); QKT(pB0, pB1, K_lds + SHM_K);
        finishSM(pA0, pA1, alA, l_reg, pa0, pa1, pa2, pa3); SBAR();
        SLOAD(SO, j + SDEPTH); SBAR();
        pv_d0(o, vb0, pa0, pa1, pa2, pa3); partialSM(pB0, pB1, m_reg, mnB, alB, a.C, a.thr);
        __syncthreads(); SWRITE(0, SE);
        RESC(alB); __syncthreads();
        SBAR(); QKT(pA0, pA1, K_lds);
        finishSM(pB0, pB1, alB, l_reg, pa0, pa1, pa2, pa3); SBAR();
        if (SDEPTH == 1 || j + 3 < NT) SLOAD(SE, j + 1 + SDEPTH); SBAR();
        pv_d0(o, vb0 + SHM_V, pa0, pa1, pa2, pa3); partialSM(pA0, pA1, m_reg, mnA, alA, a.C, a.thr);
        __syncthreads(); SWRITE(1, SO);
        RESC(alA); __syncthreads();
    }
    SBAR(); QKT(pB0, pB1, K_lds + SHM_K);
    finishSM(pA0, pA1, alA, l_reg, pa0, pa1, pa2, pa3); SBAR();
    pv_d0(o, vb0, pa0, pa1, pa2, pa3); partialSM(pB0, pB1, m_reg, mnB, alB, a.C, a.thr);
    __syncthreads(); RESC(alB);
    finishSM(pB0, pB1, alB, l_reg, pa0, pa1, pa2, pa3); SBAR();
    pv_d0(o, vb0 + SHM_V, pa0, pa1, pa2, pa3);
    if (hi == 0) li_l[r32] = l_reg; asm volatile("s_waitcnt lgkmcnt(0)" ::: "memory");
#pragma unroll
    for (int r = 0; r < 16; ++r) { const float rl = __builtin_amdgcn_rcpf(li_l[crow(r, hi)]);
#pragma unroll
        for (int d = 0; d < 4; ++d) o[d][r] *= rl; }
    __syncthreads();
#undef KROW
#undef SLOAD
#undef SWRITE
#undef RESC
#undef QKT
}

__device__ __forceinline__ void phase_attn_mla(const Params& p, char* lds) {
    const bf16_t* T1 = (const bf16_t*)(p.ws + WS_T1); bf16_t* O = (bf16_t*)(p.ws + WS_H);
    const int tid = tid_opaque(), wid = tid >> 6, lane = tid & 63, r32 = lane & 31, hi = lane >> 5;
    const float scale = 0.07216878364870322f;
    for (int it = blockIdx.x; it < 1024 + 128; it += gridDim.x) {
        int b, h, row0; AttnArgs a;
        if (it < 1024) {
            int itm = it;
            if (gridDim.x == 256) { const int w = it & 255, rnd = it >> 8, xcd = w & 7, slot = w >> 3; itm = ((rnd * 32 + xcd * 4 + (slot >> 3)) << 3) | (slot & 7); }
            b = itm >> 6; h = (itm >> 3) & 7; const int qb = itm & 7; row0 = b * SEQ + qb * 256; a.nlat = 32; a.NT = 36; }
        else { const int i2 = it - 1024; b = i2 >> 3; h = i2 & 7; row0 = MLAT + b * CTXL; a.nlat = 0; a.NT = 4; }
        a.lat0 = b * SEQ; a.ctx0 = MLAT + b * CTXL;
        a.Q = T1 + T_Q + (size_t)row0 * 1536 + h * 192; a.ldq = 1536;
        a.Kn = T1 + T_KV + h * 256; a.ldk = 2048; a.Kr = T1 + T_KR; a.ldkr = 64;
        a.V = T1 + T_KV + h * 256 + 128; a.ldv = 2048;
        a.C = scale * 1.4426950408889634f; a.thr = 8.f / scale;
        f32x16 o[4];
        attn_core<192, 128, 1536, 2048, 64, 2048, MLA_NQL, 1>(a, lds, o);
        bf16_t* Ow = O + (size_t)(row0 + wid * 32 + 4 * hi) * 1024 + h * 128 + r32;
        asm volatile("" : "+v"(Ow));
#pragma unroll
        for (int r = 0; r < 16; ++r) { bf16_t* Or = Ow + (size_t)((r & 3) + 8 * (r >> 2)) * 1024;
#pragma unroll
            for (int d0 = 0; d0 < 4; ++d0) Or[d0 * 32] = (bf16_t)(cvt_pk_bf16(o[d0][r], 0.f) & 0xffffu); }
    }
}

__device__ __forceinline__ void phase_attn_diff(const Params& p, char* lds) {
    const bf16_t* T1 = (const bf16_t*)(p.ws + WS_T1); bf16_t* O = (bf16_t*)(p.ws + WS_H);
    const int tid = tid_opaque(), wid = tid >> 6, lane = tid & 63, r32 = lane & 31, hi = lane >> 5;
    float* scr0 = (float*)(p.ws + WS_SCR) + ((size_t)blockIdx.x * 512 + tid) * 64;
    const float scale = 0.125f;
    const float lam_init = 0.8f - 0.6f * 0.40656965974059917f;
    float lam;
    { const float* lv = p.diff_lambda; float s1 = 0.f, s2 = 0.f;
      for (int k = 0; k < 64; ++k) { s1 += lv[k] * lv[64 + k]; s2 += lv[128 + k] * lv[192 + k]; }
      lam = expf(s1) - expf(s2) + lam_init; }
    float gs[4];
#pragma unroll
    for (int d0 = 0; d0 < 4; ++d0) gs[d0] = p.diff_g_subln[d0 * 32 + r32] * (1.0f - lam_init);
    for (int it = blockIdx.x; it < 1024; it += gridDim.x) {
        int itm = it;
        if (gridDim.x == 256) { const int w = it & 255, rnd = it >> 8, xcd = w & 7, slot = w >> 3; itm = ((rnd * 32 + xcd * 4 + (slot >> 3)) << 3) | (slot & 7); }
        const int b = itm >> 6, h = (itm >> 3) & 7, qb = itm & 7, row0 = b * SEQ + qb * 256;
#pragma unroll 1
        for (int j = 0; j < 2; ++j) {
            AttnArgs a; a.nlat = 32; a.NT = 36; a.lat0 = b * SEQ; a.ctx0 = MLAT + b * CTXL;
            a.Q = T1 + (size_t)row0 * 3072 + h * 128 + j * 64; a.ldq = 3072;
            a.Kn = T1 + 1024 + h * 128 + j * 64; a.ldk = 3072; a.Kr = a.Kn; a.ldkr = 3072;
            a.V = T1 + 2048 + h * 128; a.ldv = 3072;
            a.C = scale * 1.4426950408889634f; a.thr = 8.f / scale;
            f32x16 o[4];
            attn_core<64, 64, 3072, 3072, 3072, 3072, 0, 2>(a, lds, o);
            float* scr = scr0; asm volatile("" : "+v"(scr));
            if (j == 0) {
#pragma unroll
                for (int r = 0; r < 16; ++r) { f32x4 t = {o[0][r], o[1][r], o[2][r], o[3][r]}; *(f32x4*)(scr + 4 * r) = t; }
            } else {
                bf16_t* Ow = O + (size_t)(row0 + wid * 32 + 4 * hi) * 1024 + h * 128 + r32;
                asm volatile("" : "+v"(Ow));
#pragma unroll
                for (int r = 0; r < 16; ++r) {
                    const f32x4 t = *(const f32x4*)(scr + 4 * r);
                    const float v0 = t[0] - lam * o[0][r], v1 = t[1] - lam * o[1][r], v2 = t[2] - lam * o[2][r], v3 = t[3] - lam * o[3][r];
                    float ss = v0 * v0 + v1 * v1 + v2 * v2 + v3 * v3;
#pragma unroll
                    for (int x = 16; x >= 1; x >>= 1) ss += __shfl_xor(ss, x);
                    const float rs = rsqrtf(ss * (1.0f / 128.0f) + EPS);
                    bf16_t* Or = Ow + (size_t)((r & 3) + 8 * (r >> 2)) * 1024;
                    Or[0] = (bf16_t)(cvt_pk_bf16(v0 * rs * gs[0], 0.f) & 0xffffu); Or[32] = (bf16_t)(cvt_pk_bf16(v1 * rs * gs[1], 0.f) & 0xffffu);
                    Or[64] = (bf16_t)(cvt_pk_bf16(v2 * rs * gs[2], 0.f) & 0xffffu); Or[96] = (bf16_t)(cvt_pk_bf16(v3 * rs * gs[3], 0.f) & 0xffffu);
                }
            }
        }
    }
}

__device__ __forceinline__ const float* xin_row(const Params& p, int row, bool from_input) {
    if (from_input) return row < MLAT ? p.x + (size_t)row * DM : p.ctx + (size_t)(row - MLAT) * DM;
    return row < MLAT ? p.out + (size_t)row * DM : (const float*)(p.ws + WS_XC) + (size_t)(row - MLAT) * DM;
}
__device__ __forceinline__ float* xout_row(const Params& p, int row) {
    return row < MLAT ? p.out + (size_t)row * DM : (float*)(p.ws + WS_XC) + (size_t)(row - MLAT) * DM;
}

__device__ __forceinline__ void phase_rn(const Params& p, int layer, int stage, const bf16_t* Y, int nrows, int npart) {
    const int tid = tid_opaque(), wid = tid >> 6, lane = tid & 63;
    const float* MOD = (const float*)(p.ws + WS_MOD); bf16_t* H = (bf16_t*)(p.ws + WS_H);
    const int gate_c = stage == 0 ? 2 : 5;
    const float* gA = p.norm_g + (layer * 4 + (stage == 0 ? 1 : 3)) * DM;
    const bool has_next = !(layer == 3 && stage == 1);
    const int nl = stage == 0 ? layer : layer + 1;
    const float* gB = p.norm_g + ((has_next ? nl : 0) * 4 + (stage == 0 ? 2 : 0)) * DM;
    const int sh_c = stage == 0 ? 3 : 0, sc_c = stage == 0 ? 4 : 1;
    const bool from_input = (layer == 0 && stage == 0);
    for (int row = (blockIdx.x * 8 + wid) * 2; row < nrows; row += gridDim.x * 16) {
        const int mr = modrow(row);
        const float* xi = xin_row(p, row, from_input); float* xo = xout_row(p, row);
        const bf16_t* y = Y + (size_t)row * DM;
        const float* mg = MOD + ((size_t)layer * 17 + mr) * 6144 + gate_c * DM;
        u32x2 yw[2][4]; f32x4 xx[2][4], gg[4], gt[4];
#pragma unroll
        for (int q = 0; q < 2; ++q)
#pragma unroll
            for (int i = 0; i < 4; ++i) { yw[q][i] = *(const u32x2*)(y + q * DM + i * 256 + lane * 4); xx[q][i] = *(const f32x4*)(xi + q * DM + i * 256 + lane * 4); }
#pragma unroll
        for (int i = 0; i < 4; ++i) { gg[i] = *(const f32x4*)(gA + i * 256 + lane * 4); gt[i] = *(const f32x4*)(mg + i * 256 + lane * 4); }
        float yv[2][16]; float ss[2] = {0.f, 0.f};
#pragma unroll
        for (int q = 0; q < 2; ++q)
#pragma unroll
            for (int i = 0; i < 4; ++i) { yv[q][4 * i] = bf_lo(yw[q][i].x); yv[q][4 * i + 1] = bf_hi(yw[q][i].x); yv[q][4 * i + 2] = bf_lo(yw[q][i].y); yv[q][4 * i + 3] = bf_hi(yw[q][i].y); }
        if (npart > 1 && row >= MLAT) {
            const bf16_t* yp = (const bf16_t*)(p.ws + WS_SCR) + (size_t)(row - MLAT) * DM;
#pragma unroll
            for (int q = 0; q < 2; ++q)
#pragma unroll
                for (int i = 0; i < 4; ++i) { float a4[4] = {0.f, 0.f, 0.f, 0.f};
                    for (int k = 0; k < npart; ++k) { float t4[4]; load_bf4(yp + (size_t)k * MCTX * DM + q * DM + i * 256 + lane * 4, t4); a4[0] += t4[0]; a4[1] += t4[1]; a4[2] += t4[2]; a4[3] += t4[3]; }
                    yv[q][4 * i] = a4[0]; yv[q][4 * i + 1] = a4[1]; yv[q][4 * i + 2] = a4[2]; yv[q][4 * i + 3] = a4[3]; }
        }
#pragma unroll
        for (int q = 0; q < 2; ++q)
#pragma unroll
            for (int i = 0; i < 16; ++i) ss[q] += yv[q][i] * yv[q][i];
#pragma unroll
        for (int o = 32; o >= 1; o >>= 1) { ss[0] += __shfl_xor(ss[0], o); ss[1] += __shfl_xor(ss[1], o); }
        float ss2[2] = {0.f, 0.f};
#pragma unroll
        for (int q = 0; q < 2; ++q) { const float r1 = rsqrtf(ss[q] * (1.0f / DM) + EPS);
#pragma unroll
            for (int i = 0; i < 4; ++i) { f32x4 xn;
#pragma unroll
                for (int j = 0; j < 4; ++j) { xn[j] = xx[q][i][j] + gt[i][j] * (yv[q][4 * i + j] * r1 * gg[i][j]); ss2[q] += xn[j] * xn[j]; }
                xx[q][i] = xn; *(f32x4*)(xo + q * DM + i * 256 + lane * 4) = xn; } }
        if (has_next) {
            const float* msh = MOD + ((size_t)nl * 17 + mr) * 6144 + sh_c * DM; const float* msc = MOD + ((size_t)nl * 17 + mr) * 6144 + sc_c * DM;
            f32x4 gb[4], sh[4], sc[4];
#pragma unroll
            for (int i = 0; i < 4; ++i) { gb[i] = *(const f32x4*)(gB + i * 256 + lane * 4); sh[i] = *(const f32x4*)(msh + i * 256 + lane * 4); sc[i] = *(const f32x4*)(msc + i * 256 + lane * 4); }
#pragma unroll
            for (int o = 32; o >= 1; o >>= 1) { ss2[0] += __shfl_xor(ss2[0], o); ss2[1] += __shfl_xor(ss2[1], o); }
#pragma unroll
            for (int q = 0; q < 2; ++q) { const float r2 = rsqrtf(ss2[q] * (1.0f / DM) + EPS);
#pragma unroll
                for (int i = 0; i < 4; ++i) { float hv[4];
#pragma unroll
                    for (int j = 0; j < 4; ++j) hv[j] = (xx[q][i][j] * r2 * gb[i][j]) * (1.0f + sc[i][j]) + sh[i][j];
                    store_bf4(H + (size_t)(row + q) * DM + i * 256 + lane * 4, hv[0], hv[1], hv[2], hv[3]); } }
        }
    }
}

template <int I> __device__ __forceinline__ void poold_group(const float* xb, const float* RSs, int t0, int len, int lane, const float* g0, const float* msc, bf16_t* Hrow0) {
    constexpr int W = 2 << I, LO = W / 2, HI = W - 1 - LO, NR = 8 + W - 1;
    const int col = I * 256 + lane * 4;
    f32x4 xs[NR];
#pragma unroll
    for (int k = 0; k < NR; ++k) { const int tt = t0 - LO + k; const bool ok = (tt >= 0 && tt < len); const int tc = ok ? tt : t0;
        const f32x4 xx = *(const f32x4*)(xb + (size_t)tc * DM + col); const float rs = ok ? RSs[tc] : 0.f; xs[k] = xx * rs; }
    const f32x4 gg = *(const f32x4*)(g0 + col), sc = *(const f32x4*)(msc + col);
    f32x4 gm;
#pragma unroll
    for (int j = 0; j < 4; ++j) gm[j] = gg[j] * (1.0f + sc[j]);
    f32x4 S = xs[0];
#pragma unroll
    for (int k = 1; k < W; ++k) S += xs[k];
#pragma unroll
    for (int r = 0; r < 8; ++r) {
        const int t = t0 + r; const int ta = max(t - LO, 0), tb = min(t + HI + 1, len); const float inv = 1.0f / (float)(tb - ta);
        const f32x4 d = (S * inv - xs[r + LO]) * gm;
        store_bf4(Hrow0 + (size_t)r * DM + col, d[0], d[1], d[2], d[3]);
        if (r < 7) S += xs[r + W] - xs[r];
    }
}
__device__ __forceinline__ void phase_poold(const Params& p) {
    const int tid = tid_opaque(), wid = tid >> 6, lane = tid & 63;
    const float* MOD = (const float*)(p.ws + WS_MOD); const float* RS = (const float*)(p.ws + WS_RS); bf16_t* H = (bf16_t*)(p.ws + WS_H);
    const float* g0 = p.norm_g;
    for (int task = blockIdx.x * 8 + wid; task < (MALL / 8) * 4; task += gridDim.x * 8) {
        const int row = (task >> 2) * 8, grp = task & 3;
        const int mr = modrow(row);
        const int s0 = row < MLAT ? (row & ~(SEQ - 1)) : MLAT + ((row - MLAT) & ~(CTXL - 1)); const int len = row < MLAT ? SEQ : CTXL; const int t0 = row - s0;
        const float* xb = row < MLAT ? p.x + (size_t)s0 * DM : p.ctx + (size_t)(s0 - MLAT) * DM;
        const float* msc = MOD + ((size_t)0 * 17 + mr) * 6144 + 1 * DM;
        bf16_t* Hr = H + (size_t)row * DM;
        if (grp == 0) poold_group<0>(xb, RS + s0, t0, len, lane, g0, msc, Hr);
        else if (grp == 1) poold_group<1>(xb, RS + s0, t0, len, lane, g0, msc, Hr);
        else if (grp == 2) poold_group<2>(xb, RS + s0, t0, len, lane, g0, msc, Hr);
        else poold_group<3>(xb, RS + s0, t0, len, lane, g0, msc, Hr);
    }
}

__device__ __forceinline__ void phase_conv(const Params& p) {
    const int tid = tid_opaque(), wid = tid >> 6, lane = tid & 63;
    const bf16_t* T1 = (const bf16_t*)(p.ws + WS_T1); bf16_t* H = (bf16_t*)(p.ws + WS_H);
    for (int task = blockIdx.x * 8 + wid; task < (MALL / 8) * 4; task += gridDim.x * 8) {
        const int row = (task >> 2) * 8;
        const int s0 = row < MLAT ? (row & ~(SEQ - 1)) : MLAT + ((row - MLAT) & ~(CTXL - 1)); const int len = row < MLAT ? SEQ : CTXL; const int t0 = row - s0;
        { const int i = task & 3;
            const int col = i * 256 + lane * 4;
            u32x2 cw[10], vw[10], bw[8];
#pragma unroll
            for (int k = 0; k < 10; ++k) { const int tt = t0 - 1 + k; const bool ok = (tt >= 0 && tt < len); const int tc = ok ? tt : t0;
                const bf16_t* rp = T1 + (size_t)(s0 + tc) * 3072; cw[k] = *(const u32x2*)(rp + 1024 + col); vw[k] = *(const u32x2*)(rp + 2048 + col);
                if (!ok) { cw[k].x = 0u; cw[k].y = 0u; } }
#pragma unroll
            for (int r = 0; r < 8; ++r) bw[r] = *(const u32x2*)(T1 + (size_t)(row + r) * 3072 + col);
            const f32x4 w0 = *(const f32x4*)(p.conv_w + col), w1 = *(const f32x4*)(p.conv_w + DM + col), w2 = *(const f32x4*)(p.conv_w + 2 * DM + col);
            f32x4 u[10];
#pragma unroll
            for (int k = 0; k < 10; ++k) { u[k][0] = bf_lo(cw[k].x) * bf_lo(vw[k].x); u[k][1] = bf_hi(cw[k].x) * bf_hi(vw[k].x); u[k][2] = bf_lo(cw[k].y) * bf_lo(vw[k].y); u[k][3] = bf_hi(cw[k].y) * bf_hi(vw[k].y); }
#pragma unroll
            for (int r = 0; r < 8; ++r) { const f32x4 z = u[r] * w0 + u[r + 1] * w1 + u[r + 2] * w2;
                store_bf4(H + (size_t)(row + r) * DM + col, bf_lo(bw[r].x) * z[0], bf_hi(bw[r].x) * z[1], bf_lo(bw[r].y) * z[2], bf_hi(bw[r].y) * z[3]); }
        }
    }
}

__device__ __forceinline__ void phase_mlaprep(const Params& p) {
    const int tid = tid_opaque(), wid = tid >> 6, lane = tid & 63;
    bf16_t* T1 = (bf16_t*)(p.ws + WS_T1); bf16_t* CKV = (bf16_t*)(p.ws + WS_H); const float* rope = (const float*)(p.ws + WS_ROPE);
    for (int row4 = (blockIdx.x * 8 + wid) * 4; row4 < MALL; row4 += gridDim.x * 32) {
      u32x2 araw[4][3];
#pragma unroll
      for (int q = 0; q < 4; ++q)
#pragma unroll
        for (int i = 0; i < 3; ++i) araw[q][i] = *(const u32x2*)(T1 + T_AB + (size_t)(row4 + q) * 768 + i * 256 + lane * 4);
#pragma unroll
      for (int q = 0; q < 4; ++q) {
        const int row = row4 + q;
        float v[12]; float sq = 0.f, skv = 0.f;
#pragma unroll
        for (int i = 0; i < 3; ++i) { const int col = i * 256 + lane * 4; v[4 * i] = bf_lo(araw[q][i].x); v[4 * i + 1] = bf_hi(araw[q][i].x); v[4 * i + 2] = bf_lo(araw[q][i].y); v[4 * i + 3] = bf_hi(araw[q][i].y);
            const float s = v[4 * i] * v[4 * i] + v[4 * i + 1] * v[4 * i + 1] + v[4 * i + 2] * v[4 * i + 2] + v[4 * i + 3] * v[4 * i + 3];
            if (col < 384) sq += s; else if (col < 640) skv += s; }
        sq = wave_sum(sq); skv = wave_sum(skv);
        const float rq = rsqrtf(sq * (1.0f / 384.0f) + EPS), rkv = rsqrtf(skv * (1.0f / 256.0f) + EPS);
#pragma unroll
        for (int i = 0; i < 3; ++i) { const int col = i * 256 + lane * 4;
            if (col < 384) { const f32x4 g = *(const f32x4*)(p.mla_g_q + col);
                store_bf4(T1 + T_CQ + (size_t)row * 384 + col, v[4 * i] * rq * g[0], v[4 * i + 1] * rq * g[1], v[4 * i + 2] * rq * g[2], v[4 * i + 3] * rq * g[3]); }
            else if (col < 640) { const int c2 = col - 384; const f32x4 g = *(const f32x4*)(p.mla_g_kv + c2);
                store_bf4(CKV + (size_t)row * 256 + c2, v[4 * i] * rkv * g[0], v[4 * i + 1] * rkv * g[1], v[4 * i + 2] * rkv * g[2], v[4 * i + 3] * rkv * g[3]); }
        }
        {
            float pv[4];
#pragma unroll
            for (int j = 0; j < 4; ++j) pv[j] = __shfl_xor(v[8 + j], 4);
            if (lane >= 32 && lane < 48) {
                const int k = lane - 32; float ov[4];
                if (row < MLAT) {
                    const int t = row & (SEQ - 1); const int pos = (k < 8) ? (t >> 6) : (t & 63);
                    const f32x4 t0 = *(const f32x4*)(rope + (pos * 16 + 4 * (k & 3)) * 2), t1 = *(const f32x4*)(rope + (pos * 16 + 4 * (k & 3)) * 2 + 4);
                    const float cs[4] = {t0[0], t0[2], t1[0], t1[2]}, sn[4] = {t0[1], t0[3], t1[1], t1[3]};
#pragma unroll
                    for (int j = 0; j < 4; ++j) ov[j] = (k & 4) ? (v[8 + j] * cs[j] + pv[j] * sn[j]) : (v[8 + j] * cs[j] - pv[j] * sn[j]);
                } else {
#pragma unroll
                    for (int j = 0; j < 4; ++j) ov[j] = v[8 + j];
                }
                store_bf4(T1 + T_KR + (size_t)row * 64 + 4 * k, ov[0], ov[1], ov[2], ov[3]);
            }
        }
      }
    }
}

__device__ __forceinline__ void conv_wt(const float* src, int K, int N, int Npad, bf16_t* dst, float* tile, int rot) {
    const int tid = tid_opaque(), G = gridDim.x;
    const int ntn = Npad / 64, ntk = K / 64, ntiles = ntn * ntk;
    for (int u = (blockIdx.x + G - (rot % G)) % G; u < ntiles; u += G) {
        const int kt = u / ntn, nt_ = u % ntn, k0 = kt * 64, n0 = nt_ * 64;
        const int r = tid >> 4, c4 = (tid & 15) * 4;
#pragma unroll
        for (int pss = 0; pss < 2; ++pss) { const int rr = r + pss * 32; f32x4 v = {0.f, 0.f, 0.f, 0.f};
            if (n0 + c4 < N) v = *(const f32x4*)(src + (size_t)(k0 + rr) * N + n0 + c4);
            tile[rr * 65 + c4 + 0] = v[0]; tile[rr * 65 + c4 + 1] = v[1]; tile[rr * 65 + c4 + 2] = v[2]; tile[rr * 65 + c4 + 3] = v[3]; }
        __syncthreads();
        { const int n = tid >> 3, k8 = (tid & 7) * 8; float t[8];
#pragma unroll
          for (int j = 0; j < 8; ++j) t[j] = tile[(k8 + j) * 65 + n];
          u32x4 w; w.x = cvt_pk_bf16(t[0], t[1]); w.y = cvt_pk_bf16(t[2], t[3]); w.z = cvt_pk_bf16(t[4], t[5]); w.w = cvt_pk_bf16(t[6], t[7]);
          *(u32x4*)(dst + (size_t)(n0 + n) * K + k0 + k8) = w; }
        __syncthreads();
    }
}

__device__ __forceinline__ void phase_prep(const Params& p, char* lds) {
    const int tid = tid_opaque(), wid = tid >> 6, lane = tid & 63, G = gridDim.x;
    float* fl = (float*)lds;
    if (blockIdx.x < 96) {
        { f32x4 cvv[9];
#pragma unroll
          for (int q = 0; q < 9; ++q) { const int idx = tid + q * NTHREADS; const int r = idx >> 8, k4 = (idx & 255) * 4; cvv[q] = (idx < 17 * 256) ? *(const f32x4*)(r < 16 ? p.c + r * 1024 + k4 : p.c_ctx + k4) : (f32x4){0.f, 0.f, 0.f, 0.f}; }
#pragma unroll
          for (int q = 0; q < 9; ++q) { const int idx = tid + q * NTHREADS; const int r = idx >> 8, k4 = (idx & 255) * 4;
              if (idx < 17 * 256) {
#pragma unroll
                  for (int j = 0; j < 4; ++j) fl[(k4 + j) * 17 + r] = cvv[q][j] / (1.0f + expf(-cvv[q][j])); } } }
        __syncthreads();
        float* MOD = (float*)(p.ws + WS_MOD);
        for (int u = blockIdx.x; u < 96; u += G) {
            const int layer = u / 24, cb = u % 24, col0 = cb * 256 + wid * 32 + (lane & 7) * 4, kq = lane >> 3;
            float acc[17][4];
#pragma unroll
            for (int r = 0; r < 17; ++r)
#pragma unroll
                for (int j = 0; j < 4; ++j) acc[r][j] = 0.f;
            const float* W = p.ada_w + (size_t)layer * 1024 * 6144 + col0;
#pragma unroll 8
            for (int itk = 0; itk < 128; ++itk) { const int k = kq + 8 * itk; const f32x4 w = *(const f32x4*)(W + (size_t)k * 6144);
#pragma unroll
                for (int r = 0; r < 17; ++r) { const float s = fl[k * 17 + r];
#pragma unroll
                    for (int j = 0; j < 4; ++j) acc[r][j] += s * w[j]; } }
#pragma unroll
            for (int r = 0; r < 17; ++r)
#pragma unroll
                for (int j = 0; j < 4; ++j) { float v = acc[r][j]; v += __shfl_xor(v, 8); v += __shfl_xor(v, 16); v += __shfl_xor(v, 32); acc[r][j] = v; }
            if (kq == 0) { const f32x4 bb = *(const f32x4*)(p.ada_b + layer * 6144 + col0);
#pragma unroll
                for (int r = 0; r < 17; ++r) { f32x4 o = {acc[r][0] + bb[0], acc[r][1] + bb[1], acc[r][2] + bb[2], acc[r][3] + bb[3]}; *(f32x4*)(MOD + ((size_t)layer * 17 + r) * 6144 + col0) = o; } }
        }
        __syncthreads();
    }
    if (blockIdx.x == G - 1) {
        float* rt = (float*)(p.ws + WS_ROPE);
        for (int idx = tid; idx < 1024; idx += NTHREADS) { const int pos = idx >> 4, f = idx & 15; const float inv = powf(10000.0f, -(float)f / 16.0f); const float ang = (float)pos * inv;
            rt[idx * 2] = cosf(ang); rt[idx * 2 + 1] = sinf(ang); }
    }
    { float* RS = (float*)(p.ws + WS_RS);
      for (int row = (blockIdx.x * 8 + wid) * 4; row < MALL; row += G * 32) { const float* xi = xin_row(p, row, true); f32x4 xx[4][4];
#pragma unroll
          for (int q = 0; q < 4; ++q)
#pragma unroll
              for (int i = 0; i < 4; ++i) xx[q][i] = *(const f32x4*)(xi + q * DM + i * 256 + lane * 4);
          float ss[4] = {0.f, 0.f, 0.f, 0.f};
#pragma unroll
          for (int q = 0; q < 4; ++q)
#pragma unroll
              for (int i = 0; i < 4; ++i) ss[q] += xx[q][i][0] * xx[q][i][0] + xx[q][i][1] * xx[q][i][1] + xx[q][i][2] * xx[q][i][2] + xx[q][i][3] * xx[q][i][3];
#pragma unroll
          for (int o = 32; o >= 1; o >>= 1) { ss[0] += __shfl_xor(ss[0], o); ss[1] += __shfl_xor(ss[1], o); ss[2] += __shfl_xor(ss[2], o); ss[3] += __shfl_xor(ss[3], o); }
          if (lane < 4) RS[row + lane] = rsqrtf((lane == 0 ? ss[0] : lane == 1 ? ss[1] : lane == 2 ? ss[2] : ss[3]) * (1.0f / DM) + EPS); } }
    bf16_t* W = (bf16_t*)(p.ws + WS_W);
    int rot = 96;
    for (int l = 0; l < 4; ++l) {
        conv_wt(p.ffn_w1 + (size_t)l * 1024 * 4096, 1024, 4096, 4096, W + W_FFN + (size_t)l * 8388608, fl, rot); rot += 1024;
        conv_wt(p.ffn_w2 + (size_t)l * 4096 * 1024, 4096, 1024, 1024, W + W_FFN + (size_t)l * 8388608 + 4194304, fl, rot); rot += 1024;
    }
    for (int g = 0; g < 4; ++g) { conv_wt(p.pool_w + (size_t)g * 65536, 256, 256, 256, W + W_POOL + (size_t)g * 65536, fl, rot); rot += 16; }
    conv_wt(p.conv_in_w, 1024, 3072, 3072, W + W_CIN, fl, rot); rot += 768;
    conv_wt(p.conv_out_w, 1024, 1024, 1024, W + W_COUT, fl, rot); rot += 256;
    conv_wt(p.mla_w_down, 1024, 704, 768, W + W_DOWN, fl, rot); rot += 192;
    conv_wt(p.mla_w_uq, 384, 1536, 1536, W + W_UQ, fl, rot); rot += 144;
    conv_wt(p.mla_w_ukv, 256, 2048, 2048, W + W_UKV, fl, rot); rot += 128;
    conv_wt(p.mla_w_o, 1024, 1024, 1024, W + W_MO, fl, rot); rot += 256;
    conv_wt(p.diff_w_qkv, 1024, 3072, 3072, W + W_DQKV, fl, rot); rot += 768;
    conv_wt(p.diff_w_o, 1024, 1024, 1024, W + W_DO, fl, rot);
}

__device__ __forceinline__ void grid_barrier(unsigned* cnt, unsigned target) {
    asm volatile("s_waitcnt vmcnt(0) lgkmcnt(0)" ::: "memory");
    __syncthreads();
    if (threadIdx.x < 64) {
        if (threadIdx.x == 0) {
            __builtin_amdgcn_fence(__ATOMIC_RELEASE, "agent");
            asm volatile("s_waitcnt vmcnt(0)" ::: "memory");
            __hip_atomic_fetch_add(cnt, 1u, __ATOMIC_RELAXED, __HIP_MEMORY_SCOPE_AGENT);
            while (__hip_atomic_load(cnt, __ATOMIC_RELAXED, __HIP_MEMORY_SCOPE_AGENT) < target) __builtin_amdgcn_s_sleep(1);
        }
        __builtin_amdgcn_fence(__ATOMIC_ACQUIRE, "agent");
        asm volatile("s_waitcnt vmcnt(0)" ::: "memory");
    }
    __syncthreads();
}

enum { T_PREP = 0, T_POOLD, T_GEMM, T_RN, T_CONV, T_MLAPREP, T_ATTN_MLA, T_ATTN_DIFF };
constexpr int N_PHASES = 31;

__global__ void __launch_bounds__(NTHREADS, 2) mk_fwd(Params p_arg) {
    extern __shared__ __attribute__((aligned(16))) unsigned char shm[];
    LAS unsigned char* ldsl = (LAS unsigned char*)shm; char* ldsg = (char*)shm;
    const int ph_lo = p_arg.ph_lo, ph_hi = p_arg.ph_hi; unsigned char* const wsb = p_arg.ws;
    bf16_t* H = (bf16_t*)(wsb + WS_H); bf16_t* T1 = (bf16_t*)(wsb + WS_T1); const bf16_t* W = (const bf16_t*)(wsb + WS_W);
    const float* rope = (const float*)(wsb + WS_ROPE);
    unsigned nbar = 0; unsigned* barcnt = (unsigned*)(wsb + WS_BAR);
    for (int ph = ph_lo; ph < ph_hi; ++ph) {
#if defined(__HIP_DEVICE_COMPILE__)
        typedef const __attribute__((address_space(4))) Params* KArgP;
        KArgP pp = (KArgP)__builtin_amdgcn_kernarg_segment_ptr(); asm volatile("" : "+s"(pp));
        const Params p = *pp;
#else
        const Params p = p_arg;
#endif
        int type = T_GEMM, sync = 1, layer = 0, stage = 0, nrows = MALL, npart = 1; const bf16_t* Y = T1;
        GemmP g; g.A = H; g.Bt = W; g.lda = 1024; g.ldb = 1024; g.K = 1024; g.nM = 144; g.nN = 4; g.a_pn_off = 0; g.ksplit = 1; g.a_tiled = 0; g.rev = 0; g.magicN = 16384;
        EpiP e; e.O = T1; e.ldo = 1024; e.mode = 0; e.colscale = nullptr; e.rope = rope; e.Opart = (bf16_t*)(wsb + WS_SCR);
        switch (ph) {
        case 0: type = T_PREP; break;
        case 1: type = T_POOLD; break;
        case 2: g.Bt = W + W_POOL; g.ldb = 256; g.K = 256; g.a_pn_off = 256; e.colscale = p.pool_scale; break;
        case 3: type = T_RN; layer = 0; stage = 0; Y = T1; break;
        case 4: case 11: case 21: case 28: { const int l = ph == 4 ? 0 : ph == 11 ? 1 : ph == 21 ? 2 : 3;
            g.Bt = W + W_FFN + (size_t)l * 8388608; g.nN = 16; g.magicN = 4096; g.nM = l == 3 ? 128 : 144; e.ldo = 4096; e.mode = 1; } break;
        case 5: case 12: case 22: case 29: { const int l = ph == 5 ? 0 : ph == 12 ? 1 : ph == 22 ? 2 : 3;
            g.A = T1; g.lda = 4096; g.Bt = W + W_FFN + (size_t)l * 8388608 + 4194304; g.ldb = 4096; g.K = 4096; g.nM = l == 3 ? 128 : 144; g.ksplit = l == 3 ? 1 : 4; g.a_tiled = 1; e.O = H; } break;
        case 6: type = T_RN; layer = 0; stage = 1; Y = H; npart = 4; break;
        case 7: g.Bt = W + W_CIN; g.nN = 12; g.magicN = 5462; e.ldo = 3072; break;
        case 8: type = T_CONV; break;
        case 9: g.Bt = W + W_COUT; g.ksplit = 4; break;
        case 10: type = T_RN; layer = 1; stage = 0; Y = T1; npart = 4; break;
        case 13: type = T_RN; layer = 1; stage = 1; Y = H; npart = 4; break;
        case 14: g.Bt = W + W_DOWN; g.nN = 3; g.magicN = 21846; e.O = T1 + T_AB; e.ldo = 768; break;
        case 15: type = T_MLAPREP; break;
        case 16: g.A = T1 + T_CQ; g.lda = 384; g.Bt = W + W_UQ; g.ldb = 384; g.K = 384; g.nN = 6; g.magicN = 10923; e.O = T1 + T_Q; e.ldo = 1536; e.mode = 3; break;
        case 17: sync = 0; g.rev = 1; g.A = H; g.lda = 256; g.Bt = W + W_UKV; g.ldb = 256; g.K = 256; g.nN = 8; g.magicN = 8192; e.O = T1 + T_KV; e.ldo = 2048; break;
        case 18: type = T_ATTN_MLA; break;
        case 19: g.Bt = W + W_MO; g.ksplit = 4; break;
        case 20: type = T_RN; layer = 2; stage = 0; Y = T1; npart = 4; break;
        case 23: type = T_RN; layer = 2; stage = 1; Y = H; npart = 4; break;
        case 24: g.Bt = W + W_DQKV; g.nN = 12; g.magicN = 5462; e.ldo = 3072; e.mode = 2; break;
        case 25: type = T_ATTN_DIFF; break;
        case 26: g.Bt = W + W_DO; g.nM = 128; break;
        case 27: type = T_RN; layer = 3; stage = 0; Y = T1; nrows = MLAT; break;
        case 30: type = T_RN; layer = 3; stage = 1; Y = H; nrows = MLAT; break;
        default: break;
        }
        if (ph > ph_lo && sync) { if (ph_hi > N_PHASES) cg::this_grid().sync(); else { ++nbar; grid_barrier(barcnt, nbar * gridDim.x); } }
#ifdef REPEAT_MASK
        for (int rep_ = 0; rep_ < (((REPEAT_MASK) >> ph) & 1 ? 2 : 1); ++rep_) {
        if (rep_) cg::this_grid().sync();
#endif
        switch (type) {
#ifndef PH_MASK
#define PH_MASK 0xff
#endif
#if PH_MASK & 1
        case T_PREP: phase_prep(p, ldsg); break;
#endif
#if PH_MASK & 2
        case T_POOLD: phase_poold(p); break;
#endif
#if PH_MASK & 4
        case T_GEMM: gemm_phase(ldsl, g, e); break;
#endif
#if PH_MASK & 8
        case T_RN: phase_rn(p, layer, stage, Y, nrows, npart); break;
#endif
#if PH_MASK & 16
        case T_CONV: phase_conv(p); break;
#endif
#if PH_MASK & 32
        case T_MLAPREP: phase_mlaprep(p); break;
#endif
#if PH_MASK & 64
        case T_ATTN_MLA: phase_attn_mla(p, ldsg); break;
#endif
#if PH_MASK & 128
        case T_ATTN_DIFF: phase_attn_diff(p, ldsg); break;
#endif
        }
#ifdef REPEAT_MASK
        }
#endif
    }
}

extern "C" void kernel_launch(void* const* d_in, const int* in_sizes, int n_in, void* d_out, int out_size, void* d_ws, size_t ws_size, hipStream_t stream) {
    static int grid = 0;
    if (grid == 0) {
        if (n_in != 24 || out_size != MLAT * DM || ws_size < WS_END) { fprintf(stderr, "kernel_launch: unexpected shapes (n_in %d out %d ws %zu need %zu)\n", n_in, out_size, ws_size, (size_t)WS_END); grid = -1; return; }
        if (hipFuncSetAttribute((const void*)mk_fwd, hipFuncAttributeMaxDynamicSharedMemorySize, LDS_BYTES) != hipSuccess) { fprintf(stderr, "kernel_launch: hipFuncSetAttribute failed\n"); grid = -1; return; }
        int dev = 0, cus = 0, per_cu = 0;
        (void)hipGetDevice(&dev); (void)hipDeviceGetAttribute(&cus, hipDeviceAttributeMultiprocessorCount, dev);
        (void)hipOccupancyMaxActiveBlocksPerMultiprocessor(&per_cu, (const void*)mk_fwd, NTHREADS, LDS_BYTES);
        if (per_cu < 1) { fprintf(stderr, "kernel_launch: occupancy query says %d blocks per CU\n", per_cu); per_cu = 1; }
        (void)hipGetLastError();
        grid = cus * 1;
        if (grid > 256) grid = 256;
    }
    if (grid < 0) return;
    Params p{};
    const float** pp = (const float**)&p;
    for (int i = 0; i < 24; ++i) pp[i] = (const float*)d_in[i];
    p.out = (float*)d_out; p.ws = (unsigned char*)d_ws;
#if MK_ONE_LAUNCH
    (void)hipMemsetAsync((char*)d_ws + WS_BAR, 0, 256, stream);
    p.ph_lo = 0; p.ph_hi = N_PHASES;
    void* args[] = {&p};
    hipError_t e = hipLaunchCooperativeKernel((const void*)mk_fwd, dim3(grid), dim3(NTHREADS), args, LDS_BYTES, stream);
    if (e != hipSuccess) fprintf(stderr, "cooperative launch failed: %s (grid %d)\n", hipGetErrorString(e), grid);
#else
    for (int ph = 0; ph < N_PHASES; ++ph) {
        p.ph_lo = ph; p.ph_hi = ph + 1;
        hipLaunchKernelGGL(mk_fwd, dim3(grid), dim3(NTHREADS), LDS_BYTES, stream, p);
    }
#endif
}
```

```cpp
#include <hip/hip_runtime.h>
#include <hip/hip_cooperative_groups.h>
#include <cstdio>
#include <cstdint>
namespace cg = cooperative_groups;

#ifndef MK_ONE_LAUNCH
#define MK_ONE_LAUNCH 1
#endif

#define LAS __attribute__((address_space(3)))
typedef unsigned short bf16_t;
typedef short bf16x8 __attribute__((ext_vector_type(8)));
typedef short s16x4 __attribute__((ext_vector_type(4)));
typedef float f32x4 __attribute__((ext_vector_type(4)));
typedef float f32x16 __attribute__((ext_vector_type(16)));
typedef unsigned u32x4 __attribute__((ext_vector_type(4)));
typedef unsigned u32x2 __attribute__((ext_vector_type(2)));

constexpr int DM = 1024, NB = 16, SEQ = 2048, CTXL = 256, MLAT = NB * SEQ, MCTX = NB * CTXL, MALL = MLAT + MCTX;
constexpr float EPS = 1e-6f;
constexpr int NTHREADS = 512;
#ifndef MLA_NQL
#define MLA_NQL 4
#endif
constexpr int LDS_BYTES = (32768 + 49152 + 2048 + MLA_NQL * 8192) > 131072 ? (32768 + 49152 + 2048 + MLA_NQL * 8192) : 131072;

constexpr size_t WS_XC = 0;
constexpr size_t WS_H = WS_XC + (size_t)MCTX * DM * 4;
constexpr size_t WS_T1 = WS_H + (size_t)MALL * DM * 2;
constexpr size_t WS_W = WS_T1 + (size_t)MALL * 4096 * 2;
constexpr size_t W_ELTS = 45154304;
constexpr size_t WS_MOD = WS_W + W_ELTS * 2;
constexpr size_t WS_RS = WS_MOD + (size_t)4 * 17 * 6144 * 4;
constexpr size_t WS_ROPE = WS_RS + (size_t)MALL * 4;
constexpr size_t WS_SCR = WS_ROPE + 8192;
constexpr size_t WS_BAR = WS_SCR + (size_t)256 * 64 * 512 * 4;
constexpr size_t WS_END = WS_BAR + 256;
static_assert(WS_SCR % 256 == 0 && WS_MOD % 256 == 0 && WS_RS % 256 == 0 && WS_ROPE % 256 == 0, "align");
static_assert(WS_END <= 536870912ull, "workspace budget");
constexpr size_t W_FFN = 0;
constexpr size_t W_POOL = 33554432;
constexpr size_t W_CIN = W_POOL + 262144;
constexpr size_t W_COUT = W_CIN + 3145728;
constexpr size_t W_DOWN = W_COUT + 1048576;
constexpr size_t W_UQ = W_DOWN + 786432;
constexpr size_t W_UKV = W_UQ + 589824;
constexpr size_t W_MO = W_UKV + 524288;
constexpr size_t W_DQKV = W_MO + 1048576;
constexpr size_t W_DO = W_DQKV + 3145728;
static_assert(W_DO + 1048576 == W_ELTS, "weights");
constexpr size_t T_Q = 0;
constexpr size_t T_KV = T_Q + (size_t)MALL * 1536;
constexpr size_t T_CQ = T_KV + (size_t)MALL * 2048;
constexpr size_t T_KR = T_CQ + (size_t)MALL * 384;
constexpr size_t T_AB = T_KV;
static_assert(T_KR + (size_t)MALL * 64 <= (size_t)MALL * 4096, "arena");

struct Params {
    const float *x, *c, *ctx, *c_ctx, *ada_w, *ada_b, *norm_g, *ffn_w1, *ffn_w2, *pool_w, *pool_scale, *conv_in_w, *conv_w, *conv_out_w,
        *mla_w_down, *mla_g_q, *mla_g_kv, *mla_w_uq, *mla_w_ukv, *mla_w_o, *diff_w_qkv, *diff_lambda, *diff_g_subln, *diff_w_o;
    float* out; unsigned char* ws; int ph_lo, ph_hi;
};

__device__ __forceinline__ int tid_opaque() { int t = threadIdx.x; asm volatile("" : "+v"(t)); return t; }
__device__ __forceinline__ unsigned cvt_pk_bf16(float lo, float hi) { unsigned r; asm volatile("v_cvt_pk_bf16_f32 %0, %1, %2" : "=v"(r) : "v"(lo), "v"(hi)); return r; }
__device__ __forceinline__ float bf_lo(unsigned w) { return __uint_as_float(w << 16); }
__device__ __forceinline__ float bf_hi(unsigned w) { return __uint_as_float(w & 0xffff0000u); }
__device__ __forceinline__ float wave_sum(float v) {
#pragma unroll
    for (int o = 32; o >= 1; o >>= 1) v += __shfl_xor(v, o);
    return v;
}
__device__ __forceinline__ int modrow(int row) { return row < MLAT ? (row >> 11) : NB; }
__device__ __forceinline__ void load_bf4(const bf16_t* p, float* v) { const u32x2 w = *(const u32x2*)p; v[0] = bf_lo(w.x); v[1] = bf_hi(w.x); v[2] = bf_lo(w.y); v[3] = bf_hi(w.y); }
__device__ __forceinline__ void store_bf4(bf16_t* p, float a, float b, float c, float d) { u32x2 w; w.x = cvt_pk_bf16(a, b); w.y = cvt_pk_bf16(c, d); *(u32x2*)p = w; }

constexpr int BM = 256, BK = 64, HALF = 128, HTB = HALF * BK * 2;
__device__ __forceinline__ int lds_byte(int r, int c) { const int st = (r >> 4) * 2 + (c >> 5), rr = r & 15, cc = c & 31, ob = rr * 64 + cc * 2; return st * 1024 + (ob ^ (((ob >> 9) & 1) << 5)); }
__device__ __forceinline__ void stage_rc(int b, int& R, int& C) { const int st = b / 1024, sb = b % 1024, swz = sb ^ (((sb >> 9) & 1) << 5); R = (st >> 1) * 16 + swz / 64; C = (st & 1) * 32 + (swz % 64) / 2; }

struct Unit { int pm, pn, ks, nt; };
struct GemmP { const bf16_t* A; const bf16_t* Bt; int lda, ldb, K, nM, nN, a_pn_off, ksplit, a_tiled, rev, magicN; };
struct EpiP { bf16_t* O; int ldo; int mode; const float* colscale; const float* rope; bf16_t* Opart; };

__device__ __forceinline__ bool unit_next(const GemmP& g, int i, Unit& u) {
    const int nMf = g.ksplit > 1 ? 128 : g.nM;
    const int nwg = nMf * g.nN; const int L = i * (int)gridDim.x + (g.rev ? (int)gridDim.x - 1 - (int)blockIdx.x : (int)blockIdx.x);
    if (L >= nwg) {
        if (g.ksplit <= 1) return false;
        const int idx = L - nwg; if (idx >= (g.nM - nMf) * 16) return false;
        u.pm = nMf + (idx >> 4); const int r = idx & 15; u.pn = r >> 2; u.ks = r & 3; u.nt = g.K >> 8; return true;
    }
    int wgid = L; { const int q = nwg >> 3, xcd = wgid & 7, off = wgid >> 3; wgid = xcd * q + off; }
    const int w8 = wgid >> 3, gid = (w8 * g.magicN) >> 16, rem = wgid - gid * 8 * g.nN;
    u.pm = gid * 8 + (rem & 7); u.pn = rem >> 3; u.ks = -1; u.nt = g.K >> 6; return true;
}

__device__ __forceinline__ void epi_store(const f32x4 (&acc)[2][2][4][2], const Unit& u, int wr, int wc, int fr, int fq, const EpiP& e) {
    const int row0 = u.pm * BM + wr * 64 + fr;
    if (e.mode < 2) {
        const int col0 = u.pn * BM + wc * 32 + 8 * fq;
#pragma unroll
        for (int bj = 0; bj < 2; ++bj) {
            const int c = col0 + bj * HALF;
            f32x4 cs0 = {1.f, 1.f, 1.f, 1.f}, cs1 = {1.f, 1.f, 1.f, 1.f};
            if (e.mode == 0 && e.colscale) { cs0 = *(const f32x4*)(e.colscale + c); cs1 = *(const f32x4*)(e.colscale + c + 4); }
#pragma unroll
            for (int ai = 0; ai < 2; ++ai)
#pragma unroll
                for (int m = 0; m < 4; ++m) {
                    const int row = row0 + ai * HALF + m * 16;
                    f32x4 v0 = acc[ai][bj][m][0], v1 = acc[ai][bj][m][1];
                    if (e.mode == 1) {
#pragma unroll
                        for (int j = 0; j < 4; ++j) { const float a = fmaxf(v0[j], 0.f), b = fmaxf(v1[j], 0.f); v0[j] = a * a; v1[j] = b * b; }
                    } else { v0 *= cs0; v1 *= cs1; }
                    bf16_t* rowp = (u.ks < 0 ? e.O + (size_t)row * e.ldo : e.Opart + ((size_t)u.ks * MCTX + (row - MLAT)) * 1024) + c;
                    if (e.mode == 1)
                        rowp = (bf16_t*)((char*)e.O + ((size_t)(u.pm * 64 + u.pn * 4 + bj * 2 + (wc >> 1))) * 32768 + ai * 16384 + (((wr * 4 + m) * 2 + (wc & 1)) * 1024) + (fr * 4 + fq) * 16);
                    u32x4 w; w.x = cvt_pk_bf16(v0[0], v0[1]); w.y = cvt_pk_bf16(v0[2], v0[3]); w.z = cvt_pk_bf16(v1[0], v1[1]); w.w = cvt_pk_bf16(v1[2], v1[3]);
                    *(u32x4*)rowp = w;
                }
        }
        return;
    }
    const int col0 = u.pn * BM + wc * 32 + 4 * fq;
#pragma unroll
    for (int bj = 0; bj < 2; ++bj) {
        const int c = col0 + bj * HALF;
        int kind = 0;
        if (e.mode == 2) { if (c < 2048) kind = ((c >> 5) & 1) ? 2 : 1; }
        else { const int d = c % 192; if (d >= 128) kind = (d >= 160) ? 2 : 1; }
#pragma unroll
        for (int ai = 0; ai < 2; ++ai)
#pragma unroll
            for (int m = 0; m < 4; ++m) {
                const int row = row0 + ai * HALF + m * 16;
                f32x4 v0 = acc[ai][bj][m][0], v1 = acc[ai][bj][m][1];
                if (kind != 0 && row < MLAT) {
                    const int t = row & (SEQ - 1); const int pos = (kind == 1) ? (t >> 6) : (t & 63);
                    const f32x4 t0 = *(const f32x4*)(e.rope + (pos * 16 + 4 * fq) * 2), t1 = *(const f32x4*)(e.rope + (pos * 16 + 4 * fq) * 2 + 4);
                    const float cs[4] = {t0[0], t0[2], t1[0], t1[2]}, sn[4] = {t0[1], t0[3], t1[1], t1[3]};
#pragma unroll
                    for (int j = 0; j < 4; ++j) { const float x1 = v0[j], x2 = v1[j]; v0[j] = x1 * cs[j] - x2 * sn[j]; v1[j] = x2 * cs[j] + x1 * sn[j]; }
                }
                bf16_t* rowp = e.O + (size_t)row * e.ldo + c;
                u32x2 w0, w1; w0.x = cvt_pk_bf16(v0[0], v0[1]); w0.y = cvt_pk_bf16(v0[2], v0[3]); w1.x = cvt_pk_bf16(v1[0], v1[1]); w1.y = cvt_pk_bf16(v1[2], v1[3]);
                const bool odd = (fq & 1) != 0;
                const unsigned sx = odd ? w0.x : w1.x, sy = odd ? w0.y : w1.y;
                const unsigned rx = (unsigned)__shfl_xor((int)sx, 16), ry = (unsigned)__shfl_xor((int)sy, 16);
                u32x4 w; if (odd) { w.x = rx; w.y = ry; w.z = w1.x; w.w = w1.y; } else { w.x = w0.x; w.y = w0.y; w.z = rx; w.w = ry; }
                *(u32x4*)(rowp + (odd ? 12 : 0)) = w;
            }
    }
}

__device__ __forceinline__ void gemm_phase(LAS unsigned char* lds, const GemmP g, const EpiP e) {
    const int tid = tid_opaque(), wid = __builtin_amdgcn_readfirstlane(tid >> 6), lane = tid & 63, wr = wid >> 2, wc = wid & 3, fr = lane & 15, fq = lane >> 4;
    unsigned voffA[2], voffB[2];
#pragma unroll
    for (int i = 0; i < 2; ++i) { int R, C; stage_rc(tid * 16 + i * 8192, R, C); const int rho = R & 31; const int Rb = (e.mode < 2) ? ((R & ~31) + 8 * ((rho & 15) >> 2) + 4 * (rho >> 4) + (rho & 3)) : R;
        voffA[i] = g.a_tiled ? (unsigned)((((R >> 4) * 2 + (C >> 5)) * 1024) + ((R & 15) * 4 + ((C >> 3) & 3)) * 16) : (unsigned)(R * g.lda + C) * 2u; voffB[i] = (unsigned)(Rb * g.ldb + C) * 2u; }
    const size_t kstepB = (size_t)(BK * 2), kstepA = g.a_tiled ? (size_t)32768 : (size_t)(BK * 2);
    const size_t hstepA = g.a_tiled ? (size_t)16384 : (size_t)HALF * g.lda * 2, hstepB = (size_t)HALF * g.ldb * 2;
    const size_t tstepA = g.a_tiled ? (size_t)(g.K / BK) * 32768 : 2 * hstepA, tstepB = 2 * hstepB;
    const unsigned ldsw = (unsigned)wid * 1024u;
    const int aoff = lds_byte(wr * 64 + fr, fq * 8), boff = lds_byte(wc * 32 + fr, fq * 8);
#define PG8_SA(b, h) (((b) * 2 + (h)) * HTB)
#define PG8_SB(b, h) ((4 + (b) * 2 + (h)) * HTB)
#define PG8_STAGE(bufoff, gbase, voff) do { _Pragma("unroll") for (int _i = 0; _i < 2; ++_i) \
        __builtin_amdgcn_global_load_lds((const unsigned*)((const char*)(gbase) + (voff)[_i]), (LAS unsigned*)(lds + (bufoff) + ldsw + _i * 8192), 16, 0, 0); } while (0)
#define PG8_LDA(dst, b, h) do { _Pragma("unroll") for (int m = 0; m < 4; ++m) _Pragma("unroll") for (int k = 0; k < 2; ++k) dst[m][k] = *(const LAS bf16x8*)(lds + PG8_SA(b, h) + aoff + m * 2048 + k * 1024); } while (0)
#define PG8_LDB(dst, b, h) do { _Pragma("unroll") for (int n = 0; n < 2; ++n) _Pragma("unroll") for (int k = 0; k < 2; ++k) dst[n][k] = *(const LAS bf16x8*)(lds + PG8_SB(b, h) + boff + n * 2048 + k * 1024); } while (0)
#define PG8_MMA(ai, bj, At, Bt) do { __builtin_amdgcn_s_setprio(1); _Pragma("unroll") for (int m = 0; m < 4; ++m) _Pragma("unroll") for (int n = 0; n < 2; ++n) _Pragma("unroll") for (int k = 0; k < 2; ++k) \
        acc[ai][bj][m][n] = __builtin_amdgcn_mfma_f32_16x16x32_bf16(Bt[n][k], At[m][k], acc[ai][bj][m][n], 0, 0, 0); __builtin_amdgcn_s_setprio(0); } while (0)
#define PG8_WAIT_V(n) asm volatile("s_waitcnt vmcnt(" #n ")" ::: "memory")
#define PG8_WAIT_L(n) asm volatile("s_waitcnt lgkmcnt(" #n ")" ::: "memory")
#define PG8_BAR __builtin_amdgcn_s_barrier()
#define PG8_SCHED __builtin_amdgcn_sched_barrier(0)
    Unit cur, nxt; int ui = 0;
    if (!unit_next(g, 0, cur)) return;
    f32x4 acc[2][2][4][2];
#pragma unroll
    for (int a = 0; a < 2; ++a)
#pragma unroll
        for (int b = 0; b < 2; ++b)
#pragma unroll
            for (int m = 0; m < 4; ++m)
#pragma unroll
                for (int n = 0; n < 2; ++n) acc[a][b][m][n] = (f32x4){0.f, 0.f, 0.f, 0.f};
    bf16x8 At[4][2], B0[2][2], B1[2][2];
    const size_t ksliceB = (size_t)(g.ksplit > 1 ? g.K / g.ksplit : 0) * 2;
    const size_t ksliceA = g.a_tiled ? (size_t)(g.ksplit > 1 ? g.K / g.ksplit / BK : 0) * 32768 : ksliceB;
#define UNIT_A(u_) ((const char*)g.A + (size_t)(u_).pm * tstepA + (size_t)(u_).pn * g.a_pn_off * 2 + ((u_).ks > 0 ? (u_).ks * ksliceA : 0))
#define UNIT_B(u_) ((const char*)g.Bt + (size_t)(u_).pn * tstepB + ((u_).ks > 0 ? (u_).ks * ksliceB : 0))
    const char* cA = UNIT_A(cur); const char* cB = UNIT_B(cur);
    PG8_STAGE(PG8_SB(0, 0), cB, voffB); PG8_STAGE(PG8_SB(0, 1), cB + hstepB, voffB); PG8_STAGE(PG8_SA(0, 0), cA, voffA); PG8_STAGE(PG8_SA(0, 1), cA + hstepA, voffA);
    if (wr == 1) PG8_BAR;
    PG8_WAIT_V(2); PG8_BAR;
    PG8_STAGE(PG8_SB(1, 0), cB + kstepB, voffB); PG8_STAGE(PG8_SA(1, 0), cA + kstepA, voffA); PG8_STAGE(PG8_SB(1, 1), cB + hstepB + kstepB, voffB);
    PG8_WAIT_V(6); PG8_BAR;
    for (;;) {
        const bool has_next = unit_next(g, ui + 1, nxt);
        const char* nA = has_next ? UNIT_A(nxt) : cA; const char* nB = has_next ? UNIT_B(nxt) : cB;
        const int nt = cur.nt;
        for (int t = 0; t < nt; t += 2) {
            const bool last = (t == nt - 2);
            const char* a1 = cA + (size_t)(t + 1) * kstepA;
            const char* a2 = last ? nA : cA + (size_t)(t + 2) * kstepA; const char* b2 = last ? nB : cB + (size_t)(t + 2) * kstepB;
            const char* a3 = a2 + kstepA; const char* b3 = b2 + kstepB;
            PG8_LDB(B0, 0, 0); PG8_LDB(B1, 0, 1); PG8_SCHED; PG8_LDA(At, 0, 0); PG8_STAGE(PG8_SA(1, 1), a1 + hstepA, voffA);
            PG8_WAIT_V(8); PG8_WAIT_L(0); PG8_BAR; PG8_MMA(0, 0, At, B0); PG8_MMA(0, 1, At, B1); PG8_BAR; PG8_SCHED;
            PG8_LDA(At, 0, 1); PG8_STAGE(PG8_SB(0, 0), b2, voffB); PG8_STAGE(PG8_SB(0, 1), b2 + hstepB, voffB); PG8_STAGE(PG8_SA(0, 0), a2, voffA);
            PG8_WAIT_V(8); PG8_WAIT_L(0); PG8_BAR; PG8_MMA(1, 0, At, B0); PG8_MMA(1, 1, At, B1); PG8_BAR; PG8_SCHED;
            PG8_LDB(B0, 1, 0); PG8_LDB(B1, 1, 1); PG8_SCHED; PG8_LDA(At, 1, 0); PG8_STAGE(PG8_SA(0, 1), a2 + hstepA, voffA);
            PG8_WAIT_V(8); PG8_WAIT_L(0); PG8_BAR; PG8_MMA(0, 0, At, B0); PG8_MMA(0, 1, At, B1); PG8_BAR; PG8_SCHED;
            PG8_LDA(At, 1, 1); PG8_STAGE(PG8_SB(1, 0), b3, voffB); PG8_STAGE(PG8_SB(1, 1), b3 + hstepB, voffB); PG8_STAGE(PG8_SA(1, 0), a3, voffA);
            PG8_WAIT_V(8); PG8_WAIT_L(0); PG8_BAR; PG8_MMA(1, 0, At, B0); PG8_MMA(1, 1, At, B1); PG8_BAR; PG8_SCHED;
        }
        if (wr == 0) PG8_BAR;
        epi_store(acc, cur, wr, wc, fr, fq, e);
        if (!has_next) break;
#pragma unroll
        for (int a = 0; a < 2; ++a)
#pragma unroll
            for (int b = 0; b < 2; ++b)
#pragma unroll
                for (int m = 0; m < 4; ++m)
#pragma unroll
                    for (int n = 0; n < 2; ++n) acc[a][b][m][n] = (f32x4){0.f, 0.f, 0.f, 0.f};
        cur = nxt; cA = nA; cB = nB; ++ui;
        if (wr == 1) PG8_BAR;
    }
    PG8_WAIT_V(0);
    PG8_BAR;
#undef UNIT_A
#undef UNIT_B
#undef PG8_SA
#undef PG8_SB
#undef PG8_STAGE
#undef PG8_LDA
#undef PG8_LDB
#undef PG8_MMA
#undef PG8_WAIT_V
#undef PG8_WAIT_L
#undef PG8_BAR
#undef PG8_SCHED
}

#define SBAR() __builtin_amdgcn_sched_barrier(0)
__device__ __forceinline__ int crow(int r, int hi) { return (r & 3) + 8 * (r >> 2) + 4 * hi; }
__device__ __forceinline__ int v_st(int k, int c) { const int kk = (k & ~0xC) | ((k & 4) << 1) | ((k & 8) >> 1); return ((kk >> 3) * 4 + (c >> 5)) * 512 + ((kk & 7) * 32 + (c & 31)) * 2; }
__device__ __forceinline__ int v_rd_base(int lane) { return ((lane & 3) << 3) | (((lane >> 2) & 3) << 6) | (((lane >> 4) & 1) << 5) | (((lane >> 5) & 1) << 8); }
constexpr int v_rd_off(int d0, int ks, int half) { return d0 * 512 + ks * 4096 + half * 2048; }
template <int OFF> __device__ __forceinline__ s16x4 tr_read(int vb) { s16x4 r; asm volatile("ds_read_b64_tr_b16 %0, %1 offset:%2" : "=&v"(r) : "v"(vb), "i"(OFF) : "memory"); return r; }
template <int D0> __device__ __forceinline__ void pv_one(f32x16& od, int vb, bf16x8 pa0, bf16x8 pa1, bf16x8 pa2, bf16x8 pa3) {
    const s16x4 l0 = tr_read<v_rd_off(D0, 0, 0)>(vb), h0 = tr_read<v_rd_off(D0, 0, 1)>(vb), l1 = tr_read<v_rd_off(D0, 1, 0)>(vb), h1 = tr_read<v_rd_off(D0, 1, 1)>(vb);
    const s16x4 l2 = tr_read<v_rd_off(D0, 2, 0)>(vb), h2 = tr_read<v_rd_off(D0, 2, 1)>(vb), l3 = tr_read<v_rd_off(D0, 3, 0)>(vb), h3 = tr_read<v_rd_off(D0, 3, 1)>(vb);
    asm volatile("s_waitcnt lgkmcnt(0)" ::: "memory"); SBAR();
#define PK(L, H) (bf16x8){L[0], L[1], L[2], L[3], H[0], H[1], H[2], H[3]}
    od = __builtin_amdgcn_mfma_f32_32x32x16_bf16(pa0, PK(l0, h0), od, 0, 0, 0);
    od = __builtin_amdgcn_mfma_f32_32x32x16_bf16(pa1, PK(l1, h1), od, 0, 0, 0);
    od = __builtin_amdgcn_mfma_f32_32x32x16_bf16(pa2, PK(l2, h2), od, 0, 0, 0);
    od = __builtin_amdgcn_mfma_f32_32x32x16_bf16(pa3, PK(l3, h3), od, 0, 0, 0);
#undef PK
}
__device__ __forceinline__ void pv_d0(f32x16* o, int vb, bf16x8 pa0, bf16x8 pa1, bf16x8 pa2, bf16x8 pa3) {
    pv_one<0>(o[0], vb, pa0, pa1, pa2, pa3); pv_one<1>(o[1], vb, pa0, pa1, pa2, pa3); pv_one<2>(o[2], vb, pa0, pa1, pa2, pa3); pv_one<3>(o[3], vb, pa0, pa1, pa2, pa3);
}
__device__ __forceinline__ void partialSM(f32x16& p0, f32x16& p1, float& m_reg, float& mn, float& alpha, const float C, const float thr) {
    float pmax = p0[0];
#pragma unroll
    for (int r = 1; r < 16; ++r) pmax = fmaxf(pmax, p0[r]);
#pragma unroll
    for (int r = 0; r < 16; ++r) pmax = fmaxf(pmax, p1[r]);
    { auto rr = __builtin_amdgcn_permlane32_swap(__float_as_uint(pmax), __float_as_uint(pmax), false, false);
      pmax = fmaxf(__uint_as_float(rr[0]), __uint_as_float(rr[1])); }
    if (__builtin_expect(__all(pmax - m_reg <= thr), 1)) { mn = m_reg; alpha = 1.f; }
    else { mn = fmaxf(m_reg, pmax); alpha = __builtin_amdgcn_exp2f((m_reg - mn) * C); m_reg = mn; }
    const float mnC = -mn * C;
#pragma unroll
    for (int r = 0; r < 16; ++r) p0[r] = fmaf(p0[r], C, mnC);
#pragma unroll
    for (int r = 0; r < 16; ++r) p1[r] = fmaf(p1[r], C, mnC);
#pragma unroll
    for (int r = 0; r < 16; ++r) p0[r] = __builtin_amdgcn_exp2f(p0[r]);
}
__device__ __forceinline__ void finishSM(f32x16& p0, f32x16& p1, float alpha, float& l_reg, bf16x8& pa0, bf16x8& pa1, bf16x8& pa2, bf16x8& pa3) {
#pragma unroll
    for (int r = 0; r < 16; ++r) p1[r] = __builtin_amdgcn_exp2f(p1[r]);
    float ps = 0;
#pragma unroll
    for (int r = 0; r < 16; ++r) ps += p0[r];
#pragma unroll
    for (int r = 0; r < 16; ++r) ps += p1[r];
    { auto rr = __builtin_amdgcn_permlane32_swap(__float_as_uint(ps), __float_as_uint(ps), false, false);
      ps = __uint_as_float(rr[0]) + __uint_as_float(rr[1]); }
    l_reg = l_reg * alpha + ps;
#define PK4(P, BASE, OUT) do { unsigned a0 = cvt_pk_bf16(P[BASE + 0], P[BASE + 1]), a1 = cvt_pk_bf16(P[BASE + 2], P[BASE + 3]);   \
    unsigned b0 = cvt_pk_bf16(P[BASE + 4], P[BASE + 5]), b1 = cvt_pk_bf16(P[BASE + 6], P[BASE + 7]);                              \
    auto r0 = __builtin_amdgcn_permlane32_swap(a0, b0, false, false); auto r1 = __builtin_amdgcn_permlane32_swap(a1, b1, false, false); \
    u32x4 w = {r0[0], r1[0], r0[1], r1[1]}; OUT = *reinterpret_cast<bf16x8*>(&w); } while (0)
    PK4(p0, 0, pa0); PK4(p0, 8, pa1); PK4(p1, 0, pa2); PK4(p1, 8, pa3);
#undef PK4
}

struct AttnArgs {
    const bf16_t* Q; int ldq;
    const bf16_t* Kn; int ldk;
    const bf16_t* Kr; int ldkr;
    const bf16_t* V; int ldv;
    int lat0, ctx0, nlat, NT;
    float C, thr;
};

template <int DQK, int DK1, int LDQ, int LDK, int LDKR, int LDV, int NQL, int SDEPTH>
__device__ __forceinline__ void attn_core(const AttnArgs& a, char* lds, f32x16 (&o)[4]) {
    constexpr int KP = DQK * 2, SHM_K = 64 * KP, SHM_V = 64 * 128 * 2, KCH = DQK / 64, CPR = DQK / 8, ND0 = DQK / 16;
    const int tid = tid_opaque(), wid = tid >> 6, lane = tid & 63, r32 = lane & 31, hi = lane >> 5;
    char* V_lds = lds; char* K_lds = lds + 2 * SHM_V;
    float* wsf = (float*)(lds + 2 * SHM_V + 2 * SHM_K) + wid * 64; float* li_l = wsf; float* al_l = wsf + 32;
    float m_reg = -1e30f, l_reg = 0.f;
#pragma unroll
    for (int d = 0; d < 4; ++d)
#pragma unroll
        for (int r = 0; r < 16; ++r) o[d][r] = 0.f;
    constexpr int NQR = ND0 - NQL;
    bf16x8 qr[NQR];
    char* QL = lds + 2 * SHM_V + 2 * SHM_K + 2048 + tid * 16;
    { const bf16_t* Qw = a.Q + (long)(wid * 32 + r32) * LDQ + hi * 8;
#pragma unroll
      for (int d0 = 0; d0 < NQR; ++d0) qr[d0] = *(const bf16x8*)(Qw + d0 * 16);
#pragma unroll
      for (int d0 = NQR; d0 < ND0; ++d0) *(bf16x8*)(QL + (d0 - NQR) * 8192) = *(const bf16x8*)(Qw + d0 * 16); }
    const int sr = tid >> 4, sc = (tid & 15) * 8, vst0 = v_st(sr, sc), vst1 = v_st(32 + sr, sc);
    const int vb0 = (int)(uintptr_t)V_lds + v_rd_base(lane);
    const bf16_t* kptr[KCH]; int kld[KCH], kwo[KCH];
#pragma unroll
    for (int c = 0; c < KCH; ++c) { const int idx = tid + c * 512, kr_ = idx / CPR, kc = (idx % CPR) * 8;
        if (kc < DK1) { kptr[c] = a.Kn + (long)kr_ * LDK + kc; kld[c] = LDK; } else { kptr[c] = a.Kr + (long)kr_ * LDKR + (kc - DK1); kld[c] = LDKR; }
        kwo[c] = kr_ * KP + ((kc * 2) ^ ((kr_ & 7) << 4)); }
    struct { bf16x8 vs0, vs1, ks[KCH]; } sr_[SDEPTH];
    int kb[4];
#pragma unroll
    for (int m = 0; m < 4; ++m) kb[m] = r32 * KP + ((m * 32 + hi * 16) ^ ((r32 & 7) << 4));
#define KROW(j) ((j) < a.nlat ? a.lat0 + 64 * (j) : a.ctx0 + 64 * ((j) - a.nlat))
#define SLOAD(i, j) do { const long rb_ = KROW(j); sr_[i].vs0 = *(const bf16x8*)(a.V + (rb_ + sr) * LDV + sc); sr_[i].vs1 = *(const bf16x8*)(a.V + (rb_ + 32 + sr) * LDV + sc); \
    _Pragma("unroll") for (int c_ = 0; c_ < KCH; ++c_) sr_[i].ks[c_] = *(const bf16x8*)(kptr[c_] + rb_ * kld[c_]); } while (0)
#define SWRITE(b, i) do { *(bf16x8*)(V_lds + (b) * SHM_V + vst0) = sr_[i].vs0; *(bf16x8*)(V_lds + (b) * SHM_V + vst1) = sr_[i].vs1; \
    _Pragma("unroll") for (int c_ = 0; c_ < KCH; ++c_) *(bf16x8*)(K_lds + (b) * SHM_K + kwo[c_]) = sr_[i].ks[c_]; } while (0)
#define RESC(al) do { if (__any((al) < 1.f)) { if (hi == 0) al_l[r32] = (al); asm volatile("s_waitcnt lgkmcnt(0)" ::: "memory"); \
    _Pragma("unroll") for (int d = 0; d < 4; ++d) _Pragma("unroll") for (int r = 0; r < 16; ++r) o[d][r] *= al_l[crow(r, hi)]; } } while (0)
#define QKT(P0, P1, KB) do { P0 = f32x16{}; P1 = f32x16{}; \
    _Pragma("unroll") for (int d0 = 0; d0 < ND0; ++d0) { \
      const bf16x8 b0 = *(const bf16x8*)((KB) + kb[d0 & 3] + (d0 >> 2) * 128); \
      const bf16x8 b1 = *(const bf16x8*)((KB) + kb[d0 & 3] + (d0 >> 2) * 128 + 32 * KP); \
      const bf16x8 qf = (d0 < NQR) ? qr[d0 < NQR ? d0 : 0] : *(const bf16x8*)(QL + (d0 - NQR) * 8192); \
      P0 = __builtin_amdgcn_mfma_f32_32x32x16_bf16(b0, qf, P0, 0, 0, 0); \
      P1 = __builtin_amdgcn_mfma_f32_32x32x16_bf16(b1, qf, P1, 0, 0, 0); } } while (0)
    f32x16 pA0, pA1, pB0, pB1; float mnA, mnB, alA, alB; bf16x8 pa0, pa1, pa2, pa3; const int NT = a.NT;
    constexpr int SE = 0, SO = SDEPTH - 1;
    SLOAD(SE, 0); asm volatile("s_waitcnt vmcnt(0)" ::: "memory"); SWRITE(0, SE); __syncthreads();
    QKT(pA0, pA1, K_lds); partialSM(pA0, pA1, m_reg, mnA, alA, a.C, a.thr);
    SLOAD(SO, 1); if (SDEPTH == 2 && 2 < NT) SLOAD(SE, 2);
    SWRITE(1, SO); __syncthreads();
    for (int j = 1; j + 1 < NT; j += 2) {
        SBAR(); QKT(pB0, pB1, K_lds + SHM_K);
        finishSM(pA0, pA1, alA, l_reg, pa0, pa1, pa2, pa3); SBAR();
        SLOAD(SO, j + SDEPTH); SBAR();
        pv_d0(o, vb0, pa0, pa1, pa2, pa3); partialSM(pB0, pB1, m_reg, mnB, alB, a.C, a.thr);
        __syncthreads(); SWRITE(0, SE);
        RESC(alB); __syncthreads();
        SBAR(); QKT(pA0, pA1, K_lds);
        finishSM(pB0, pB1, alB, l_reg, pa0, pa1, pa2, pa3); SBAR();
        if (SDEPTH == 1 || j + 3 < NT) SLOAD(SE, j + 1 + SDEPTH); SBAR();
        pv_d0(o, vb0 + SHM_V, pa0, pa1, pa2, pa3); partialSM(pA0, pA1, m_reg, mnA, alA, a.C, a.thr);
        __syncthreads(); SWRITE(1, SO);
        RESC(alA); __syncthreads();
    }
    SBAR(); QKT(pB0, pB1, K_lds + SHM_K);
    finishSM(pA0, pA1, alA, l_reg, pa0, pa1, pa2, pa3); SBAR();
    pv_d0(o, vb0, pa0, pa1, pa2, pa3); partialSM(pB0, pB1, m_reg, mnB, alB, a.C, a.thr);
    __syncthreads(); RESC(alB);
    finishSM(pB0, pB1, alB, l_reg, pa0, pa1, pa2, pa3); SBAR();
    pv_d0(o, vb0 + SHM_V, pa0, pa1, pa2, pa3);
    if (hi == 0) li_l[r32] = l_reg; asm volatile("s_waitcnt lgkmcnt(0)" ::: "memory");
#pragma unroll
    for (int r = 0; r < 16; ++r) { const float rl = __builtin_amdgcn_rcpf(li_l[crow(r, hi)]);
#pragma unroll
        for (int d = 0; d < 4; ++d) o[d][r] *= rl; }
    __syncthreads();
#undef KROW
#undef SLOAD
#undef SWRITE
#undef RESC
#undef QKT
}

__device__ __forceinline__ void phase_attn_mla(const Params& p, char* lds) {
    const bf16_t* T1 = (const bf16_t*)(p.ws + WS_T1); bf16_t* O = (bf16_t*)(p.ws + WS_H);
    const int tid = tid_opaque(), wid = tid >> 6, lane = tid & 63, r32 = lane & 31, hi = lane >> 5;
    const float scale = 0.07216878364870322f;
    for (int it = blockIdx.x; it < 1024 + 128; it += gridDim.x) {
        int b, h, row0; AttnArgs a;
        if (it < 1024) {
            int itm = it;
            if (gridDim.x == 256) { const int w = it & 255, rnd = it >> 8, xcd = w & 7, slot = w >> 3; itm = ((rnd * 32 + xcd * 4 + (slot >> 3)) << 3) | (slot & 7); }
            b = itm >> 6; h = (itm >> 3) & 7; const int qb = itm & 7; row0 = b * SEQ + qb * 256; a.nlat = 32; a.NT = 36; }
        else { const int i2 = it - 1024; b = i2 >> 3; h = i2 & 7; row0 = MLAT + b * CTXL; a.nlat = 0; a.NT = 4; }
        a.lat0 = b * SEQ; a.ctx0 = MLAT + b * CTXL;
        a.Q = T1 + T_Q + (size_t)row0 * 1536 + h * 192; a.ldq = 1536;
        a.Kn = T1 + T_KV + h * 256; a.ldk = 2048; a.Kr = T1 + T_KR; a.ldkr = 64;
        a.V = T1 + T_KV + h * 256 + 128; a.ldv = 2048;
        a.C = scale * 1.4426950408889634f; a.thr = 8.f / scale;
        f32x16 o[4];
        attn_core<192, 128, 1536, 2048, 64, 2048, MLA_NQL, 1>(a, lds, o);
        bf16_t* Ow = O + (size_t)(row0 + wid * 32 + 4 * hi) * 1024 + h * 128 + r32;
        asm volatile("" : "+v"(Ow));
#pragma unroll
        for (int r = 0; r < 16; ++r) { bf16_t* Or = Ow + (size_t)((r & 3) + 8 * (r >> 2)) * 1024;
#pragma unroll
            for (int d0 = 0; d0 < 4; ++d0) Or[d0 * 32] = (bf16_t)(cvt_pk_bf16(o[d0][r], 0.f) & 0xffffu); }
    }
}

__device__ __forceinline__ void phase_attn_diff(const Params& p, char* lds) {
    const bf16_t* T1 = (const bf16_t*)(p.ws + WS_T1); bf16_t* O = (bf16_t*)(p.ws + WS_H);
    const int tid = tid_opaque(), wid = tid >> 6, lane = tid & 63, r32 = lane & 31, hi = lane >> 5;
    float* scr0 = (float*)(p.ws + WS_SCR) + ((size_t)blockIdx.x * 512 + tid) * 64;
    const float scale = 0.125f;
    const float lam_init = 0.8f - 0.6f * 0.40656965974059917f;
    float lam;
    { const float* lv = p.diff_lambda; float s1 = 0.f, s2 = 0.f;
      for (int k = 0; k < 64; ++k) { s1 += lv[k] * lv[64 + k]; s2 += lv[128 + k] * lv[192 + k]; }
      lam = expf(s1) - expf(s2) + lam_init; }
    float gs[4];
#pragma unroll
    for (int d0 = 0; d0 < 4; ++d0) gs[d0] = p.diff_g_subln[d0 * 32 + r32] * (1.0f - lam_init);
    for (int it = blockIdx.x; it < 1024; it += gridDim.x) {
        int itm = it;
        if (gridDim.x == 256) { const int w = it & 255, rnd = it >> 8, xcd = w & 7, slot = w >> 3; itm = ((rnd * 32 + xcd * 4 + (slot >> 3)) << 3) | (slot & 7); }
        const int b = itm >> 6, h = (itm >> 3) & 7, qb = itm & 7, row0 = b * SEQ + qb * 256;
#pragma unroll 1
        for (int j = 0; j < 2; ++j) {
            AttnArgs a; a.nlat = 32; a.NT = 36; a.lat0 = b * SEQ; a.ctx0 = MLAT + b * CTXL;
            a.Q = T1 + (size_t)row0 * 3072 + h * 128 + j * 64; a.ldq = 3072;
            a.Kn = T1 + 1024 + h * 128 + j * 64; a.ldk = 3072; a.Kr = a.Kn; a.ldkr = 3072;
            a.V = T1 + 2048 + h * 128; a.ldv = 3072;
            a.C = scale * 1.4426950408889634f; a.thr = 8.f / scale;
            f32x16 o[4];
            attn_core<64, 64, 3072, 3072, 3072, 3072, 0, 2>(a, lds, o);
            float* scr = scr0; asm volatile("" : "+v"(scr));
            if (j == 0) {
#pragma unroll
                for (int r = 0; r < 16; ++r) { f32x4 t = {o[0][r], o[1][r], o[2][r], o[3][r]}; *(f32x4*)(scr + 4 * r) = t; }
            } else {
                bf16_t* Ow = O + (size_t)(row0 + wid * 32 + 4 * hi) * 1024 + h * 128 + r32;
                asm volatile("" : "+v"(Ow));
#pragma unroll
                for (int r = 0; r < 16; ++r) {
                    const f32x4 t = *(const f32x4*)(scr + 4 * r);
                    const float v0 = t[0] - lam * o[0][r], v1 = t[1] - lam * o[1][r], v2 = t[2] - lam * o[2][r], v3 = t[3] - lam * o[3][r];
                    float ss = v0 * v0 + v1 * v1 + v2 * v2 + v3 * v3;
#pragma unroll
                    for (int x = 16; x >= 1; x >>= 1) ss += __shfl_xor(ss, x);
                    const float rs = rsqrtf(ss * (1.0f / 128.0f) + EPS);
                    bf16_t* Or = Ow + (size_t)((r & 3) + 8 * (r >> 2)) * 1024;
                    Or[0] = (bf16_t)(cvt_pk_bf16(v0 * rs * gs[0], 0.f) & 0xffffu); Or[32] = (bf16_t)(cvt_pk_bf16(v1 * rs * gs[1], 0.f) & 0xffffu);
                    Or[64] = (bf16_t)(cvt_pk_bf16(v2 * rs * gs[2], 0.f) & 0xffffu); Or[96] = (bf16_t)(cvt_pk_bf16(v3 * rs * gs[3], 0.f) & 0xffffu);
                }
            }
        }
    }
}

__device__ __forceinline__ const float* xin_row(const Params& p, int row, bool from_input) {
    if (from_input) return row < MLAT ? p.x + (size_t)row * DM : p.ctx + (size_t)(row - MLAT) * DM;
    return row < MLAT ? p.out + (size_t)row * DM : (const float*)(p.ws + WS_XC) + (size_t)(row - MLAT) * DM;
}
__device__ __forceinline__ float* xout_row(const Params& p, int row) {
    return row < MLAT ? p.out + (size_t)row * DM : (float*)(p.ws + WS_XC) + (size_t)(row - MLAT) * DM;
}

__device__ __forceinline__ void phase_rn(const Params& p, int layer, int stage, const bf16_t* Y, int nrows, int npart) {
    const int tid = tid_opaque(), wid = tid >> 6, lane = tid & 63;
    const float* MOD = (const float*)(p.ws + WS_MOD); bf16_t* H = (bf16_t*)(p.ws + WS_H);
    const int gate_c = stage == 0 ? 2 : 5;
    const float* gA = p.norm_g + (layer * 4 + (stage == 0 ? 1 : 3)) * DM;
    const bool has_next = !(layer == 3 && stage == 1);
    const int nl = stage == 0 ? layer : layer + 1;
    const float* gB = p.norm_g + ((has_next ? nl : 0) * 4 + (stage == 0 ? 2 : 0)) * DM;
    const int sh_c = stage == 0 ? 3 : 0, sc_c = stage == 0 ? 4 : 1;
    const bool from_input = (layer == 0 && stage == 0);
    for (int row = (blockIdx.x * 8 + wid) * 2; row < nrows; row += gridDim.x * 16) {
        const int mr = modrow(row);
        const float* xi = xin_row(p, row, from_input); float* xo = xout_row(p, row);
        const bf16_t* y = Y + (size_t)row * DM;
        const float* mg = MOD + ((size_t)layer * 17 + mr) * 6144 + gate_c * DM;
        u32x2 yw[2][4]; f32x4 xx[2][4], gg[4], gt[4];
#pragma unroll
        for (int q = 0; q < 2; ++q)
#pragma unroll
            for (int i = 0; i < 4; ++i) { yw[q][i] = *(const u32x2*)(y + q * DM + i * 256 + lane * 4); xx[q][i] = *(const f32x4*)(xi + q * DM + i * 256 + lane * 4); }
#pragma unroll
        for (int i = 0; i < 4; ++i) { gg[i] = *(const f32x4*)(gA + i * 256 + lane * 4); gt[i] = *(const f32x4*)(mg + i * 256 + lane * 4); }
        float yv[2][16]; float ss[2] = {0.f, 0.f};
#pragma unroll
        for (int q = 0; q < 2; ++q)
#pragma unroll
            for (int i = 0; i < 4; ++i) { yv[q][4 * i] = bf_lo(yw[q][i].x); yv[q][4 * i + 1] = bf_hi(yw[q][i].x); yv[q][4 * i + 2] = bf_lo(yw[q][i].y); yv[q][4 * i + 3] = bf_hi(yw[q][i].y); }
        if (npart > 1 && row >= MLAT) {
            const bf16_t* yp = (const bf16_t*)(p.ws + WS_SCR) + (size_t)(row - MLAT) * DM;
#pragma unroll
            for (int q = 0; q < 2; ++q)
#pragma unroll
                for (int i = 0; i < 4; ++i) { float a4[4] = {0.f, 0.f, 0.f, 0.f};
                    for (int k = 0; k < npart; ++k) { float t4[4]; load_bf4(yp + (size_t)k * MCTX * DM + q * DM + i * 256 + lane * 4, t4); a4[0] += t4[0]; a4[1] += t4[1]; a4[2] += t4[2]; a4[3] += t4[3]; }
                    yv[q][4 * i] = a4[0]; yv[q][4 * i + 1] = a4[1]; yv[q][4 * i + 2] = a4[2]; yv[q][4 * i + 3] = a4[3]; }
        }
#pragma unroll
        for (int q = 0; q < 2; ++q)
#pragma unroll
            for (int i = 0; i < 16; ++i) ss[q] += yv[q][i] * yv[q][i];
#pragma unroll
        for (int o = 32; o >= 1; o >>= 1) { ss[0] += __shfl_xor(ss[0], o); ss[1] += __shfl_xor(ss[1], o); }
        float ss2[2] = {0.f, 0.f};
#pragma unroll
        for (int q = 0; q < 2; ++q) { const float r1 = rsqrtf(ss[q] * (1.0f / DM) + EPS);
#pragma unroll
            for (int i = 0; i < 4; ++i) { f32x4 xn;
#pragma unroll
                for (int j = 0; j < 4; ++j) { xn[j] = xx[q][i][j] + gt[i][j] * (yv[q][4 * i + j] * r1 * gg[i][j]); ss2[q] += xn[j] * xn[j]; }
                xx[q][i] = xn; *(f32x4*)(xo + q * DM + i * 256 + lane * 4) = xn; } }
        if (has_next) {
            const float* msh = MOD + ((size_t)nl * 17 + mr) * 6144 + sh_c * DM; const float* msc = MOD + ((size_t)nl * 17 + mr) * 6144 + sc_c * DM;
            f32x4 gb[4], sh[4], sc[4];
#pragma unroll
            for (int i = 0; i < 4; ++i) { gb[i] = *(const f32x4*)(gB + i * 256 + lane * 4); sh[i] = *(const f32x4*)(msh + i * 256 + lane * 4); sc[i] = *(const f32x4*)(msc + i * 256 + lane * 4); }
#pragma unroll
            for (int o = 32; o >= 1; o >>= 1) { ss2[0] += __shfl_xor(ss2[0], o); ss2[1] += __shfl_xor(ss2[1], o); }
#pragma unroll
            for (int q = 0; q < 2; ++q) { const float r2 = rsqrtf(ss2[q] * (1.0f / DM) + EPS);
#pragma unroll
                for (int i = 0; i < 4; ++i) { float hv[4];
#pragma unroll
                    for (int j = 0; j < 4; ++j) hv[j] = (xx[q][i][j] * r2 * gb[i][j]) * (1.0f + sc[i][j]) + sh[i][j];
                    store_bf4(H + (size_t)(row + q) * DM + i * 256 + lane * 4, hv[0], hv[1], hv[2], hv[3]); } }
        }
    }
}

template <int I> __device__ __forceinline__ void poold_group(const float* xb, const float* RSs, int t0, int len, int lane, const float* g0, const float* msc, bf16_t* Hrow0) {
    constexpr int W = 2 << I, LO = W / 2, HI = W - 1 - LO, NR = 8 + W - 1;
    const int col = I * 256 + lane * 4;
    f32x4 xs[NR];
#pragma unroll
    for (int k = 0; k < NR; ++k) { const int tt = t0 - LO + k; const bool ok = (tt >= 0 && tt < len); const int tc = ok ? tt : t0;
        const f32x4 xx = *(const f32x4*)(xb + (size_t)tc * DM + col); const float rs = ok ? RSs[tc] : 0.f; xs[k] = xx * rs; }
    const f32x4 gg = *(const f32x4*)(g0 + col), sc = *(const f32x4*)(msc + col);
    f32x4 gm;
#pragma unroll
    for (int j = 0; j < 4; ++j) gm[j] = gg[j] * (1.0f + sc[j]);
    f32x4 S = xs[0];
#pragma unroll
    for (int k = 1; k < W; ++k) S += xs[k];
#pragma unroll
    for (int r = 0; r < 8; ++r) {
        const int t = t0 + r; const int ta = max(t - LO, 0), tb = min(t + HI + 1, len); const float inv = 1.0f / (float)(tb - ta);
        const f32x4 d = (S * inv - xs[r + LO]) * gm;
        store_bf4(Hrow0 + (size_t)r * DM + col, d[0], d[1], d[2], d[3]);
        if (r < 7) S += xs[r + W] - xs[r];
    }
}
__device__ __forceinline__ void phase_poold(const Params& p) {
    const int tid = tid_opaque(), wid = tid >> 6, lane = tid & 63;
    const float* MOD = (const float*)(p.ws + WS_MOD); const float* RS = (const float*)(p.ws + WS_RS); bf16_t* H = (bf16_t*)(p.ws + WS_H);
    const float* g0 = p.norm_g;
    for (int task = blockIdx.x * 8 + wid; task < (MALL / 8) * 4; task += gridDim.x * 8) {
        const int row = (task >> 2) * 8, grp = task & 3;
        const int mr = modrow(row);
        const int s0 = row < MLAT ? (row & ~(SEQ - 1)) : MLAT + ((row - MLAT) & ~(CTXL - 1)); const int len = row < MLAT ? SEQ : CTXL; const int t0 = row - s0;
        const float* xb = row < MLAT ? p.x + (size_t)s0 * DM : p.ctx + (size_t)(s0 - MLAT) * DM;
        const float* msc = MOD + ((size_t)0 * 17 + mr) * 6144 + 1 * DM;
        bf16_t* Hr = H + (size_t)row * DM;
        if (grp == 0) poold_group<0>(xb, RS + s0, t0, len, lane, g0, msc, Hr);
        else if (grp == 1) poold_group<1>(xb, RS + s0, t0, len, lane, g0, msc, Hr);
        else if (grp == 2) poold_group<2>(xb, RS + s0, t0, len, lane, g0, msc, Hr);
        else poold_group<3>(xb, RS + s0, t0, len, lane, g0, msc, Hr);
    }
}

__device__ __forceinline__ void phase_conv(const Params& p) {
    const int tid = tid_opaque(), wid = tid >> 6, lane = tid & 63;
    const bf16_t* T1 = (const bf16_t*)(p.ws + WS_T1); bf16_t* H = (bf16_t*)(p.ws + WS_H);
    for (int task = blockIdx.x * 8 + wid; task < (MALL / 8) * 4; task += gridDim.x * 8) {
        const int row = (task >> 2) * 8;
        const int s0 = row < MLAT ? (row & ~(SEQ - 1)) : MLAT + ((row - MLAT) & ~(CTXL - 1)); const int len = row < MLAT ? SEQ : CTXL; const int t0 = row - s0;
        { const int i = task & 3;
            const int col = i * 256 + lane * 4;
            u32x2 cw[10], vw[10], bw[8];
#pragma unroll
            for (int k = 0; k < 10; ++k) { const int tt = t0 - 1 + k; const bool ok = (tt >= 0 && tt < len); const int tc = ok ? tt : t0;
                const bf16_t* rp = T1 + (size_t)(s0 + tc) * 3072; cw[k] = *(const u32x2*)(rp + 1024 + col); vw[k] = *(const u32x2*)(rp + 2048 + col);
                if (!ok) { cw[k].x = 0u; cw[k].y = 0u; } }
#pragma unroll
            for (int r = 0; r < 8; ++r) bw[r] = *(const u32x2*)(T1 + (size_t)(row + r) * 3072 + col);
            const f32x4 w0 = *(const f32x4*)(p.conv_w + col), w1 = *(const f32x4*)(p.conv_w + DM + col), w2 = *(const f32x4*)(p.conv_w + 2 * DM + col);
            f32x4 u[10];
#pragma unroll
            for (int k = 0; k < 10; ++k) { u[k][0] = bf_lo(cw[k].x) * bf_lo(vw[k].x); u[k][1] = bf_hi(cw[k].x) * bf_hi(vw[k].x); u[k][2] = bf_lo(cw[k].y) * bf_lo(vw[k].y); u[k][3] = bf_hi(cw[k].y) * bf_hi(vw[k].y); }
#pragma unroll
            for (int r = 0; r < 8; ++r) { const f32x4 z = u[r] * w0 + u[r + 1] * w1 + u[r + 2] * w2;
                store_bf4(H + (size_t)(row + r) * DM + col, bf_lo(bw[r].x) * z[0], bf_hi(bw[r].x) * z[1], bf_lo(bw[r].y) * z[2], bf_hi(bw[r].y) * z[3]); }
        }
    }
}

__device__ __forceinline__ void phase_mlaprep(const Params& p) {
    const int tid = tid_opaque(), wid = tid >> 6, lane = tid & 63;
    bf16_t* T1 = (bf16_t*)(p.ws + WS_T1); bf16_t* CKV = (bf16_t*)(p.ws + WS_H); const float* rope = (const float*)(p.ws + WS_ROPE);
    for (int row4 = (blockIdx.x * 8 + wid) * 4; row4 < MALL; row4 += gridDim.x * 32) {
      u32x2 araw[4][3];
#pragma unroll
      for (int q = 0; q < 4; ++q)
#pragma unroll
        for (int i = 0; i < 3; ++i) araw[q][i] = *(const u32x2*)(T1 + T_AB + (size_t)(row4 + q) * 768 + i * 256 + lane * 4);
#pragma unroll
      for (int q = 0; q < 4; ++q) {
        const int row = row4 + q;
        float v[12]; float sq = 0.f, skv = 0.f;
#pragma unroll
        for (int i = 0; i < 3; ++i) { const int col = i * 256 + lane * 4; v[4 * i] = bf_lo(araw[q][i].x); v[4 * i + 1] = bf_hi(araw[q][i].x); v[4 * i + 2] = bf_lo(araw[q][i].y); v[4 * i + 3] = bf_hi(araw[q][i].y);
            const float s = v[4 * i] * v[4 * i] + v[4 * i + 1] * v[4 * i + 1] + v[4 * i + 2] * v[4 * i + 2] + v[4 * i + 3] * v[4 * i + 3];
            if (col < 384) sq += s; else if (col < 640) skv += s; }
        sq = wave_sum(sq); skv = wave_sum(skv);
        const float rq = rsqrtf(sq * (1.0f / 384.0f) + EPS), rkv = rsqrtf(skv * (1.0f / 256.0f) + EPS);
#pragma unroll
        for (int i = 0; i < 3; ++i) { const int col = i * 256 + lane * 4;
            if (col < 384) { const f32x4 g = *(const f32x4*)(p.mla_g_q + col);
                store_bf4(T1 + T_CQ + (size_t)row * 384 + col, v[4 * i] * rq * g[0], v[4 * i + 1] * rq * g[1], v[4 * i + 2] * rq * g[2], v[4 * i + 3] * rq * g[3]); }
            else if (col < 640) { const int c2 = col - 384; const f32x4 g = *(const f32x4*)(p.mla_g_kv + c2);
                store_bf4(CKV + (size_t)row * 256 + c2, v[4 * i] * rkv * g[0], v[4 * i + 1] * rkv * g[1], v[4 * i + 2] * rkv * g[2], v[4 * i + 3] * rkv * g[3]); }
        }
        {
            float pv[4];
#pragma unroll
            for (int j = 0; j < 4; ++j) pv[j] = __shfl_xor(v[8 + j], 4);
            if (lane >= 32 && lane < 48) {
                const int k = lane - 32; float ov[4];
                if (row < MLAT) {
                    const int t = row & (SEQ - 1); const int pos = (k < 8) ? (t >> 6) : (t & 63);
                    const f32x4 t0 = *(const f32x4*)(rope + (pos * 16 + 4 * (k & 3)) * 2), t1 = *(const f32x4*)(rope + (pos * 16 + 4 * (k & 3)) * 2 + 4);
                    const float cs[4] = {t0[0], t0[2], t1[0], t1[2]}, sn[4] = {t0[1], t0[3], t1[1], t1[3]};
#pragma unroll
                    for (int j = 0; j < 4; ++j) ov[j] = (k & 4) ? (v[8 + j] * cs[j] + pv[j] * sn[j]) : (v[8 + j] * cs[j] - pv[j] * sn[j]);
                } else {
#pragma unroll
                    for (int j = 0; j < 4; ++j) ov[j] = v[8 + j];
                }
                store_bf4(T1 + T_KR + (size_t)row * 64 + 4 * k, ov[0], ov[1], ov[2], ov[3]);
            }
        }
      }
    }
}

__device__ __forceinline__ void conv_wt(const float* src, int K, int N, int Npad, bf16_t* dst, float* tile, int rot) {
    const int tid = tid_opaque(), G = gridDim.x;
    const int ntn = Npad / 64, ntk = K / 64, ntiles = ntn * ntk;
    const int r = tid >> 4, c4 = (tid & 15) * 4;
    int u = (blockIdx.x + G - (rot % G)) % G;
    f32x4 v0 = {0.f, 0.f, 0.f, 0.f}, v1 = {0.f, 0.f, 0.f, 0.f};
    if (u < ntiles) { const int k0 = (u / ntn) * 64, n0 = (u % ntn) * 64;
        if (n0 + c4 < N) { v0 = *(const f32x4*)(src + (size_t)(k0 + r) * N + n0 + c4); v1 = *(const f32x4*)(src + (size_t)(k0 + r + 32) * N + n0 + c4); } }
    for (; u < ntiles; u += G) {
        const int k0 = (u / ntn) * 64, n0 = (u % ntn) * 64;
        const int un = u + G; f32x4 w0 = {0.f, 0.f, 0.f, 0.f}, w1 = {0.f, 0.f, 0.f, 0.f};
        if (un < ntiles) { const int k1 = (un / ntn) * 64, n1 = (un % ntn) * 64;
            if (n1 + c4 < N) { w0 = *(const f32x4*)(src + (size_t)(k1 + r) * N + n1 + c4); w1 = *(const f32x4*)(src + (size_t)(k1 + r + 32) * N + n1 + c4); } }
        tile[r * 65 + c4 + 0] = v0[0]; tile[r * 65 + c4 + 1] = v0[1]; tile[r * 65 + c4 + 2] = v0[2]; tile[r * 65 + c4 + 3] = v0[3];
        tile[(r + 32) * 65 + c4 + 0] = v1[0]; tile[(r + 32) * 65 + c4 + 1] = v1[1]; tile[(r + 32) * 65 + c4 + 2] = v1[2]; tile[(r + 32) * 65 + c4 + 3] = v1[3];
        __syncthreads();
        { const int n = tid >> 3, k8 = (tid & 7) * 8; float t[8];
#pragma unroll
          for (int j = 0; j < 8; ++j) t[j] = tile[(k8 + j) * 65 + n];
          u32x4 w; w.x = cvt_pk_bf16(t[0], t[1]); w.y = cvt_pk_bf16(t[2], t[3]); w.z = cvt_pk_bf16(t[4], t[5]); w.w = cvt_pk_bf16(t[6], t[7]);
          *(u32x4*)(dst + (size_t)(n0 + n) * K + k0 + k8) = w; }
        __syncthreads();
        v0 = w0; v1 = w1;
    }
}

__device__ __forceinline__ void phase_prep(const Params& p, char* lds) {
    const int tid = tid_opaque(), wid = tid >> 6, lane = tid & 63, G = gridDim.x;
    float* fl = (float*)lds;
    if (blockIdx.x < 192) {
        { f32x4 cvv[9];
#pragma unroll
          for (int q = 0; q < 9; ++q) { const int idx = tid + q * NTHREADS; const int r = idx >> 8, k4 = (idx & 255) * 4; cvv[q] = (idx < 17 * 256) ? *(const f32x4*)(r < 16 ? p.c + r * 1024 + k4 : p.c_ctx + k4) : (f32x4){0.f, 0.f, 0.f, 0.f}; }
#pragma unroll
          for (int q = 0; q < 9; ++q) { const int idx = tid + q * NTHREADS; const int r = idx >> 8, k4 = (idx & 255) * 4;
              if (idx < 17 * 256) {
#pragma unroll
                  for (int j = 0; j < 4; ++j) fl[(k4 + j) * 17 + r] = cvv[q][j] / (1.0f + expf(-cvv[q][j])); } } }
        __syncthreads();
        float* MOD = (float*)(p.ws + WS_MOD);
        for (int u = blockIdx.x; u < 192; u += G) {
            const int layer = u / 48, cb = u % 48, col0 = cb * 128 + wid * 16 + (lane & 3) * 4, kq = lane >> 2;
            float acc[17][4];
#pragma unroll
            for (int r = 0; r < 17; ++r)
#pragma unroll
                for (int j = 0; j < 4; ++j) acc[r][j] = 0.f;
            const float* W = p.ada_w + (size_t)layer * 1024 * 6144 + col0;
#pragma unroll 8
            for (int itk = 0; itk < 64; ++itk) { const int k = kq + 16 * itk; const f32x4 w = *(const f32x4*)(W + (size_t)k * 6144);
#pragma unroll
                for (int r = 0; r < 17; ++r) { const float s_ = fl[k * 17 + r];
#pragma unroll
                    for (int j = 0; j < 4; ++j) acc[r][j] += s_ * w[j]; } }
#pragma unroll
            for (int r = 0; r < 17; ++r)
#pragma unroll
                for (int j = 0; j < 4; ++j) { float v = acc[r][j]; v += __shfl_xor(v, 4); v += __shfl_xor(v, 8); v += __shfl_xor(v, 16); v += __shfl_xor(v, 32); acc[r][j] = v; }
            if (kq == 0) { const f32x4 bb = *(const f32x4*)(p.ada_b + layer * 6144 + col0);
#pragma unroll
                for (int r = 0; r < 17; ++r) { f32x4 o = {acc[r][0] + bb[0], acc[r][1] + bb[1], acc[r][2] + bb[2], acc[r][3] + bb[3]}; *(f32x4*)(MOD + ((size_t)layer * 17 + r) * 6144 + col0) = o; } }
        }
        __syncthreads();
    }
    if (blockIdx.x == G - 1) {
        float* rt = (float*)(p.ws + WS_ROPE);
        for (int idx = tid; idx < 1024; idx += NTHREADS) { const int pos = idx >> 4, f = idx & 15; const float inv = powf(10000.0f, -(float)f / 16.0f); const float ang = (float)pos * inv;
            rt[idx * 2] = cosf(ang); rt[idx * 2 + 1] = sinf(ang); }
    }
    { float* RS = (float*)(p.ws + WS_RS);
      for (int row = (blockIdx.x * 8 + wid) * 4; row < MALL; row += G * 32) { const float* xi = xin_row(p, row, true); f32x4 xx[4][4];
#pragma unroll
          for (int q = 0; q < 4; ++q)
#pragma unroll
              for (int i = 0; i < 4; ++i) xx[q][i] = *(const f32x4*)(xi + q * DM + i * 256 + lane * 4);
          float ss[4] = {0.f, 0.f, 0.f, 0.f};
#pragma unroll
          for (int q = 0; q < 4; ++q)
#pragma unroll
              for (int i = 0; i < 4; ++i) ss[q] += xx[q][i][0] * xx[q][i][0] + xx[q][i][1] * xx[q][i][1] + xx[q][i][2] * xx[q][i][2] + xx[q][i][3] * xx[q][i][3];
#pragma unroll
          for (int o = 32; o >= 1; o >>= 1) { ss[0] += __shfl_xor(ss[0], o); ss[1] += __shfl_xor(ss[1], o); ss[2] += __shfl_xor(ss[2], o); ss[3] += __shfl_xor(ss[3], o); }
          if (lane < 4) RS[row + lane] = rsqrtf((lane == 0 ? ss[0] : lane == 1 ? ss[1] : lane == 2 ? ss[2] : ss[3]) * (1.0f / DM) + EPS); } }
    bf16_t* W = (bf16_t*)(p.ws + WS_W);
    int rot = 192;
    for (int l = 0; l < 4; ++l) {
        conv_wt(p.ffn_w1 + (size_t)l * 1024 * 4096, 1024, 4096, 4096, W + W_FFN + (size_t)l * 8388608, fl, rot); rot += 1024;
        conv_wt(p.ffn_w2 + (size_t)l * 4096 * 1024, 4096, 1024, 1024, W + W_FFN + (size_t)l * 8388608 + 4194304, fl, rot); rot += 1024;
    }
    for (int g = 0; g < 4; ++g) { conv_wt(p.pool_w + (size_t)g * 65536, 256, 256, 256, W + W_POOL + (size_t)g * 65536, fl, rot); rot += 16; }
    conv_wt(p.conv_in_w, 1024, 3072, 3072, W + W_CIN, fl, rot); rot += 768;
    conv_wt(p.conv_out_w, 1024, 1024, 1024, W + W_COUT, fl, rot); rot += 256;
    conv_wt(p.mla_w_down, 1024, 704, 768, W + W_DOWN, fl, rot); rot += 192;
    conv_wt(p.mla_w_uq, 384, 1536, 1536, W + W_UQ, fl, rot); rot += 144;
    conv_wt(p.mla_w_ukv, 256, 2048, 2048, W + W_UKV, fl, rot); rot += 128;
    conv_wt(p.mla_w_o, 1024, 1024, 1024, W + W_MO, fl, rot); rot += 256;
    conv_wt(p.diff_w_qkv, 1024, 3072, 3072, W + W_DQKV, fl, rot); rot += 768;
    conv_wt(p.diff_w_o, 1024, 1024, 1024, W + W_DO, fl, rot);
}

__device__ __forceinline__ void grid_barrier(unsigned* cnt, unsigned target) {
    asm volatile("s_waitcnt vmcnt(0) lgkmcnt(0)" ::: "memory");
    __syncthreads();
    if (threadIdx.x < 64) {
        if (threadIdx.x == 0) {
            __builtin_amdgcn_fence(__ATOMIC_RELEASE, "agent");
            asm volatile("s_waitcnt vmcnt(0)" ::: "memory");
            __hip_atomic_fetch_add(cnt, 1u, __ATOMIC_RELAXED, __HIP_MEMORY_SCOPE_AGENT);
            while (__hip_atomic_load(cnt, __ATOMIC_RELAXED, __HIP_MEMORY_SCOPE_AGENT) < target) __builtin_amdgcn_s_sleep(1);
        }
        __builtin_amdgcn_fence(__ATOMIC_ACQUIRE, "agent");
        asm volatile("s_waitcnt vmcnt(0)" ::: "memory");
    }
    __syncthreads();
}

enum { T_PREP = 0, T_POOLD, T_GEMM, T_RN, T_CONV, T_MLAPREP, T_ATTN_MLA, T_ATTN_DIFF };
constexpr int N_PHASES = 31;

__global__ void __launch_bounds__(NTHREADS, 2) mk_fwd(Params p_arg) {
    extern __shared__ __attribute__((aligned(16))) unsigned char shm[];
    LAS unsigned char* ldsl = (LAS unsigned char*)shm; char* ldsg = (char*)shm;
    const int ph_lo = p_arg.ph_lo, ph_hi = p_arg.ph_hi; unsigned char* const wsb = p_arg.ws;
    bf16_t* H = (bf16_t*)(wsb + WS_H); bf16_t* T1 = (bf16_t*)(wsb + WS_T1); const bf16_t* W = (const bf16_t*)(wsb + WS_W);
    const float* rope = (const float*)(wsb + WS_ROPE);
    unsigned nbar = 0; unsigned* barcnt = (unsigned*)(wsb + WS_BAR);
    for (int ph = ph_lo; ph < ph_hi; ++ph) {
#if defined(__HIP_DEVICE_COMPILE__)
        typedef const __attribute__((address_space(4))) Params* KArgP;
        KArgP pp = (KArgP)__builtin_amdgcn_kernarg_segment_ptr(); asm volatile("" : "+s"(pp));
        const Params p = *pp;
#else
        const Params p = p_arg;
#endif
        int type = T_GEMM, sync = 1, layer = 0, stage = 0, nrows = MALL, npart = 1; const bf16_t* Y = T1;
        GemmP g; g.A = H; g.Bt = W; g.lda = 1024; g.ldb = 1024; g.K = 1024; g.nM = 144; g.nN = 4; g.a_pn_off = 0; g.ksplit = 1; g.a_tiled = 0; g.rev = 0; g.magicN = 16384;
        EpiP e; e.O = T1; e.ldo = 1024; e.mode = 0; e.colscale = nullptr; e.rope = rope; e.Opart = (bf16_t*)(wsb + WS_SCR);
        switch (ph) {
        case 0: type = T_PREP; break;
        case 1: type = T_POOLD; break;
        case 2: g.Bt = W + W_POOL; g.ldb = 256; g.K = 256; g.a_pn_off = 256; e.colscale = p.pool_scale; break;
        case 3: type = T_RN; layer = 0; stage = 0; Y = T1; break;
        case 4: case 11: case 21: case 28: { const int l = ph == 4 ? 0 : ph == 11 ? 1 : ph == 21 ? 2 : 3;
            g.Bt = W + W_FFN + (size_t)l * 8388608; g.nN = 16; g.magicN = 4096; g.nM = l == 3 ? 128 : 144; e.ldo = 4096; e.mode = 1; } break;
        case 5: case 12: case 22: case 29: { const int l = ph == 5 ? 0 : ph == 12 ? 1 : ph == 22 ? 2 : 3;
            g.A = T1; g.lda = 4096; g.Bt = W + W_FFN + (size_t)l * 8388608 + 4194304; g.ldb = 4096; g.K = 4096; g.nM = l == 3 ? 128 : 144; g.ksplit = l == 3 ? 1 : 4; g.a_tiled = 1; e.O = H; } break;
        case 6: type = T_RN; layer = 0; stage = 1; Y = H; npart = 4; break;
        case 7: g.Bt = W + W_CIN; g.nN = 12; g.magicN = 5462; e.ldo = 3072; break;
        case 8: type = T_CONV; break;
        case 9: g.Bt = W + W_COUT; g.ksplit = 4; break;
        case 10: type = T_RN; layer = 1; stage = 0; Y = T1; npart = 4; break;
        case 13: type = T_RN; layer = 1; stage = 1; Y = H; npart = 4; break;
        case 14: g.Bt = W + W_DOWN; g.nN = 3; g.magicN = 21846; e.O = T1 + T_AB; e.ldo = 768; break;
        case 15: type = T_MLAPREP; break;
        case 16: g.A = T1 + T_CQ; g.lda = 384; g.Bt = W + W_UQ; g.ldb = 384; g.K = 384; g.nN = 6; g.magicN = 10923; e.O = T1 + T_Q; e.ldo = 1536; e.mode = 3; break;
        case 17: sync = 0; g.rev = 1; g.A = H; g.lda = 256; g.Bt = W + W_UKV; g.ldb = 256; g.K = 256; g.nN = 8; g.magicN = 8192; e.O = T1 + T_KV; e.ldo = 2048; break;
        case 18: type = T_ATTN_MLA; break;
        case 19: g.Bt = W + W_MO; g.ksplit = 4; break;
        case 20: type = T_RN; layer = 2; stage = 0; Y = T1; npart = 4; break;
        case 23: type = T_RN; layer = 2; stage = 1; Y = H; npart = 4; break;
        case 24: g.Bt = W + W_DQKV; g.nN = 12; g.magicN = 5462; e.ldo = 3072; e.mode = 2; break;
        case 25: type = T_ATTN_DIFF; break;
        case 26: g.Bt = W + W_DO; g.nM = 128; break;
        case 27: type = T_RN; layer = 3; stage = 0; Y = T1; nrows = MLAT; break;
        case 30: type = T_RN; layer = 3; stage = 1; Y = H; nrows = MLAT; break;
        default: break;
        }
        if (ph > ph_lo && sync) { if (ph_hi > N_PHASES) cg::this_grid().sync(); else { ++nbar; grid_barrier(barcnt, nbar * gridDim.x); } }
#ifdef REPEAT_MASK
        for (int rep_ = 0; rep_ < (((REPEAT_MASK) >> ph) & 1 ? 2 : 1); ++rep_) {
        if (rep_) cg::this_grid().sync();
#endif
        switch (type) {
#ifndef PH_MASK
#define PH_MASK 0xff
#endif
#if PH_MASK & 1
        case T_PREP: phase_prep(p, ldsg); break;
#endif
#if PH_MASK & 2
        case T_POOLD: phase_poold(p); break;
#endif
#if PH_MASK & 4
        case T_GEMM: gemm_phase(ldsl, g, e); break;
#endif
#if PH_MASK & 8
        case T_RN: phase_rn(p, layer, stage, Y, nrows, npart); break;
#endif
#if PH_MASK & 16
        case T_CONV: phase_conv(p); break;
#endif
#if PH_MASK & 32
        case T_MLAPREP: phase_mlaprep(p); break;
#endif
#if PH_MASK & 64
        case T_ATTN_MLA: phase_attn_mla(p, ldsg); break;
#endif
#if PH_MASK & 128
        case T_ATTN_DIFF: phase_attn_diff(p, ldsg); break;
#endif
        }
#ifdef REPEAT_MASK
        }
#endif
    }
}

extern "C" void kernel_launch(void* const* d_in, const int* in_sizes, int n_in, void* d_out, int out_size, void* d_ws, size_t ws_size, hipStream_t stream) {
    static int grid = 0;
    if (grid == 0) {
        if (n_in != 24 || out_size != MLAT * DM || ws_size < WS_END) { fprintf(stderr, "kernel_launch: unexpected shapes (n_in %d out %d ws %zu need %zu)\n", n_in, out_size, ws_size, (size_t)WS_END); grid = -1; return; }
        if (hipFuncSetAttribute((const void*)mk_fwd, hipFuncAttributeMaxDynamicSharedMemorySize, LDS_BYTES) != hipSuccess) { fprintf(stderr, "kernel_launch: hipFuncSetAttribute failed\n"); grid = -1; return; }
        int dev = 0, cus = 0, per_cu = 0;
        (void)hipGetDevice(&dev); (void)hipDeviceGetAttribute(&cus, hipDeviceAttributeMultiprocessorCount, dev);
        (void)hipOccupancyMaxActiveBlocksPerMultiprocessor(&per_cu, (const void*)mk_fwd, NTHREADS, LDS_BYTES);
        if (per_cu < 1) { fprintf(stderr, "kernel_launch: occupancy query says %d blocks per CU\n", per_cu); per_cu = 1; }
        (void)hipGetLastError();
        grid = cus * 1;
        if (grid > 256) grid = 256;
    }
    if (grid < 0) return;
    Params p{};
    const float** pp = (const float**)&p;
    for (int i = 0; i < 24; ++i) pp[i] = (const float*)d_in[i];
    p.out = (float*)d_out; p.ws = (unsigned char*)d_ws;
#if MK_ONE_LAUNCH
    (void)hipMemsetAsync((char*)d_ws + WS_BAR, 0, 256, stream);
    p.ph_lo = 0; p.ph_hi = N_PHASES;
    void* args[] = {&p};
    hipError_t e = hipLaunchCooperativeKernel((const void*)mk_fwd, dim3(grid), dim3(NTHREADS), args, LDS_BYTES, stream);
    if (e != hipSuccess) fprintf(stderr, "cooperative launch failed: %s (grid %d)\n", hipGetErrorString(e), grid);
#else
    for (int ph = 0; ph < N_PHASES; ++ph) {
        p.ph_lo = ph; p.ph_hi = ph + 1;
        hipLaunchKernelGGL(mk_fwd, dim3(grid), dim3(NTHREADS), LDS_BYTES, stream, p);
    }
#endif
}
```

```cpp
#include <hip/hip_runtime.h>
#include <hip/hip_cooperative_groups.h>
#include <cstdio>
#include <cstdint>
namespace cg = cooperative_groups;

#ifndef MK_ONE_LAUNCH
#define MK_ONE_LAUNCH 1
#endif

#define LAS __attribute__((address_space(3)))
typedef unsigned short bf16_t;
typedef short bf16x8 __attribute__((ext_vector_type(8)));
typedef short s16x4 __attribute__((ext_vector_type(4)));
typedef float f32x4 __attribute__((ext_vector_type(4)));
typedef float f32x16 __attribute__((ext_vector_type(16)));
typedef unsigned u32x4 __attribute__((ext_vector_type(4)));
typedef unsigned u32x2 __attribute__((ext_vector_type(2)));

constexpr int DM = 1024, NB = 16, SEQ = 2048, CTXL = 256, MLAT = NB * SEQ, MCTX = NB * CTXL, MALL = MLAT + MCTX;
constexpr float EPS = 1e-6f;
constexpr int NTHREADS = 512;
#ifndef MLA_NQL
#define MLA_NQL 4
#endif
constexpr int LDS_BYTES = (32768 + 49152 + 2048 + MLA_NQL * 8192) > 131072 ? (32768 + 49152 + 2048 + MLA_NQL * 8192) : 131072;

constexpr size_t WS_XC = 0;
constexpr size_t WS_H = WS_XC + (size_t)MCTX * DM * 4;
constexpr size_t WS_T1 = WS_H + (size_t)MALL * DM * 2;
constexpr size_t WS_W = WS_T1 + (size_t)MALL * 4096 * 2;
constexpr size_t W_ELTS = 45154304;
constexpr size_t WS_MOD = WS_W + W_ELTS * 2;
constexpr size_t WS_RS = WS_MOD + (size_t)4 * 17 * 6144 * 4;
constexpr size_t WS_ROPE = WS_RS + (size_t)MALL * 4;
constexpr size_t WS_SCR = WS_ROPE + 8192;
constexpr size_t WS_BAR = WS_SCR + (size_t)256 * 64 * 512 * 4;
constexpr size_t WS_END = WS_BAR + 17 * 256;
static_assert(WS_SCR % 256 == 0 && WS_MOD % 256 == 0 && WS_RS % 256 == 0 && WS_ROPE % 256 == 0, "align");
static_assert(WS_END <= 536870912ull, "workspace budget");
constexpr size_t W_FFN = 0;
constexpr size_t W_POOL = 33554432;
constexpr size_t W_CIN = W_POOL + 262144;
constexpr size_t W_COUT = W_CIN + 3145728;
constexpr size_t W_DOWN = W_COUT + 1048576;
constexpr size_t W_UQ = W_DOWN + 786432;
constexpr size_t W_UKV = W_UQ + 589824;
constexpr size_t W_MO = W_UKV + 524288;
constexpr size_t W_DQKV = W_MO + 1048576;
constexpr size_t W_DO = W_DQKV + 3145728;
static_assert(W_DO + 1048576 == W_ELTS, "weights");
constexpr size_t T_Q = 0;
constexpr size_t T_KV = T_Q + (size_t)MALL * 1536;
constexpr size_t T_CQ = T_KV + (size_t)MALL * 2048;
constexpr size_t T_KR = T_CQ + (size_t)MALL * 384;
constexpr size_t T_AB = T_KV;
static_assert(T_KR + (size_t)MALL * 64 <= (size_t)MALL * 4096, "arena");

struct Params {
    const float *x, *c, *ctx, *c_ctx, *ada_w, *ada_b, *norm_g, *ffn_w1, *ffn_w2, *pool_w, *pool_scale, *conv_in_w, *conv_w, *conv_out_w,
        *mla_w_down, *mla_g_q, *mla_g_kv, *mla_w_uq, *mla_w_ukv, *mla_w_o, *diff_w_qkv, *diff_lambda, *diff_g_subln, *diff_w_o;
    float* out; unsigned char* ws; int ph_lo, ph_hi;
};

__device__ __forceinline__ int tid_opaque() { int t = threadIdx.x; asm volatile("" : "+v"(t)); return t; }
__device__ __forceinline__ unsigned cvt_pk_bf16(float lo, float hi) { unsigned r; asm volatile("v_cvt_pk_bf16_f32 %0, %1, %2" : "=v"(r) : "v"(lo), "v"(hi)); return r; }
__device__ __forceinline__ float bf_lo(unsigned w) { return __uint_as_float(w << 16); }
__device__ __forceinline__ float bf_hi(unsigned w) { return __uint_as_float(w & 0xffff0000u); }
__device__ __forceinline__ float wave_sum(float v) {
#pragma unroll
    for (int o = 32; o >= 1; o >>= 1) v += __shfl_xor(v, o);
    return v;
}
__device__ __forceinline__ int modrow(int row) { return row < MLAT ? (row >> 11) : NB; }
__device__ __forceinline__ void load_bf4(const bf16_t* p, float* v) { const u32x2 w = *(const u32x2*)p; v[0] = bf_lo(w.x); v[1] = bf_hi(w.x); v[2] = bf_lo(w.y); v[3] = bf_hi(w.y); }
__device__ __forceinline__ void store_bf4(bf16_t* p, float a, float b, float c, float d) { u32x2 w; w.x = cvt_pk_bf16(a, b); w.y = cvt_pk_bf16(c, d); *(u32x2*)p = w; }

constexpr int BM = 256, BK = 64, HALF = 128, HTB = HALF * BK * 2;
__device__ __forceinline__ int lds_byte(int r, int c) { const int st = (r >> 4) * 2 + (c >> 5), rr = r & 15, cc = c & 31, ob = rr * 64 + cc * 2; return st * 1024 + (ob ^ (((ob >> 9) & 1) << 5)); }
__device__ __forceinline__ void stage_rc(int b, int& R, int& C) { const int st = b / 1024, sb = b % 1024, swz = sb ^ (((sb >> 9) & 1) << 5); R = (st >> 1) * 16 + swz / 64; C = (st & 1) * 32 + (swz % 64) / 2; }

struct Unit { int pm, pn, ks, nt; };
struct GemmP { const bf16_t* A; const bf16_t* Bt; int lda, ldb, K, nM, nN, a_pn_off, ksplit, a_tiled, rev, magicN; };
struct EpiP { bf16_t* O; int ldo; int mode; const float* colscale; const float* rope; bf16_t* Opart; };

__device__ __forceinline__ bool unit_next(const GemmP& g, int i, Unit& u) {
    const int nMf = g.ksplit > 1 ? 128 : g.nM;
    const int nwg = nMf * g.nN; const int L = i * (int)gridDim.x + (g.rev ? (int)gridDim.x - 1 - (int)blockIdx.x : (int)blockIdx.x);
    if (L >= nwg) {
        if (g.ksplit <= 1) return false;
        const int idx = L - nwg; if (idx >= (g.nM - nMf) * 16) return false;
        u.pm = nMf + (idx >> 4); const int r = idx & 15; u.pn = r >> 2; u.ks = r & 3; u.nt = g.K >> 8; return true;
    }
    int wgid = L; { const int q = nwg >> 3, xcd = wgid & 7, off = wgid >> 3; wgid = xcd * q + off; }
    const int w8 = wgid >> 3, gid = (w8 * g.magicN) >> 16, rem = wgid - gid * 8 * g.nN;
    u.pm = gid * 8 + (rem & 7); u.pn = rem >> 3; u.ks = -1; u.nt = g.K >> 6; return true;
}

__device__ __forceinline__ void epi_store(const f32x4 (&acc)[2][2][4][2], const Unit& u, int wr, int wc, int fr, int fq, const EpiP& e) {
    const int row0 = u.pm * BM + wr * 64 + fr;
    if (e.mode < 2) {
        const int col0 = u.pn * BM + wc * 32 + 8 * fq;
#pragma unroll
        for (int bj = 0; bj < 2; ++bj) {
            const int c = col0 + bj * HALF;
            f32x4 cs0 = {1.f, 1.f, 1.f, 1.f}, cs1 = {1.f, 1.f, 1.f, 1.f};
            if (e.mode == 0 && e.colscale) { cs0 = *(const f32x4*)(e.colscale + c); cs1 = *(const f32x4*)(e.colscale + c + 4); }
#pragma unroll
            for (int ai = 0; ai < 2; ++ai)
#pragma unroll
                for (int m = 0; m < 4; ++m) {
                    const int row = row0 + ai * HALF + m * 16;
                    f32x4 v0 = acc[ai][bj][m][0], v1 = acc[ai][bj][m][1];
                    if (e.mode == 1) {
#pragma unroll
                        for (int j = 0; j < 4; ++j) { const float a = fmaxf(v0[j], 0.f), b = fmaxf(v1[j], 0.f); v0[j] = a * a; v1[j] = b * b; }
                    } else { v0 *= cs0; v1 *= cs1; }
                    bf16_t* rowp = (u.ks < 0 ? e.O + (size_t)row * e.ldo : e.Opart + ((size_t)u.ks * MCTX + (row - MLAT)) * 1024) + c;
                    if (e.mode == 1)
                        rowp = (bf16_t*)((char*)e.O + ((size_t)(u.pm * 64 + u.pn * 4 + bj * 2 + (wc >> 1))) * 32768 + ai * 16384 + (((wr * 4 + m) * 2 + (wc & 1)) * 1024) + (fr * 4 + fq) * 16);
                    u32x4 w; w.x = cvt_pk_bf16(v0[0], v0[1]); w.y = cvt_pk_bf16(v0[2], v0[3]); w.z = cvt_pk_bf16(v1[0], v1[1]); w.w = cvt_pk_bf16(v1[2], v1[3]);
                    *(u32x4*)rowp = w;
                }
        }
        return;
    }
    const int col0 = u.pn * BM + wc * 32 + 4 * fq;
#pragma unroll
    for (int bj = 0; bj < 2; ++bj) {
        const int c = col0 + bj * HALF;
        int kind = 0;
        if (e.mode == 2) { if (c < 2048) kind = ((c >> 5) & 1) ? 2 : 1; }
        else { const int d = c % 192; if (d >= 128) kind = (d >= 160) ? 2 : 1; }
#pragma unroll
        for (int ai = 0; ai < 2; ++ai)
#pragma unroll
            for (int m = 0; m < 4; ++m) {
                const int row = row0 + ai * HALF + m * 16;
                f32x4 v0 = acc[ai][bj][m][0], v1 = acc[ai][bj][m][1];
                if (kind != 0 && row < MLAT) {
                    const int t = row & (SEQ - 1); const int pos = (kind == 1) ? (t >> 6) : (t & 63);
                    const f32x4 t0 = *(const f32x4*)(e.rope + (pos * 16 + 4 * fq) * 2), t1 = *(const f32x4*)(e.rope + (pos * 16 + 4 * fq) * 2 + 4);
                    const float cs[4] = {t0[0], t0[2], t1[0], t1[2]}, sn[4] = {t0[1], t0[3], t1[1], t1[3]};
#pragma unroll
                    for (int j = 0; j < 4; ++j) { const float x1 = v0[j], x2 = v1[j]; v0[j] = x1 * cs[j] - x2 * sn[j]; v1[j] = x2 * cs[j] + x1 * sn[j]; }
                }
                bf16_t* rowp = e.O + (size_t)row * e.ldo + c;
                u32x2 w0, w1; w0.x = cvt_pk_bf16(v0[0], v0[1]); w0.y = cvt_pk_bf16(v0[2], v0[3]); w1.x = cvt_pk_bf16(v1[0], v1[1]); w1.y = cvt_pk_bf16(v1[2], v1[3]);
                const bool odd = (fq & 1) != 0;
                const unsigned sx = odd ? w0.x : w1.x, sy = odd ? w0.y : w1.y;
                const unsigned rx = (unsigned)__shfl_xor((int)sx, 16), ry = (unsigned)__shfl_xor((int)sy, 16);
                u32x4 w; if (odd) { w.x = rx; w.y = ry; w.z = w1.x; w.w = w1.y; } else { w.x = w0.x; w.y = w0.y; w.z = rx; w.w = ry; }
                *(u32x4*)(rowp + (odd ? 12 : 0)) = w;
            }
    }
}

__device__ __forceinline__ void gemm_phase(LAS unsigned char* lds, const GemmP g, const EpiP e) {
    const int tid = tid_opaque(), wid = __builtin_amdgcn_readfirstlane(tid >> 6), lane = tid & 63, wr = wid >> 2, wc = wid & 3, fr = lane & 15, fq = lane >> 4;
    unsigned voffA[2], voffB[2];
#pragma unroll
    for (int i = 0; i < 2; ++i) { int R, C; stage_rc(tid * 16 + i * 8192, R, C); const int rho = R & 31; const int Rb = (e.mode < 2) ? ((R & ~31) + 8 * ((rho & 15) >> 2) + 4 * (rho >> 4) + (rho & 3)) : R;
        voffA[i] = g.a_tiled ? (unsigned)((((R >> 4) * 2 + (C >> 5)) * 1024) + ((R & 15) * 4 + ((C >> 3) & 3)) * 16) : (unsigned)(R * g.lda + C) * 2u; voffB[i] = (unsigned)(Rb * g.ldb + C) * 2u; }
    const size_t kstepB = (size_t)(BK * 2), kstepA = g.a_tiled ? (size_t)32768 : (size_t)(BK * 2);
    const size_t hstepA = g.a_tiled ? (size_t)16384 : (size_t)HALF * g.lda * 2, hstepB = (size_t)HALF * g.ldb * 2;
    const size_t tstepA = g.a_tiled ? (size_t)(g.K / BK) * 32768 : 2 * hstepA, tstepB = 2 * hstepB;
    const unsigned ldsw = (unsigned)wid * 1024u;
    const int aoff = lds_byte(wr * 64 + fr, fq * 8), boff = lds_byte(wc * 32 + fr, fq * 8);
#define PG8_SA(b, h) (((b) * 2 + (h)) * HTB)
#define PG8_SB(b, h) ((4 + (b) * 2 + (h)) * HTB)
#define PG8_STAGE(bufoff, gbase, voff) do { _Pragma("unroll") for (int _i = 0; _i < 2; ++_i) \
        __builtin_amdgcn_global_load_lds((const unsigned*)((const char*)(gbase) + (voff)[_i]), (LAS unsigned*)(lds + (bufoff) + ldsw + _i * 8192), 16, 0, 0); } while (0)
#define PG8_LDA(dst, b, h) do { _Pragma("unroll") for (int m = 0; m < 4; ++m) _Pragma("unroll") for (int k = 0; k < 2; ++k) dst[m][k] = *(const LAS bf16x8*)(lds + PG8_SA(b, h) + aoff + m * 2048 + k * 1024); } while (0)
#define PG8_LDB(dst, b, h) do { _Pragma("unroll") for (int n = 0; n < 2; ++n) _Pragma("unroll") for (int k = 0; k < 2; ++k) dst[n][k] = *(const LAS bf16x8*)(lds + PG8_SB(b, h) + boff + n * 2048 + k * 1024); } while (0)
#define PG8_MMA(ai, bj, At, Bt) do { __builtin_amdgcn_s_setprio(1); _Pragma("unroll") for (int m = 0; m < 4; ++m) _Pragma("unroll") for (int n = 0; n < 2; ++n) _Pragma("unroll") for (int k = 0; k < 2; ++k) \
        acc[ai][bj][m][n] = __builtin_amdgcn_mfma_f32_16x16x32_bf16(Bt[n][k], At[m][k], acc[ai][bj][m][n], 0, 0, 0); __builtin_amdgcn_s_setprio(0); } while (0)
#define PG8_WAIT_V(n) asm volatile("s_waitcnt vmcnt(" #n ")" ::: "memory")
#define PG8_WAIT_L(n) asm volatile("s_waitcnt lgkmcnt(" #n ")" ::: "memory")
#define PG8_BAR __builtin_amdgcn_s_barrier()
#define PG8_SCHED __builtin_amdgcn_sched_barrier(0)
    Unit cur, nxt; int ui = 0;
    if (!unit_next(g, 0, cur)) return;
    f32x4 acc[2][2][4][2];
#pragma unroll
    for (int a = 0; a < 2; ++a)
#pragma unroll
        for (int b = 0; b < 2; ++b)
#pragma unroll
            for (int m = 0; m < 4; ++m)
#pragma unroll
                for (int n = 0; n < 2; ++n) acc[a][b][m][n] = (f32x4){0.f, 0.f, 0.f, 0.f};
    bf16x8 At[4][2], B0[2][2], B1[2][2];
    const size_t ksliceB = (size_t)(g.ksplit > 1 ? g.K / g.ksplit : 0) * 2;
    const size_t ksliceA = g.a_tiled ? (size_t)(g.ksplit > 1 ? g.K / g.ksplit / BK : 0) * 32768 : ksliceB;
#define UNIT_A(u_) ((const char*)g.A + (size_t)(u_).pm * tstepA + (size_t)(u_).pn * g.a_pn_off * 2 + ((u_).ks > 0 ? (u_).ks * ksliceA : 0))
#define UNIT_B(u_) ((const char*)g.Bt + (size_t)(u_).pn * tstepB + ((u_).ks > 0 ? (u_).ks * ksliceB : 0))
    const char* cA = UNIT_A(cur); const char* cB = UNIT_B(cur);
    PG8_STAGE(PG8_SB(0, 0), cB, voffB); PG8_STAGE(PG8_SB(0, 1), cB + hstepB, voffB); PG8_STAGE(PG8_SA(0, 0), cA, voffA); PG8_STAGE(PG8_SA(0, 1), cA + hstepA, voffA);
    if (wr == 1) PG8_BAR;
    PG8_WAIT_V(2); PG8_BAR;
    PG8_STAGE(PG8_SB(1, 0), cB + kstepB, voffB); PG8_STAGE(PG8_SA(1, 0), cA + kstepA, voffA); PG8_STAGE(PG8_SB(1, 1), cB + hstepB + kstepB, voffB);
    PG8_WAIT_V(6); PG8_BAR;
    for (;;) {
        const bool has_next = unit_next(g, ui + 1, nxt);
        const char* nA = has_next ? UNIT_A(nxt) : cA; const char* nB = has_next ? UNIT_B(nxt) : cB;
        const int nt = cur.nt;
        for (int t = 0; t < nt; t += 2) {
            const bool last = (t == nt - 2);
            const char* a1 = cA + (size_t)(t + 1) * kstepA;
            const char* a2 = last ? nA : cA + (size_t)(t + 2) * kstepA; const char* b2 = last ? nB : cB + (size_t)(t + 2) * kstepB;
            const char* a3 = a2 + kstepA; const char* b3 = b2 + kstepB;
            PG8_LDB(B0, 0, 0); PG8_LDB(B1, 0, 1); PG8_SCHED; PG8_LDA(At, 0, 0); PG8_STAGE(PG8_SA(1, 1), a1 + hstepA, voffA);
            PG8_WAIT_V(8); PG8_WAIT_L(0); PG8_BAR; PG8_MMA(0, 0, At, B0); PG8_MMA(0, 1, At, B1); PG8_BAR; PG8_SCHED;
            PG8_LDA(At, 0, 1); PG8_STAGE(PG8_SB(0, 0), b2, voffB); PG8_STAGE(PG8_SB(0, 1), b2 + hstepB, voffB); PG8_STAGE(PG8_SA(0, 0), a2, voffA);
            PG8_WAIT_V(8); PG8_WAIT_L(0); PG8_BAR; PG8_MMA(1, 0, At, B0); PG8_MMA(1, 1, At, B1); PG8_BAR; PG8_SCHED;
            PG8_LDB(B0, 1, 0); PG8_LDB(B1, 1, 1); PG8_SCHED; PG8_LDA(At, 1, 0); PG8_STAGE(PG8_SA(0, 1), a2 + hstepA, voffA);
            PG8_WAIT_V(8); PG8_WAIT_L(0); PG8_BAR; PG8_MMA(0, 0, At, B0); PG8_MMA(0, 1, At, B1); PG8_BAR; PG8_SCHED;
            PG8_LDA(At, 1, 1); PG8_STAGE(PG8_SB(1, 0), b3, voffB); PG8_STAGE(PG8_SB(1, 1), b3 + hstepB, voffB); PG8_STAGE(PG8_SA(1, 0), a3, voffA);
            PG8_WAIT_V(8); PG8_WAIT_L(0); PG8_BAR; PG8_MMA(1, 0, At, B0); PG8_MMA(1, 1, At, B1); PG8_BAR; PG8_SCHED;
        }
        if (wr == 0) PG8_BAR;
        epi_store(acc, cur, wr, wc, fr, fq, e);
        if (!has_next) break;
#pragma unroll
        for (int a = 0; a < 2; ++a)
#pragma unroll
            for (int b = 0; b < 2; ++b)
#pragma unroll
                for (int m = 0; m < 4; ++m)
#pragma unroll
                    for (int n = 0; n < 2; ++n) acc[a][b][m][n] = (f32x4){0.f, 0.f, 0.f, 0.f};
        cur = nxt; cA = nA; cB = nB; ++ui;
        if (wr == 1) PG8_BAR;
    }
    PG8_WAIT_V(0);
    PG8_BAR;
#undef UNIT_A
#undef UNIT_B
#undef PG8_SA
#undef PG8_SB
#undef PG8_STAGE
#undef PG8_LDA
#undef PG8_LDB
#undef PG8_MMA
#undef PG8_WAIT_V
#undef PG8_WAIT_L
#undef PG8_BAR
#undef PG8_SCHED
}

#define SBAR() __builtin_amdgcn_sched_barrier(0)
__device__ __forceinline__ int crow(int r, int hi) { return (r & 3) + 8 * (r >> 2) + 4 * hi; }
__device__ __forceinline__ int v_st(int k, int c) { const int kk = (k & ~0xC) | ((k & 4) << 1) | ((k & 8) >> 1); return ((kk >> 3) * 4 + (c >> 5)) * 512 + ((kk & 7) * 32 + (c & 31)) * 2; }
__device__ __forceinline__ int v_rd_base(int lane) { return ((lane & 3) << 3) | (((lane >> 2) & 3) << 6) | (((lane >> 4) & 1) << 5) | (((lane >> 5) & 1) << 8); }
constexpr int v_rd_off(int d0, int ks, int half) { return d0 * 512 + ks * 4096 + half * 2048; }
template <int OFF> __device__ __forceinline__ s16x4 tr_read(int vb) { s16x4 r; asm volatile("ds_read_b64_tr_b16 %0, %1 offset:%2" : "=&v"(r) : "v"(vb), "i"(OFF) : "memory"); return r; }
template <int D0> __device__ __forceinline__ void pv_one(f32x16& od, int vb, bf16x8 pa0, bf16x8 pa1, bf16x8 pa2, bf16x8 pa3) {
    const s16x4 l0 = tr_read<v_rd_off(D0, 0, 0)>(vb), h0 = tr_read<v_rd_off(D0, 0, 1)>(vb), l1 = tr_read<v_rd_off(D0, 1, 0)>(vb), h1 = tr_read<v_rd_off(D0, 1, 1)>(vb);
    const s16x4 l2 = tr_read<v_rd_off(D0, 2, 0)>(vb), h2 = tr_read<v_rd_off(D0, 2, 1)>(vb), l3 = tr_read<v_rd_off(D0, 3, 0)>(vb), h3 = tr_read<v_rd_off(D0, 3, 1)>(vb);
    asm volatile("s_waitcnt lgkmcnt(0)" ::: "memory"); SBAR();
#define PK(L, H) (bf16x8){L[0], L[1], L[2], L[3], H[0], H[1], H[2], H[3]}
    od = __builtin_amdgcn_mfma_f32_32x32x16_bf16(pa0, PK(l0, h0), od, 0, 0, 0);
    od = __builtin_amdgcn_mfma_f32_32x32x16_bf16(pa1, PK(l1, h1), od, 0, 0, 0);
    od = __builtin_amdgcn_mfma_f32_32x32x16_bf16(pa2, PK(l2, h2), od, 0, 0, 0);
    od = __builtin_amdgcn_mfma_f32_32x32x16_bf16(pa3, PK(l3, h3), od, 0, 0, 0);
#undef PK
}
__device__ __forceinline__ void pv_d0(f32x16* o, int vb, bf16x8 pa0, bf16x8 pa1, bf16x8 pa2, bf16x8 pa3) {
    pv_one<0>(o[0], vb, pa0, pa1, pa2, pa3); pv_one<1>(o[1], vb, pa0, pa1, pa2, pa3); pv_one<2>(o[2], vb, pa0, pa1, pa2, pa3); pv_one<3>(o[3], vb, pa0, pa1, pa2, pa3);
}
__device__ __forceinline__ void partialSM(f32x16& p0, f32x16& p1, float& m_reg, float& mn, float& alpha, const float C, const float thr) {
    float pmax = p0[0];
#pragma unroll
    for (int r = 1; r < 16; ++r) pmax = fmaxf(pmax, p0[r]);
#pragma unroll
    for (int r = 0; r < 16; ++r) pmax = fmaxf(pmax, p1[r]);
    { auto rr = __builtin_amdgcn_permlane32_swap(__float_as_uint(pmax), __float_as_uint(pmax), false, false);
      pmax = fmaxf(__uint_as_float(rr[0]), __uint_as_float(rr[1])); }
    if (__builtin_expect(__all(pmax - m_reg <= thr), 1)) { mn = m_reg; alpha = 1.f; }
    else { mn = fmaxf(m_reg, pmax); alpha = __builtin_amdgcn_exp2f((m_reg - mn) * C); m_reg = mn; }
    const float mnC = -mn * C;
#pragma unroll
    for (int r = 0; r < 16; ++r) p0[r] = fmaf(p0[r], C, mnC);
#pragma unroll
    for (int r = 0; r < 16; ++r) p1[r] = fmaf(p1[r], C, mnC);
#pragma unroll
    for (int r = 0; r < 16; ++r) p0[r] = __builtin_amdgcn_exp2f(p0[r]);
}
__device__ __forceinline__ void finishSM(f32x16& p0, f32x16& p1, float alpha, float& l_reg, bf16x8& pa0, bf16x8& pa1, bf16x8& pa2, bf16x8& pa3) {
#pragma unroll
    for (int r = 0; r < 16; ++r) p1[r] = __builtin_amdgcn_exp2f(p1[r]);
    float ps = 0;
#pragma unroll
    for (int r = 0; r < 16; ++r) ps += p0[r];
#pragma unroll
    for (int r = 0; r < 16; ++r) ps += p1[r];
    { auto rr = __builtin_amdgcn_permlane32_swap(__float_as_uint(ps), __float_as_uint(ps), false, false);
      ps = __uint_as_float(rr[0]) + __uint_as_float(rr[1]); }
    l_reg = l_reg * alpha + ps;
#define PK4(P, BASE, OUT) do { unsigned a0 = cvt_pk_bf16(P[BASE + 0], P[BASE + 1]), a1 = cvt_pk_bf16(P[BASE + 2], P[BASE + 3]);   \
    unsigned b0 = cvt_pk_bf16(P[BASE + 4], P[BASE + 5]), b1 = cvt_pk_bf16(P[BASE + 6], P[BASE + 7]);                              \
    auto r0 = __builtin_amdgcn_permlane32_swap(a0, b0, false, false); auto r1 = __builtin_amdgcn_permlane32_swap(a1, b1, false, false); \
    u32x4 w = {r0[0], r1[0], r0[1], r1[1]}; OUT = *reinterpret_cast<bf16x8*>(&w); } while (0)
    PK4(p0, 0, pa0); PK4(p0, 8, pa1); PK4(p1, 0, pa2); PK4(p1, 8, pa3);
#undef PK4
}

struct AttnArgs {
    const bf16_t* Q; int ldq;
    const bf16_t* Kn; int ldk;
    const bf16_t* Kr; int ldkr;
    const bf16_t* V; int ldv;
    int lat0, ctx0, nlat, NT;
    float C, thr;
};

template <int DQK, int DK1, int LDQ, int LDK, int LDKR, int LDV, int NQL, int SDEPTH>
__device__ __forceinline__ void attn_core(const AttnArgs& a, char* lds, f32x16 (&o)[4]) {
    constexpr int KP = DQK * 2, SHM_K = 64 * KP, SHM_V = 64 * 128 * 2, KCH = DQK / 64, CPR = DQK / 8, ND0 = DQK / 16;
    const int tid = tid_opaque(), wid = tid >> 6, lane = tid & 63, r32 = lane & 31, hi = lane >> 5;
    char* V_lds = lds; char* K_lds = lds + 2 * SHM_V;
    float* wsf = (float*)(lds + 2 * SHM_V + 2 * SHM_K) + wid * 64; float* li_l = wsf; float* al_l = wsf + 32;
    float m_reg = -1e30f, l_reg = 0.f;
#pragma unroll
    for (int d = 0; d < 4; ++d)
#pragma unroll
        for (int r = 0; r < 16; ++r) o[d][r] = 0.f;
    constexpr int NQR = ND0 - NQL;
    bf16x8 qr[NQR];
    char* QL = lds + 2 * SHM_V + 2 * SHM_K + 2048 + tid * 16;
    { const bf16_t* Qw = a.Q + (long)(wid * 32 + r32) * LDQ + hi * 8;
#pragma unroll
      for (int d0 = 0; d0 < NQR; ++d0) qr[d0] = *(const bf16x8*)(Qw + d0 * 16);
#pragma unroll
      for (int d0 = NQR; d0 < ND0; ++d0) *(bf16x8*)(QL + (d0 - NQR) * 8192) = *(const bf16x8*)(Qw + d0 * 16); }
    const int sr = tid >> 4, sc = (tid & 15) * 8, vst0 = v_st(sr, sc), vst1 = v_st(32 + sr, sc);
    const int vb0 = (int)(uintptr_t)V_lds + v_rd_base(lane);
    const bf16_t* kptr[KCH]; int kld[KCH], kwo[KCH];
#pragma unroll
    for (int c = 0; c < KCH; ++c) { const int idx = tid + c * 512, kr_ = idx / CPR, kc = (idx % CPR) * 8;
        if (kc < DK1) { kptr[c] = a.Kn + (long)kr_ * LDK + kc; kld[c] = LDK; } else { kptr[c] = a.Kr + (long)kr_ * LDKR + (kc - DK1); kld[c] = LDKR; }
        kwo[c] = kr_ * KP + ((kc * 2) ^ ((kr_ & 7) << 4)); }
    struct { bf16x8 vs0, vs1, ks[KCH]; } sr_[SDEPTH];
    int kb[4];
#pragma unroll
    for (int m = 0; m < 4; ++m) kb[m] = r32 * KP + ((m * 32 + hi * 16) ^ ((r32 & 7) << 4));
#define KROW(j) ((j) < a.nlat ? a.lat0 + 64 * (j) : a.ctx0 + 64 * ((j) - a.nlat))
#define SLOAD(i, j) do { const long rb_ = KROW(j); sr_[i].vs0 = *(const bf16x8*)(a.V + (rb_ + sr) * LDV + sc); sr_[i].vs1 = *(const bf16x8*)(a.V + (rb_ + 32 + sr) * LDV + sc); \
    _Pragma("unroll") for (int c_ = 0; c_ < KCH; ++c_) sr_[i].ks[c_] = *(const bf16x8*)(kptr[c_] + rb_ * kld[c_]); } while (0)
#define SWRITE(b, i) do { *(bf16x8*)(V_lds + (b) * SHM_V + vst0) = sr_[i].vs0; *(bf16x8*)(V_lds + (b) * SHM_V + vst1) = sr_[i].vs1; \
    _Pragma("unroll") for (int c_ = 0; c_ < KCH; ++c_) *(bf16x8*)(K_lds + (b) * SHM_K + kwo[c_]) = sr_[i].ks[c_]; } while (0)
#define RESC(al) do { if (__any((al) < 1.f)) { if (hi == 0) al_l[r32] = (al); asm volatile("s_waitcnt lgkmcnt(0)" ::: "memory"); \
    _Pragma("unroll") for (int d = 0; d < 4; ++d) _Pragma("unroll") for (int r = 0; r < 16; ++r) o[d][r] *= al_l[crow(r, hi)]; } } while (0)
#define QKT(P0, P1, KB) do { P0 = f32x16{}; P1 = f32x16{}; \
    _Pragma("unroll") for (int d0 = 0; d0 < ND0; ++d0) { \
      const bf16x8 b0 = *(const bf16x8*)((KB) + kb[d0 & 3] + (d0 >> 2) * 128); \
      const bf16x8 b1 = *(const bf16x8*)((KB) + kb[d0 & 3] + (d0 >> 2) * 128 + 32 * KP); \
      const bf16x8 qf = (d0 < NQR) ? qr[d0 < NQR ? d0 : 0] : *(const bf16x8*)(QL + (d0 - NQR) * 8192); \
      P0 = __builtin_amdgcn_mfma_f32_32x32x16_bf16(b0, qf, P0, 0, 0, 0); \
      P1 = __builtin_amdgcn_mfma_f32_32x32x16_bf16(b1, qf, P1, 0, 0, 0); } } while (0)
    f32x16 pA0, pA1, pB0, pB1; float mnA, mnB, alA, alB; bf16x8 pa0, pa1, pa2, pa3; const int NT = a.NT;
    constexpr int SE = 0, SO = SDEPTH - 1;
    SLOAD(SE, 0); asm volatile("s_waitcnt vmcnt(0)" ::: "memory"); SWRITE(0, SE); __syncthreads();
    QKT(pA0, pA1, K_lds); partialSM(pA0, pA1, m_reg, mnA, alA, a.C, a.thr);
    SLOAD(SO, 1); if (SDEPTH == 2 && 2 < NT) SLOAD(SE, 2);
    SWRITE(1, SO); __syncthreads();
    for (int j = 1; j + 1 < NT; j += 2) {
        SBAR(); QKT(pB0, pB1, K_lds + SHM_K);
        finishSM(pA0, pA1, alA, l_reg, pa0, pa1, pa2, pa3); SBAR();
        SLOAD(SO, j + SDEPTH); SBAR();
        pv_d0(o, vb0, pa0, pa1, pa2, pa3); partialSM(pB0, pB1, m_reg, mnB, alB, a.C, a.thr);
        __syncthreads(); SWRITE(0, SE);
        RESC(alB); __syncthreads();
        SBAR(); QKT(pA0, pA1, K_lds);
        finishSM(pB0, pB1, alB, l_reg, pa0, pa1, pa2, pa3); SBAR();
        if (SDEPTH == 1 || j + 3 < NT) SLOAD(SE, j + 1 + SDEPTH); SBAR();
        pv_d0(o, vb0 + SHM_V, pa0, pa1, pa2, pa3); partialSM(pA0, pA1, m_reg, mnA, alA, a.C, a.thr);
        __syncthreads(); SWRITE(1, SO);
        RESC(alA); __syncthreads();
    }
    SBAR(); QKT(pB0, pB1, K_lds + SHM_K);
    finishSM(pA0, pA1, alA, l_reg, pa0, pa1, pa2, pa3); SBAR();
    pv_d0(o, vb0, pa0, pa1, pa2, pa3); partialSM(pB0, pB1, m_reg, mnB, alB, a.C, a.thr);
    __syncthreads(); RESC(alB);
    finishSM(pB0, pB1, alB, l_reg, pa0, pa1, pa2, pa3); SBAR();
    pv_d0(o, vb0 + SHM_V, pa0, pa1, pa2, pa3);
    if (hi == 0) li_l[r32] = l_reg; asm volatile("s_waitcnt lgkmcnt(0)" ::: "memory");
#pragma unroll
    for (int r = 0; r < 16; ++r) { const float rl = __builtin_amdgcn_rcpf(li_l[crow(r, hi)]);
#pragma unroll
        for (int d = 0; d < 4; ++d) o[d][r] *= rl; }
    __syncthreads();
#undef KROW
#undef SLOAD
#undef SWRITE
#undef RESC
#undef QKT
}

__device__ __forceinline__ void phase_attn_mla(const Params& p, char* lds) {
    const bf16_t* T1 = (const bf16_t*)(p.ws + WS_T1); bf16_t* O = (bf16_t*)(p.ws + WS_H);
    const int tid = tid_opaque(), wid = tid >> 6, lane = tid & 63, r32 = lane & 31, hi = lane >> 5;
    const float scale = 0.07216878364870322f;
    for (int it = blockIdx.x; it < 1024 + 128; it += gridDim.x) {
        int b, h, row0; AttnArgs a;
        if (it < 1024) {
            int itm = it;
            if (gridDim.x == 256) { const int w = it & 255, rnd = it >> 8, xcd = w & 7, slot = w >> 3; itm = ((rnd * 32 + xcd * 4 + (slot >> 3)) << 3) | (slot & 7); }
            b = itm >> 6; h = (itm >> 3) & 7; const int qb = itm & 7; row0 = b * SEQ + qb * 256; a.nlat = 32; a.NT = 36; }
        else { const int i2 = it - 1024; b = i2 >> 3; h = i2 & 7; row0 = MLAT + b * CTXL; a.nlat = 0; a.NT = 4; }
        a.lat0 = b * SEQ; a.ctx0 = MLAT + b * CTXL;
        a.Q = T1 + T_Q + (size_t)row0 * 1536 + h * 192; a.ldq = 1536;
        a.Kn = T1 + T_KV + h * 256; a.ldk = 2048; a.Kr = T1 + T_KR; a.ldkr = 64;
        a.V = T1 + T_KV + h * 256 + 128; a.ldv = 2048;
        a.C = scale * 1.4426950408889634f; a.thr = 8.f / scale;
        f32x16 o[4];
        attn_core<192, 128, 1536, 2048, 64, 2048, MLA_NQL, 1>(a, lds, o);
        bf16_t* Ow = O + (size_t)(row0 + wid * 32 + 4 * hi) * 1024 + h * 128 + r32;
        asm volatile("" : "+v"(Ow));
#pragma unroll
        for (int r = 0; r < 16; ++r) { bf16_t* Or = Ow + (size_t)((r & 3) + 8 * (r >> 2)) * 1024;
#pragma unroll
            for (int d0 = 0; d0 < 4; ++d0) Or[d0 * 32] = (bf16_t)(cvt_pk_bf16(o[d0][r], 0.f) & 0xffffu); }
    }
}

__device__ __forceinline__ void phase_attn_diff(const Params& p, char* lds) {
    const bf16_t* T1 = (const bf16_t*)(p.ws + WS_T1); bf16_t* O = (bf16_t*)(p.ws + WS_H);
    const int tid = tid_opaque(), wid = tid >> 6, lane = tid & 63, r32 = lane & 31, hi = lane >> 5;
    float* scr0 = (float*)(p.ws + WS_SCR) + ((size_t)blockIdx.x * 512 + tid) * 64;
    const float scale = 0.125f;
    const float lam_init = 0.8f - 0.6f * 0.40656965974059917f;
    float lam;
    { const float* lv = p.diff_lambda; float s1 = 0.f, s2 = 0.f;
      for (int k = 0; k < 64; ++k) { s1 += lv[k] * lv[64 + k]; s2 += lv[128 + k] * lv[192 + k]; }
      lam = expf(s1) - expf(s2) + lam_init; }
    float gs[4];
#pragma unroll
    for (int d0 = 0; d0 < 4; ++d0) gs[d0] = p.diff_g_subln[d0 * 32 + r32] * (1.0f - lam_init);
    for (int it = blockIdx.x; it < 1024; it += gridDim.x) {
        int itm = it;
        if (gridDim.x == 256) { const int w = it & 255, rnd = it >> 8, xcd = w & 7, slot = w >> 3; itm = ((rnd * 32 + xcd * 4 + (slot >> 3)) << 3) | (slot & 7); }
        const int b = itm >> 6, h = (itm >> 3) & 7, qb = itm & 7, row0 = b * SEQ + qb * 256;
#pragma unroll 1
        for (int j = 0; j < 2; ++j) {
            AttnArgs a; a.nlat = 32; a.NT = 36; a.lat0 = b * SEQ; a.ctx0 = MLAT + b * CTXL;
            a.Q = T1 + (size_t)row0 * 3072 + h * 128 + j * 64; a.ldq = 3072;
            a.Kn = T1 + 1024 + h * 128 + j * 64; a.ldk = 3072; a.Kr = a.Kn; a.ldkr = 3072;
            a.V = T1 + 2048 + h * 128; a.ldv = 3072;
            a.C = scale * 1.4426950408889634f; a.thr = 8.f / scale;
            f32x16 o[4];
            attn_core<64, 64, 3072, 3072, 3072, 3072, 0, 2>(a, lds, o);
            float* scr = scr0; asm volatile("" : "+v"(scr));
            if (j == 0) {
#pragma unroll
                for (int r = 0; r < 16; ++r) { f32x4 t = {o[0][r], o[1][r], o[2][r], o[3][r]}; *(f32x4*)(scr + 4 * r) = t; }
            } else {
                bf16_t* Ow = O + (size_t)(row0 + wid * 32 + 4 * hi) * 1024 + h * 128 + r32;
                asm volatile("" : "+v"(Ow));
#pragma unroll
                for (int r = 0; r < 16; ++r) {
                    const f32x4 t = *(const f32x4*)(scr + 4 * r);
                    const float v0 = t[0] - lam * o[0][r], v1 = t[1] - lam * o[1][r], v2 = t[2] - lam * o[2][r], v3 = t[3] - lam * o[3][r];
                    float ss = v0 * v0 + v1 * v1 + v2 * v2 + v3 * v3;
#pragma unroll
                    for (int x = 16; x >= 1; x >>= 1) ss += __shfl_xor(ss, x);
                    const float rs = rsqrtf(ss * (1.0f / 128.0f) + EPS);
                    bf16_t* Or = Ow + (size_t)((r & 3) + 8 * (r >> 2)) * 1024;
                    Or[0] = (bf16_t)(cvt_pk_bf16(v0 * rs * gs[0], 0.f) & 0xffffu); Or[32] = (bf16_t)(cvt_pk_bf16(v1 * rs * gs[1], 0.f) & 0xffffu);
                    Or[64] = (bf16_t)(cvt_pk_bf16(v2 * rs * gs[2], 0.f) & 0xffffu); Or[96] = (bf16_t)(cvt_pk_bf16(v3 * rs * gs[3], 0.f) & 0xffffu);
                }
            }
        }
    }
}

__device__ __forceinline__ const float* xin_row(const Params& p, int row, bool from_input) {
    if (from_input) return row < MLAT ? p.x + (size_t)row * DM : p.ctx + (size_t)(row - MLAT) * DM;
    return row < MLAT ? p.out + (size_t)row * DM : (const float*)(p.ws + WS_XC) + (size_t)(row - MLAT) * DM;
}
__device__ __forceinline__ float* xout_row(const Params& p, int row) {
    return row < MLAT ? p.out + (size_t)row * DM : (float*)(p.ws + WS_XC) + (size_t)(row - MLAT) * DM;
}

__device__ __forceinline__ void phase_rn(const Params& p, int layer, int stage, const bf16_t* Y, int nrows, int npart) {
    const int tid = tid_opaque(), wid = tid >> 6, lane = tid & 63;
    const float* MOD = (const float*)(p.ws + WS_MOD); bf16_t* H = (bf16_t*)(p.ws + WS_H);
    const int gate_c = stage == 0 ? 2 : 5;
    const float* gA = p.norm_g + (layer * 4 + (stage == 0 ? 1 : 3)) * DM;
    const bool has_next = !(layer == 3 && stage == 1);
    const int nl = stage == 0 ? layer : layer + 1;
    const float* gB = p.norm_g + ((has_next ? nl : 0) * 4 + (stage == 0 ? 2 : 0)) * DM;
    const int sh_c = stage == 0 ? 3 : 0, sc_c = stage == 0 ? 4 : 1;
    const bool from_input = (layer == 0 && stage == 0);
    for (int row = (blockIdx.x * 8 + wid) * 2; row < nrows; row += gridDim.x * 16) {
        const int mr = modrow(row);
        const float* xi = xin_row(p, row, from_input); float* xo = xout_row(p, row);
        const bf16_t* y = Y + (size_t)row * DM;
        const float* mg = MOD + ((size_t)layer * 17 + mr) * 6144 + gate_c * DM;
        u32x2 yw[2][4]; f32x4 xx[2][4], gg[4], gt[4];
#pragma unroll
        for (int q = 0; q < 2; ++q)
#pragma unroll
            for (int i = 0; i < 4; ++i) { yw[q][i] = *(const u32x2*)(y + q * DM + i * 256 + lane * 4); xx[q][i] = *(const f32x4*)(xi + q * DM + i * 256 + lane * 4); }
#pragma unroll
        for (int i = 0; i < 4; ++i) { gg[i] = *(const f32x4*)(gA + i * 256 + lane * 4); gt[i] = *(const f32x4*)(mg + i * 256 + lane * 4); }
        float yv[2][16]; float ss[2] = {0.f, 0.f};
#pragma unroll
        for (int q = 0; q < 2; ++q)
#pragma unroll
            for (int i = 0; i < 4; ++i) { yv[q][4 * i] = bf_lo(yw[q][i].x); yv[q][4 * i + 1] = bf_hi(yw[q][i].x); yv[q][4 * i + 2] = bf_lo(yw[q][i].y); yv[q][4 * i + 3] = bf_hi(yw[q][i].y); }
        if (npart > 1 && row >= MLAT) {
            const bf16_t* yp = (const bf16_t*)(p.ws + WS_SCR) + (size_t)(row - MLAT) * DM;
#pragma unroll
            for (int q = 0; q < 2; ++q)
#pragma unroll
                for (int i = 0; i < 4; ++i) { float a4[4] = {0.f, 0.f, 0.f, 0.f};
                    for (int k = 0; k < npart; ++k) { float t4[4]; load_bf4(yp + (size_t)k * MCTX * DM + q * DM + i * 256 + lane * 4, t4); a4[0] += t4[0]; a4[1] += t4[1]; a4[2] += t4[2]; a4[3] += t4[3]; }
                    yv[q][4 * i] = a4[0]; yv[q][4 * i + 1] = a4[1]; yv[q][4 * i + 2] = a4[2]; yv[q][4 * i + 3] = a4[3]; }
        }
#pragma unroll
        for (int q = 0; q < 2; ++q)
#pragma unroll
            for (int i = 0; i < 16; ++i) ss[q] += yv[q][i] * yv[q][i];
#pragma unroll
        for (int o = 32; o >= 1; o >>= 1) { ss[0] += __shfl_xor(ss[0], o); ss[1] += __shfl_xor(ss[1], o); }
        float ss2[2] = {0.f, 0.f};
#pragma unroll
        for (int q = 0; q < 2; ++q) { const float r1 = rsqrtf(ss[q] * (1.0f / DM) + EPS);
#pragma unroll
            for (int i = 0; i < 4; ++i) { f32x4 xn;
#pragma unroll
                for (int j = 0; j < 4; ++j) { xn[j] = xx[q][i][j] + gt[i][j] * (yv[q][4 * i + j] * r1 * gg[i][j]); ss2[q] += xn[j] * xn[j]; }
                xx[q][i] = xn; *(f32x4*)(xo + q * DM + i * 256 + lane * 4) = xn; } }
        if (has_next) {
            const float* msh = MOD + ((size_t)nl * 17 + mr) * 6144 + sh_c * DM; const float* msc = MOD + ((size_t)nl * 17 + mr) * 6144 + sc_c * DM;
            f32x4 gb[4], sh[4], sc[4];
#pragma unroll
            for (int i = 0; i < 4; ++i) { gb[i] = *(const f32x4*)(gB + i * 256 + lane * 4); sh[i] = *(const f32x4*)(msh + i * 256 + lane * 4); sc[i] = *(const f32x4*)(msc + i * 256 + lane * 4); }
#pragma unroll
            for (int o = 32; o >= 1; o >>= 1) { ss2[0] += __shfl_xor(ss2[0], o); ss2[1] += __shfl_xor(ss2[1], o); }
#pragma unroll
            for (int q = 0; q < 2; ++q) { const float r2 = rsqrtf(ss2[q] * (1.0f / DM) + EPS);
#pragma unroll
                for (int i = 0; i < 4; ++i) { float hv[4];
#pragma unroll
                    for (int j = 0; j < 4; ++j) hv[j] = (xx[q][i][j] * r2 * gb[i][j]) * (1.0f + sc[i][j]) + sh[i][j];
                    store_bf4(H + (size_t)(row + q) * DM + i * 256 + lane * 4, hv[0], hv[1], hv[2], hv[3]); } }
        }
    }
}

template <int I> __device__ __forceinline__ void poold_group(const float* xb, const float* RSs, int t0, int len, int lane, const float* g0, const float* msc, bf16_t* Hrow0) {
    constexpr int W = 2 << I, LO = W / 2, HI = W - 1 - LO, NR = 8 + W - 1;
    const int col = I * 256 + lane * 4;
    f32x4 xs[NR];
#pragma unroll
    for (int k = 0; k < NR; ++k) { const int tt = t0 - LO + k; const bool ok = (tt >= 0 && tt < len); const int tc = ok ? tt : t0;
        const f32x4 xx = *(const f32x4*)(xb + (size_t)tc * DM + col); const float rs = ok ? RSs[tc] : 0.f; xs[k] = xx * rs; }
    const f32x4 gg = *(const f32x4*)(g0 + col), sc = *(const f32x4*)(msc + col);
    f32x4 gm;
#pragma unroll
    for (int j = 0; j < 4; ++j) gm[j] = gg[j] * (1.0f + sc[j]);
    f32x4 S = xs[0];
#pragma unroll
    for (int k = 1; k < W; ++k) S += xs[k];
#pragma unroll
    for (int r = 0; r < 8; ++r) {
        const int t = t0 + r; const int ta = max(t - LO, 0), tb = min(t + HI + 1, len); const float inv = 1.0f / (float)(tb - ta);
        const f32x4 d = (S * inv - xs[r + LO]) * gm;
        store_bf4(Hrow0 + (size_t)r * DM + col, d[0], d[1], d[2], d[3]);
        if (r < 7) S += xs[r + W] - xs[r];
    }
}
__device__ __forceinline__ void phase_poold(const Params& p) {
    const int tid = tid_opaque(), wid = tid >> 6, lane = tid & 63;
    const float* MOD = (const float*)(p.ws + WS_MOD); const float* RS = (const float*)(p.ws + WS_RS); bf16_t* H = (bf16_t*)(p.ws + WS_H);
    const float* g0 = p.norm_g;
    for (int task = blockIdx.x * 8 + wid; task < (MALL / 8) * 4; task += gridDim.x * 8) {
        const int row = (task >> 2) * 8, grp = task & 3;
        const int mr = modrow(row);
        const int s0 = row < MLAT ? (row & ~(SEQ - 1)) : MLAT + ((row - MLAT) & ~(CTXL - 1)); const int len = row < MLAT ? SEQ : CTXL; const int t0 = row - s0;
        const float* xb = row < MLAT ? p.x + (size_t)s0 * DM : p.ctx + (size_t)(s0 - MLAT) * DM;
        const float* msc = MOD + ((size_t)0 * 17 + mr) * 6144 + 1 * DM;
        bf16_t* Hr = H + (size_t)row * DM;
        if (grp == 0) poold_group<0>(xb, RS + s0, t0, len, lane, g0, msc, Hr);
        else if (grp == 1) poold_group<1>(xb, RS + s0, t0, len, lane, g0, msc, Hr);
        else if (grp == 2) poold_group<2>(xb, RS + s0, t0, len, lane, g0, msc, Hr);
        else poold_group<3>(xb, RS + s0, t0, len, lane, g0, msc, Hr);
    }
}

__device__ __forceinline__ void phase_conv(const Params& p) {
    const int tid = tid_opaque(), wid = tid >> 6, lane = tid & 63;
    const bf16_t* T1 = (const bf16_t*)(p.ws + WS_T1); bf16_t* H = (bf16_t*)(p.ws + WS_H);
    for (int task = blockIdx.x * 8 + wid; task < (MALL / 8) * 4; task += gridDim.x * 8) {
        const int row = (task >> 2) * 8;
        const int s0 = row < MLAT ? (row & ~(SEQ - 1)) : MLAT + ((row - MLAT) & ~(CTXL - 1)); const int len = row < MLAT ? SEQ : CTXL; const int t0 = row - s0;
        { const int i = task & 3;
            const int col = i * 256 + lane * 4;
            u32x2 cw[10], vw[10], bw[8];
#pragma unroll
            for (int k = 0; k < 10; ++k) { const int tt = t0 - 1 + k; const bool ok = (tt >= 0 && tt < len); const int tc = ok ? tt : t0;
                const bf16_t* rp = T1 + (size_t)(s0 + tc) * 3072; cw[k] = *(const u32x2*)(rp + 1024 + col); vw[k] = *(const u32x2*)(rp + 2048 + col);
                if (!ok) { cw[k].x = 0u; cw[k].y = 0u; } }
#pragma unroll
            for (int r = 0; r < 8; ++r) bw[r] = *(const u32x2*)(T1 + (size_t)(row + r) * 3072 + col);
            const f32x4 w0 = *(const f32x4*)(p.conv_w + col), w1 = *(const f32x4*)(p.conv_w + DM + col), w2 = *(const f32x4*)(p.conv_w + 2 * DM + col);
            f32x4 u[10];
#pragma unroll
            for (int k = 0; k < 10; ++k) { u[k][0] = bf_lo(cw[k].x) * bf_lo(vw[k].x); u[k][1] = bf_hi(cw[k].x) * bf_hi(vw[k].x); u[k][2] = bf_lo(cw[k].y) * bf_lo(vw[k].y); u[k][3] = bf_hi(cw[k].y) * bf_hi(vw[k].y); }
#pragma unroll
            for (int r = 0; r < 8; ++r) { const f32x4 z = u[r] * w0 + u[r + 1] * w1 + u[r + 2] * w2;
                store_bf4(H + (size_t)(row + r) * DM + col, bf_lo(bw[r].x) * z[0], bf_hi(bw[r].x) * z[1], bf_lo(bw[r].y) * z[2], bf_hi(bw[r].y) * z[3]); }
        }
    }
}

__device__ __forceinline__ void phase_mlaprep(const Params& p) {
    const int tid = tid_opaque(), wid = tid >> 6, lane = tid & 63;
    bf16_t* T1 = (bf16_t*)(p.ws + WS_T1); bf16_t* CKV = (bf16_t*)(p.ws + WS_H); const float* rope = (const float*)(p.ws + WS_ROPE);
    for (int row4 = (blockIdx.x * 8 + wid) * 4; row4 < MALL; row4 += gridDim.x * 32) {
      u32x2 araw[4][3];
#pragma unroll
      for (int q = 0; q < 4; ++q)
#pragma unroll
        for (int i = 0; i < 3; ++i) araw[q][i] = *(const u32x2*)(T1 + T_AB + (size_t)(row4 + q) * 768 + i * 256 + lane * 4);
#pragma unroll
      for (int q = 0; q < 4; ++q) {
        const int row = row4 + q;
        float v[12]; float sq = 0.f, skv = 0.f;
#pragma unroll
        for (int i = 0; i < 3; ++i) { const int col = i * 256 + lane * 4; v[4 * i] = bf_lo(araw[q][i].x); v[4 * i + 1] = bf_hi(araw[q][i].x); v[4 * i + 2] = bf_lo(araw[q][i].y); v[4 * i + 3] = bf_hi(araw[q][i].y);
            const float s = v[4 * i] * v[4 * i] + v[4 * i + 1] * v[4 * i + 1] + v[4 * i + 2] * v[4 * i + 2] + v[4 * i + 3] * v[4 * i + 3];
            if (col < 384) sq += s; else if (col < 640) skv += s; }
        sq = wave_sum(sq); skv = wave_sum(skv);
        const float rq = rsqrtf(sq * (1.0f / 384.0f) + EPS), rkv = rsqrtf(skv * (1.0f / 256.0f) + EPS);
#pragma unroll
        for (int i = 0; i < 3; ++i) { const int col = i * 256 + lane * 4;
            if (col < 384) { const f32x4 g = *(const f32x4*)(p.mla_g_q + col);
                store_bf4(T1 + T_CQ + (size_t)row * 384 + col, v[4 * i] * rq * g[0], v[4 * i + 1] * rq * g[1], v[4 * i + 2] * rq * g[2], v[4 * i + 3] * rq * g[3]); }
            else if (col < 640) { const int c2 = col - 384; const f32x4 g = *(const f32x4*)(p.mla_g_kv + c2);
                store_bf4(CKV + (size_t)row * 256 + c2, v[4 * i] * rkv * g[0], v[4 * i + 1] * rkv * g[1], v[4 * i + 2] * rkv * g[2], v[4 * i + 3] * rkv * g[3]); }
        }
        {
            float pv[4];
#pragma unroll
            for (int j = 0; j < 4; ++j) pv[j] = __shfl_xor(v[8 + j], 4);
            if (lane >= 32 && lane < 48) {
                const int k = lane - 32; float ov[4];
                if (row < MLAT) {
                    const int t = row & (SEQ - 1); const int pos = (k < 8) ? (t >> 6) : (t & 63);
                    const f32x4 t0 = *(const f32x4*)(rope + (pos * 16 + 4 * (k & 3)) * 2), t1 = *(const f32x4*)(rope + (pos * 16 + 4 * (k & 3)) * 2 + 4);
                    const float cs[4] = {t0[0], t0[2], t1[0], t1[2]}, sn[4] = {t0[1], t0[3], t1[1], t1[3]};
#pragma unroll
                    for (int j = 0; j < 4; ++j) ov[j] = (k & 4) ? (v[8 + j] * cs[j] + pv[j] * sn[j]) : (v[8 + j] * cs[j] - pv[j] * sn[j]);
                } else {
#pragma unroll
                    for (int j = 0; j < 4; ++j) ov[j] = v[8 + j];
                }
                store_bf4(T1 + T_KR + (size_t)row * 64 + 4 * k, ov[0], ov[1], ov[2], ov[3]);
            }
        }
      }
    }
}

__device__ __forceinline__ void conv_wt(const float* src, int K, int N, int Npad, bf16_t* dst, float* tile, int rot) {
    const int tid = tid_opaque(), G = gridDim.x;
    const int ntn = Npad / 64, ntk = K / 64, ntiles = ntn * ntk;
    const int r = tid >> 4, c4 = (tid & 15) * 4;
    int u = (blockIdx.x + G - (rot % G)) % G;
    f32x4 v0 = {0.f, 0.f, 0.f, 0.f}, v1 = {0.f, 0.f, 0.f, 0.f};
    if (u < ntiles) { const int k0 = (u / ntn) * 64, n0 = (u % ntn) * 64;
        if (n0 + c4 < N) { v0 = *(const f32x4*)(src + (size_t)(k0 + r) * N + n0 + c4); v1 = *(const f32x4*)(src + (size_t)(k0 + r + 32) * N + n0 + c4); } }
    for (; u < ntiles; u += G) {
        const int k0 = (u / ntn) * 64, n0 = (u % ntn) * 64;
        const int un = u + G; f32x4 w0 = {0.f, 0.f, 0.f, 0.f}, w1 = {0.f, 0.f, 0.f, 0.f};
        if (un < ntiles) { const int k1 = (un / ntn) * 64, n1 = (un % ntn) * 64;
            if (n1 + c4 < N) { w0 = *(const f32x4*)(src + (size_t)(k1 + r) * N + n1 + c4); w1 = *(const f32x4*)(src + (size_t)(k1 + r + 32) * N + n1 + c4); } }
        tile[r * 65 + c4 + 0] = v0[0]; tile[r * 65 + c4 + 1] = v0[1]; tile[r * 65 + c4 + 2] = v0[2]; tile[r * 65 + c4 + 3] = v0[3];
        tile[(r + 32) * 65 + c4 + 0] = v1[0]; tile[(r + 32) * 65 + c4 + 1] = v1[1]; tile[(r + 32) * 65 + c4 + 2] = v1[2]; tile[(r + 32) * 65 + c4 + 3] = v1[3];
        __syncthreads();
        { const int n = tid >> 3, k8 = (tid & 7) * 8; float t[8];
#pragma unroll
          for (int j = 0; j < 8; ++j) t[j] = tile[(k8 + j) * 65 + n];
          u32x4 w; w.x = cvt_pk_bf16(t[0], t[1]); w.y = cvt_pk_bf16(t[2], t[3]); w.z = cvt_pk_bf16(t[4], t[5]); w.w = cvt_pk_bf16(t[6], t[7]);
          *(u32x4*)(dst + (size_t)(n0 + n) * K + k0 + k8) = w; }
        __syncthreads();
        v0 = w0; v1 = w1;
    }
}

__device__ __forceinline__ void phase_prep(const Params& p, char* lds) {
    const int tid = tid_opaque(), wid = tid >> 6, lane = tid & 63, G = gridDim.x;
    float* fl = (float*)lds;
    if (blockIdx.x < 192) {
        { f32x4 cvv[9];
#pragma unroll
          for (int q = 0; q < 9; ++q) { const int idx = tid + q * NTHREADS; const int r = idx >> 8, k4 = (idx & 255) * 4; cvv[q] = (idx < 17 * 256) ? *(const f32x4*)(r < 16 ? p.c + r * 1024 + k4 : p.c_ctx + k4) : (f32x4){0.f, 0.f, 0.f, 0.f}; }
#pragma unroll
          for (int q = 0; q < 9; ++q) { const int idx = tid + q * NTHREADS; const int r = idx >> 8, k4 = (idx & 255) * 4;
              if (idx < 17 * 256) {
#pragma unroll
                  for (int j = 0; j < 4; ++j) fl[(k4 + j) * 17 + r] = cvv[q][j] / (1.0f + expf(-cvv[q][j])); } } }
        __syncthreads();
        float* MOD = (float*)(p.ws + WS_MOD);
        for (int u = blockIdx.x; u < 192; u += G) {
            const int layer = u / 48, cb = u % 48, col0 = cb * 128 + wid * 16 + (lane & 3) * 4, kq = lane >> 2;
            float acc[17][4];
#pragma unroll
            for (int r = 0; r < 17; ++r)
#pragma unroll
                for (int j = 0; j < 4; ++j) acc[r][j] = 0.f;
            const float* W = p.ada_w + (size_t)layer * 1024 * 6144 + col0;
#pragma unroll 8
            for (int itk = 0; itk < 64; ++itk) { const int k = kq + 16 * itk; const f32x4 w = *(const f32x4*)(W + (size_t)k * 6144);
#pragma unroll
                for (int r = 0; r < 17; ++r) { const float s_ = fl[k * 17 + r];
#pragma unroll
                    for (int j = 0; j < 4; ++j) acc[r][j] += s_ * w[j]; } }
#pragma unroll
            for (int r = 0; r < 17; ++r)
#pragma unroll
                for (int j = 0; j < 4; ++j) { float v = acc[r][j]; v += __shfl_xor(v, 4); v += __shfl_xor(v, 8); v += __shfl_xor(v, 16); v += __shfl_xor(v, 32); acc[r][j] = v; }
            if (kq == 0) { const f32x4 bb = *(const f32x4*)(p.ada_b + layer * 6144 + col0);
#pragma unroll
                for (int r = 0; r < 17; ++r) { f32x4 o = {acc[r][0] + bb[0], acc[r][1] + bb[1], acc[r][2] + bb[2], acc[r][3] + bb[3]}; *(f32x4*)(MOD + ((size_t)layer * 17 + r) * 6144 + col0) = o; } }
        }
        __syncthreads();
    }
    if (blockIdx.x == G - 1) {
        float* rt = (float*)(p.ws + WS_ROPE);
        for (int idx = tid; idx < 1024; idx += NTHREADS) { const int pos = idx >> 4, f = idx & 15; const float inv = powf(10000.0f, -(float)f / 16.0f); const float ang = (float)pos * inv;
            rt[idx * 2] = cosf(ang); rt[idx * 2 + 1] = sinf(ang); }
    }
    { float* RS = (float*)(p.ws + WS_RS);
      for (int row = (blockIdx.x * 8 + wid) * 4; row < MALL; row += G * 32) { const float* xi = xin_row(p, row, true); f32x4 xx[4][4];
#pragma unroll
          for (int q = 0; q < 4; ++q)
#pragma unroll
              for (int i = 0; i < 4; ++i) xx[q][i] = *(const f32x4*)(xi + q * DM + i * 256 + lane * 4);
          float ss[4] = {0.f, 0.f, 0.f, 0.f};
#pragma unroll
          for (int q = 0; q < 4; ++q)
#pragma unroll
              for (int i = 0; i < 4; ++i) ss[q] += xx[q][i][0] * xx[q][i][0] + xx[q][i][1] * xx[q][i][1] + xx[q][i][2] * xx[q][i][2] + xx[q][i][3] * xx[q][i][3];
#pragma unroll
          for (int o = 32; o >= 1; o >>= 1) { ss[0] += __shfl_xor(ss[0], o); ss[1] += __shfl_xor(ss[1], o); ss[2] += __shfl_xor(ss[2], o); ss[3] += __shfl_xor(ss[3], o); }
          if (lane < 4) RS[row + lane] = rsqrtf((lane == 0 ? ss[0] : lane == 1 ? ss[1] : lane == 2 ? ss[2] : ss[3]) * (1.0f / DM) + EPS); } }
    bf16_t* W = (bf16_t*)(p.ws + WS_W);
    int rot = 192;
    for (int l = 0; l < 4; ++l) {
        conv_wt(p.ffn_w1 + (size_t)l * 1024 * 4096, 1024, 4096, 4096, W + W_FFN + (size_t)l * 8388608, fl, rot); rot += 1024;
        conv_wt(p.ffn_w2 + (size_t)l * 4096 * 1024, 4096, 1024, 1024, W + W_FFN + (size_t)l * 8388608 + 4194304, fl, rot); rot += 1024;
    }
    for (int g = 0; g < 4; ++g) { conv_wt(p.pool_w + (size_t)g * 65536, 256, 256, 256, W + W_POOL + (size_t)g * 65536, fl, rot); rot += 16; }
    conv_wt(p.conv_in_w, 1024, 3072, 3072, W + W_CIN, fl, rot); rot += 768;
    conv_wt(p.conv_out_w, 1024, 1024, 1024, W + W_COUT, fl, rot); rot += 256;
    conv_wt(p.mla_w_down, 1024, 704, 768, W + W_DOWN, fl, rot); rot += 192;
    conv_wt(p.mla_w_uq, 384, 1536, 1536, W + W_UQ, fl, rot); rot += 144;
    conv_wt(p.mla_w_ukv, 256, 2048, 2048, W + W_UKV, fl, rot); rot += 128;
    conv_wt(p.mla_w_o, 1024, 1024, 1024, W + W_MO, fl, rot); rot += 256;
    conv_wt(p.diff_w_qkv, 1024, 3072, 3072, W + W_DQKV, fl, rot); rot += 768;
    conv_wt(p.diff_w_o, 1024, 1024, 1024, W + W_DO, fl, rot);
}

__device__ __forceinline__ void grid_barrier(unsigned* bar, unsigned gen) {
    asm volatile("s_waitcnt vmcnt(0) lgkmcnt(0)" ::: "memory");
    __syncthreads();
    if (threadIdx.x < 64) {
        if (threadIdx.x == 0) {
            const unsigned g = blockIdx.x & 7, G = gridDim.x, gsize = (G + 7 - g) >> 3, ng = G < 8 ? G : 8;
            __builtin_amdgcn_fence(__ATOMIC_RELEASE, "agent");
            asm volatile("s_waitcnt vmcnt(0)" ::: "memory");
            if (__hip_atomic_fetch_add(bar + 64 * (1 + g), 1u, __ATOMIC_RELAXED, __HIP_MEMORY_SCOPE_AGENT) + 1 == gen * gsize) {
                if (__hip_atomic_fetch_add(bar, 1u, __ATOMIC_RELAXED, __HIP_MEMORY_SCOPE_AGENT) + 1 == gen * ng) {
                    for (unsigned j = 0; j < ng; ++j) __hip_atomic_store(bar + 64 * (9 + j), gen, __ATOMIC_RELAXED, __HIP_MEMORY_SCOPE_AGENT);
                }
            }
            while (__hip_atomic_load(bar + 64 * (9 + g), __ATOMIC_RELAXED, __HIP_MEMORY_SCOPE_AGENT) < gen) __builtin_amdgcn_s_sleep(1);
        }
        __builtin_amdgcn_fence(__ATOMIC_ACQUIRE, "agent");
        asm volatile("s_waitcnt vmcnt(0)" ::: "memory");
    }
    __syncthreads();
}

enum { T_PREP = 0, T_POOLD, T_GEMM, T_RN, T_CONV, T_MLAPREP, T_ATTN_MLA, T_ATTN_DIFF };
constexpr int N_PHASES = 31;

__global__ void __launch_bounds__(NTHREADS, 2) mk_fwd(Params p_arg) {
    extern __shared__ __attribute__((aligned(16))) unsigned char shm[];
    LAS unsigned char* ldsl = (LAS unsigned char*)shm; char* ldsg = (char*)shm;
    const int ph_lo = p_arg.ph_lo, ph_hi = p_arg.ph_hi; unsigned char* const wsb = p_arg.ws;
    bf16_t* H = (bf16_t*)(wsb + WS_H); bf16_t* T1 = (bf16_t*)(wsb + WS_T1); const bf16_t* W = (const bf16_t*)(wsb + WS_W);
    const float* rope = (const float*)(wsb + WS_ROPE);
    unsigned nbar = 0; unsigned* barcnt = (unsigned*)(wsb + WS_BAR);
    for (int ph = ph_lo; ph < ph_hi; ++ph) {
#if defined(__HIP_DEVICE_COMPILE__)
        typedef const __attribute__((address_space(4))) Params* KArgP;
        KArgP pp = (KArgP)__builtin_amdgcn_kernarg_segment_ptr(); asm volatile("" : "+s"(pp));
        const Params p = *pp;
#else
        const Params p = p_arg;
#endif
        int type = T_GEMM, sync = 1, layer = 0, stage = 0, nrows = MALL, npart = 1; const bf16_t* Y = T1;
        GemmP g; g.A = H; g.Bt = W; g.lda = 1024; g.ldb = 1024; g.K = 1024; g.nM = 144; g.nN = 4; g.a_pn_off = 0; g.ksplit = 1; g.a_tiled = 0; g.rev = 0; g.magicN = 16384;
        EpiP e; e.O = T1; e.ldo = 1024; e.mode = 0; e.colscale = nullptr; e.rope = rope; e.Opart = (bf16_t*)(wsb + WS_SCR);
        switch (ph) {
        case 0: type = T_PREP; break;
        case 1: type = T_POOLD; break;
        case 2: g.Bt = W + W_POOL; g.ldb = 256; g.K = 256; g.a_pn_off = 256; e.colscale = p.pool_scale; break;
        case 3: type = T_RN; layer = 0; stage = 0; Y = T1; break;
        case 4: case 11: case 21: case 28: { const int l = ph == 4 ? 0 : ph == 11 ? 1 : ph == 21 ? 2 : 3;
            g.Bt = W + W_FFN + (size_t)l * 8388608; g.nN = 16; g.magicN = 4096; g.nM = l == 3 ? 128 : 144; e.ldo = 4096; e.mode = 1; } break;
        case 5: case 12: case 22: case 29: { const int l = ph == 5 ? 0 : ph == 12 ? 1 : ph == 22 ? 2 : 3;
            g.A = T1; g.lda = 4096; g.Bt = W + W_FFN + (size_t)l * 8388608 + 4194304; g.ldb = 4096; g.K = 4096; g.nM = l == 3 ? 128 : 144; g.ksplit = l == 3 ? 1 : 4; g.a_tiled = 1; e.O = H; } break;
        case 6: type = T_RN; layer = 0; stage = 1; Y = H; npart = 4; break;
        case 7: g.Bt = W + W_CIN; g.nN = 12; g.magicN = 5462; e.ldo = 3072; break;
        case 8: type = T_CONV; break;
        case 9: g.Bt = W + W_COUT; g.ksplit = 4; break;
        case 10: type = T_RN; layer = 1; stage = 0; Y = T1; npart = 4; break;
        case 13: type = T_RN; layer = 1; stage = 1; Y = H; npart = 4; break;
        case 14: g.Bt = W + W_DOWN; g.nN = 3; g.magicN = 21846; e.O = T1 + T_AB; e.ldo = 768; break;
        case 15: type = T_MLAPREP; break;
        case 16: g.A = T1 + T_CQ; g.lda = 384; g.Bt = W + W_UQ; g.ldb = 384; g.K = 384; g.nN = 6; g.magicN = 10923; e.O = T1 + T_Q; e.ldo = 1536; e.mode = 3; break;
        case 17: sync = 0; g.rev = 1; g.A = H; g.lda = 256; g.Bt = W + W_UKV; g.ldb = 256; g.K = 256; g.nN = 8; g.magicN = 8192; e.O = T1 + T_KV; e.ldo = 2048; break;
        case 18: type = T_ATTN_MLA; break;
        case 19: g.Bt = W + W_MO; g.ksplit = 4; break;
        case 20: type = T_RN; layer = 2; stage = 0; Y = T1; npart = 4; break;
        case 23: type = T_RN; layer = 2; stage = 1; Y = H; npart = 4; break;
        case 24: g.Bt = W + W_DQKV; g.nN = 12; g.magicN = 5462; e.ldo = 3072; e.mode = 2; break;
        case 25: type = T_ATTN_DIFF; break;
        case 26: g.Bt = W + W_DO; g.nM = 128; break;
        case 27: type = T_RN; layer = 3; stage = 0; Y = T1; nrows = MLAT; break;
        case 30: type = T_RN; layer = 3; stage = 1; Y = H; nrows = MLAT; break;
        default: break;
        }
        if (ph > ph_lo && sync) { if (ph_hi > N_PHASES) cg::this_grid().sync(); else { ++nbar; grid_barrier(barcnt, nbar); } }
#ifdef REPEAT_MASK
        for (int rep_ = 0; rep_ < (((REPEAT_MASK) >> ph) & 1 ? 2 : 1); ++rep_) {
        if (rep_) cg::this_grid().sync();
#endif
        switch (type) {
#ifndef PH_MASK
#define PH_MASK 0xff
#endif
#if PH_MASK & 1
        case T_PREP: phase_prep(p, ldsg); break;
#endif
#if PH_MASK & 2
        case T_POOLD: phase_poold(p); break;
#endif
#if PH_MASK & 4
        case T_GEMM: gemm_phase(ldsl, g, e); break;
#endif
#if PH_MASK & 8
        case T_RN: phase_rn(p, layer, stage, Y, nrows, npart); break;
#endif
#if PH_MASK & 16
        case T_CONV: phase_conv(p); break;
#endif
#if PH_MASK & 32
        case T_MLAPREP: phase_mlaprep(p); break;
#endif
#if PH_MASK & 64
        case T_ATTN_MLA: phase_attn_mla(p, ldsg); break;
#endif
#if PH_MASK & 128
        case T_ATTN_DIFF: phase_attn_diff(p, ldsg); break;
#endif
        }
#ifdef REPEAT_MASK
        }
#endif
    }
}

extern "C" void kernel_launch(void* const* d_in, const int* in_sizes, int n_in, void* d_out, int out_size, void* d_ws, size_t ws_size, hipStream_t stream) {
    static int grid = 0;
    if (grid == 0) {
        if (n_in != 24 || out_size != MLAT * DM || ws_size < WS_END) { fprintf(stderr, "kernel_launch: unexpected shapes (n_in %d out %d ws %zu need %zu)\n", n_in, out_size, ws_size, (size_t)WS_END); grid = -1; return; }
        if (hipFuncSetAttribute((const void*)mk_fwd, hipFuncAttributeMaxDynamicSharedMemorySize, LDS_BYTES) != hipSuccess) { fprintf(stderr, "kernel_launch: hipFuncSetAttribute failed\n"); grid = -1; return; }
        int dev = 0, cus = 0, per_cu = 0;
        (void)hipGetDevice(&dev); (void)hipDeviceGetAttribute(&cus, hipDeviceAttributeMultiprocessorCount, dev);
        (void)hipOccupancyMaxActiveBlocksPerMultiprocessor(&per_cu, (const void*)mk_fwd, NTHREADS, LDS_BYTES);
        if (per_cu < 1) { fprintf(stderr, "kernel_launch: occupancy query says %d blocks per CU\n", per_cu); per_cu = 1; }
        (void)hipGetLastError();
        grid = cus * 1;
        if (grid > 256) grid = 256;
    }
    if (grid < 0) return;
    Params p{};
    const float** pp = (const float**)&p;
    for (int i = 0; i < 24; ++i) pp[i] = (const float*)d_in[i];
    p.out = (float*)d_out; p.ws = (unsigned char*)d_ws;
#if MK_ONE_LAUNCH
    (void)hipMemsetAsync((char*)d_ws + WS_BAR, 0, 17 * 256, stream);
    p.ph_lo = 0; p.ph_hi = N_PHASES;
    void* args[] = {&p};
    hipError_t e = hipLaunchCooperativeKernel((const void*)mk_fwd, dim3(grid), dim3(NTHREADS), args, LDS_BYTES, stream);
    if (e != hipSuccess) fprintf(stderr, "cooperative launch failed: %s (grid %d)\n", hipGetErrorString(e), grid);
#else
    for (int ph = 0; ph < N_PHASES; ++ph) {
        p.ph_lo = ph; p.ph_hi = ph + 1;
        hipLaunchKernelGGL(mk_fwd, dim3(grid), dim3(NTHREADS), LDS_BYTES, stream, p);
    }
#endif
}
```

```cpp
#include <hip/hip_runtime.h>
#include <hip/hip_cooperative_groups.h>
#include <cstdio>
#include <cstdint>
namespace cg = cooperative_groups;

#ifndef MK_ONE_LAUNCH
#define MK_ONE_LAUNCH 1
#endif

#define LAS __attribute__((address_space(3)))
typedef unsigned short bf16_t;
typedef short bf16x8 __attribute__((ext_vector_type(8)));
typedef short s16x4 __attribute__((ext_vector_type(4)));
typedef float f32x4 __attribute__((ext_vector_type(4)));
typedef float f32x16 __attribute__((ext_vector_type(16)));
typedef unsigned u32x4 __attribute__((ext_vector_type(4)));
typedef unsigned u32x2 __attribute__((ext_vector_type(2)));

constexpr int DM = 1024, NB = 16, SEQ = 2048, CTXL = 256, MLAT = NB * SEQ, MCTX = NB * CTXL, MALL = MLAT + MCTX;
constexpr float EPS = 1e-6f;
constexpr int NTHREADS = 512;
#ifndef MLA_NQL
#define MLA_NQL 4
#endif
constexpr int LDS_BYTES = (32768 + 49152 + 2048 + MLA_NQL * 8192) > 131072 ? (32768 + 49152 + 2048 + MLA_NQL * 8192) : 131072;

constexpr size_t WS_XC = 0;
constexpr size_t WS_H = WS_XC + (size_t)MCTX * DM * 4;
constexpr size_t WS_T1 = WS_H + (size_t)MALL * DM * 2;
constexpr size_t WS_W = WS_T1 + (size_t)MALL * 4096 * 2;
constexpr size_t W_ELTS = 45154304;
constexpr size_t WS_MOD = WS_W + W_ELTS * 2;
constexpr size_t WS_RS = WS_MOD + (size_t)4 * 17 * 6144 * 4;
constexpr size_t WS_ROPE = WS_RS + (size_t)MALL * 4;
constexpr size_t WS_SCR = WS_ROPE + 8192;
constexpr size_t WS_BAR = WS_SCR + (size_t)256 * 64 * 512 * 4;
constexpr size_t WS_END = WS_BAR + 17 * 256;
static_assert(WS_SCR % 256 == 0 && WS_MOD % 256 == 0 && WS_RS % 256 == 0 && WS_ROPE % 256 == 0, "align");
static_assert(WS_END <= 536870912ull, "workspace budget");
constexpr size_t W_FFN = 0;
constexpr size_t W_POOL = 33554432;
constexpr size_t W_CIN = W_POOL + 262144;
constexpr size_t W_COUT = W_CIN + 3145728;
constexpr size_t W_DOWN = W_COUT + 1048576;
constexpr size_t W_UQ = W_DOWN + 786432;
constexpr size_t W_UKV = W_UQ + 589824;
constexpr size_t W_MO = W_UKV + 524288;
constexpr size_t W_DQKV = W_MO + 1048576;
constexpr size_t W_DO = W_DQKV + 3145728;
static_assert(W_DO + 1048576 == W_ELTS, "weights");
constexpr size_t T_Q = 0;
constexpr size_t T_KV = T_Q + (size_t)MALL * 1536;
constexpr size_t T_CQ = T_KV + (size_t)MALL * 2048;
constexpr size_t T_KR = T_CQ + (size_t)MALL * 384;
constexpr size_t T_AB = T_KV;
static_assert(T_KR + (size_t)MALL * 64 <= (size_t)MALL * 4096, "arena");

struct Params {
    const float *x, *c, *ctx, *c_ctx, *ada_w, *ada_b, *norm_g, *ffn_w1, *ffn_w2, *pool_w, *pool_scale, *conv_in_w, *conv_w, *conv_out_w,
        *mla_w_down, *mla_g_q, *mla_g_kv, *mla_w_uq, *mla_w_ukv, *mla_w_o, *diff_w_qkv, *diff_lambda, *diff_g_subln, *diff_w_o;
    float* out; unsigned char* ws; int ph_lo, ph_hi;
};

__device__ __forceinline__ int tid_opaque() { int t = threadIdx.x; asm volatile("" : "+v"(t)); return t; }
__device__ __forceinline__ unsigned cvt_pk_bf16(float lo, float hi) { unsigned r; asm volatile("v_cvt_pk_bf16_f32 %0, %1, %2" : "=v"(r) : "v"(lo), "v"(hi)); return r; }
__device__ __forceinline__ float bf_lo(unsigned w) { return __uint_as_float(w << 16); }
__device__ __forceinline__ float bf_hi(unsigned w) { return __uint_as_float(w & 0xffff0000u); }
__device__ __forceinline__ float wave_sum(float v) {
#pragma unroll
    for (int o = 32; o >= 1; o >>= 1) v += __shfl_xor(v, o);
    return v;
}
__device__ __forceinline__ int modrow(int row) { return row < MLAT ? (row >> 11) : NB; }
__device__ __forceinline__ void load_bf4(const bf16_t* p, float* v) { const u32x2 w = *(const u32x2*)p; v[0] = bf_lo(w.x); v[1] = bf_hi(w.x); v[2] = bf_lo(w.y); v[3] = bf_hi(w.y); }
__device__ __forceinline__ void store_bf4(bf16_t* p, float a, float b, float c, float d) { u32x2 w; w.x = cvt_pk_bf16(a, b); w.y = cvt_pk_bf16(c, d); *(u32x2*)p = w; }

constexpr int BM = 256, BK = 64, HALF = 128, HTB = HALF * BK * 2;
__device__ __forceinline__ int lds_byte(int r, int c) { const int st = (r >> 4) * 2 + (c >> 5), rr = r & 15, cc = c & 31, ob = rr * 64 + cc * 2; return st * 1024 + (ob ^ (((ob >> 9) & 1) << 5)); }
__device__ __forceinline__ void stage_rc(int b, int& R, int& C) { const int st = b / 1024, sb = b % 1024, swz = sb ^ (((sb >> 9) & 1) << 5); R = (st >> 1) * 16 + swz / 64; C = (st & 1) * 32 + (swz % 64) / 2; }

struct Unit { int pm, pn, ks, nt; };
struct GemmP { const bf16_t* A; const bf16_t* Bt; int lda, ldb, K, nM, nN, a_pn_off, ksplit, a_tiled, rev, magicN; };
struct EpiP { bf16_t* O; int ldo; int mode; const float* colscale; const float* rope; bf16_t* Opart; };

__device__ __forceinline__ bool unit_next(const GemmP& g, int i, Unit& u) {
    const int nMf = g.ksplit > 1 ? 128 : g.nM;
    const int nwg = nMf * g.nN; const int L = i * (int)gridDim.x + (g.rev ? (int)gridDim.x - 1 - (int)blockIdx.x : (int)blockIdx.x);
    if (L >= nwg) {
        if (g.ksplit <= 1) return false;
        const int idx = L - nwg; if (idx >= (g.nM - nMf) * 16) return false;
        u.pm = nMf + (idx >> 4); const int r = idx & 15; u.pn = r >> 2; u.ks = r & 3; u.nt = g.K >> 8; return true;
    }
    int wgid = L; { const int q = nwg >> 3, xcd = wgid & 7, off = wgid >> 3; wgid = xcd * q + off; }
    const int w8 = wgid >> 3, gid = (w8 * g.magicN) >> 16, rem = wgid - gid * 8 * g.nN;
    u.pm = gid * 8 + (rem & 7); u.pn = rem >> 3; u.ks = -1; u.nt = g.K >> 6; return true;
}

__device__ __forceinline__ void epi_store(const f32x4 (&acc)[2][2][4][2], const Unit& u, int wr, int wc, int fr, int fq, const EpiP& e) {
    const int row0 = u.pm * BM + wr * 64 + fr;
    if (e.mode < 2) {
        const int col0 = u.pn * BM + wc * 32 + 8 * fq;
#pragma unroll
        for (int bj = 0; bj < 2; ++bj) {
            const int c = col0 + bj * HALF;
            f32x4 cs0 = {1.f, 1.f, 1.f, 1.f}, cs1 = {1.f, 1.f, 1.f, 1.f};
            if (e.mode == 0 && e.colscale) { cs0 = *(const f32x4*)(e.colscale + c); cs1 = *(const f32x4*)(e.colscale + c + 4); }
#pragma unroll
            for (int ai = 0; ai < 2; ++ai)
#pragma unroll
                for (int m = 0; m < 4; ++m) {
                    const int row = row0 + ai * HALF + m * 16;
                    f32x4 v0 = acc[ai][bj][m][0], v1 = acc[ai][bj][m][1];
                    if (e.mode == 1) {
#pragma unroll
                        for (int j = 0; j < 4; ++j) { const float a = fmaxf(v0[j], 0.f), b = fmaxf(v1[j], 0.f); v0[j] = a * a; v1[j] = b * b; }
                    } else { v0 *= cs0; v1 *= cs1; }
                    bf16_t* rowp = (u.ks < 0 ? e.O + (size_t)row * e.ldo : e.Opart + ((size_t)u.ks * MCTX + (row - MLAT)) * 1024) + c;
                    if (e.mode == 1)
                        rowp = (bf16_t*)((char*)e.O + ((size_t)(u.pm * 64 + u.pn * 4 + bj * 2 + (wc >> 1))) * 32768 + ai * 16384 + (((wr * 4 + m) * 2 + (wc & 1)) * 1024) + (fr * 4 + fq) * 16);
                    u32x4 w; w.x = cvt_pk_bf16(v0[0], v0[1]); w.y = cvt_pk_bf16(v0[2], v0[3]); w.z = cvt_pk_bf16(v1[0], v1[1]); w.w = cvt_pk_bf16(v1[2], v1[3]);
                    *(u32x4*)rowp = w;
                }
        }
        return;
    }
    const int col0 = u.pn * BM + wc * 32 + 4 * fq;
#pragma unroll
    for (int bj = 0; bj < 2; ++bj) {
        const int c = col0 + bj * HALF;
        int kind = 0;
        if (e.mode == 2) { if (c < 2048) kind = ((c >> 5) & 1) ? 2 : 1; }
        else { const int d = c % 192; if (d >= 128) kind = (d >= 160) ? 2 : 1; }
#pragma unroll
        for (int ai = 0; ai < 2; ++ai)
#pragma unroll
            for (int m = 0; m < 4; ++m) {
                const int row = row0 + ai * HALF + m * 16;
                f32x4 v0 = acc[ai][bj][m][0], v1 = acc[ai][bj][m][1];
                if (kind != 0 && row < MLAT) {
                    const int t = row & (SEQ - 1); const int pos = (kind == 1) ? (t >> 6) : (t & 63);
                    const f32x4 t0 = *(const f32x4*)(e.rope + (pos * 16 + 4 * fq) * 2), t1 = *(const f32x4*)(e.rope + (pos * 16 + 4 * fq) * 2 + 4);
                    const float cs[4] = {t0[0], t0[2], t1[0], t1[2]}, sn[4] = {t0[1], t0[3], t1[1], t1[3]};
#pragma unroll
                    for (int j = 0; j < 4; ++j) { const float x1 = v0[j], x2 = v1[j]; v0[j] = x1 * cs[j] - x2 * sn[j]; v1[j] = x2 * cs[j] + x1 * sn[j]; }
                }
                bf16_t* rowp = e.O + (size_t)row * e.ldo + c;
                u32x2 w0, w1; w0.x = cvt_pk_bf16(v0[0], v0[1]); w0.y = cvt_pk_bf16(v0[2], v0[3]); w1.x = cvt_pk_bf16(v1[0], v1[1]); w1.y = cvt_pk_bf16(v1[2], v1[3]);
                const bool odd = (fq & 1) != 0;
                const unsigned sx = odd ? w0.x : w1.x, sy = odd ? w0.y : w1.y;
                const unsigned rx = (unsigned)__shfl_xor((int)sx, 16), ry = (unsigned)__shfl_xor((int)sy, 16);
                u32x4 w; if (odd) { w.x = rx; w.y = ry; w.z = w1.x; w.w = w1.y; } else { w.x = w0.x; w.y = w0.y; w.z = rx; w.w = ry; }
                *(u32x4*)(rowp + (odd ? 12 : 0)) = w;
            }
    }
}

__device__ __forceinline__ void gemm_phase(LAS unsigned char* lds, const GemmP g, const EpiP e) {
    const int tid = tid_opaque(), wid = __builtin_amdgcn_readfirstlane(tid >> 6), lane = tid & 63, wr = wid >> 2, wc = wid & 3, fr = lane & 15, fq = lane >> 4;
    unsigned voffA[2], voffB[2];
#pragma unroll
    for (int i = 0; i < 2; ++i) { int R, C; stage_rc(tid * 16 + i * 8192, R, C); const int rho = R & 31; const int Rb = (e.mode < 2) ? ((R & ~31) + 8 * ((rho & 15) >> 2) + 4 * (rho >> 4) + (rho & 3)) : R;
        voffA[i] = g.a_tiled ? (unsigned)((((R >> 4) * 2 + (C >> 5)) * 1024) + ((R & 15) * 4 + ((C >> 3) & 3)) * 16) : (unsigned)(R * g.lda + C) * 2u; voffB[i] = (unsigned)(Rb * g.ldb + C) * 2u; }
    const size_t kstepB = (size_t)(BK * 2), kstepA = g.a_tiled ? (size_t)32768 : (size_t)(BK * 2);
    const size_t hstepA = g.a_tiled ? (size_t)16384 : (size_t)HALF * g.lda * 2, hstepB = (size_t)HALF * g.ldb * 2;
    const size_t tstepA = g.a_tiled ? (size_t)(g.K / BK) * 32768 : 2 * hstepA, tstepB = 2 * hstepB;
    const unsigned ldsw = (unsigned)wid * 1024u;
    const int aoff = lds_byte(wr * 64 + fr, fq * 8), boff = lds_byte(wc * 32 + fr, fq * 8);
#define PG8_SA(b, h) (((b) * 2 + (h)) * HTB)
#define PG8_SB(b, h) ((4 + (b) * 2 + (h)) * HTB)
#define PG8_STAGE(bufoff, gbase, voff) do { _Pragma("unroll") for (int _i = 0; _i < 2; ++_i) \
        __builtin_amdgcn_global_load_lds((const unsigned*)((const char*)(gbase) + (voff)[_i]), (LAS unsigned*)(lds + (bufoff) + ldsw + _i * 8192), 16, 0, 0); } while (0)
#define PG8_LDA(dst, b, h) do { _Pragma("unroll") for (int m = 0; m < 4; ++m) _Pragma("unroll") for (int k = 0; k < 2; ++k) dst[m][k] = *(const LAS bf16x8*)(lds + PG8_SA(b, h) + aoff + m * 2048 + k * 1024); } while (0)
#define PG8_LDB(dst, b, h) do { _Pragma("unroll") for (int n = 0; n < 2; ++n) _Pragma("unroll") for (int k = 0; k < 2; ++k) dst[n][k] = *(const LAS bf16x8*)(lds + PG8_SB(b, h) + boff + n * 2048 + k * 1024); } while (0)
#define PG8_MMA(ai, bj, At, Bt) do { __builtin_amdgcn_s_setprio(1); _Pragma("unroll") for (int m = 0; m < 4; ++m) _Pragma("unroll") for (int n = 0; n < 2; ++n) _Pragma("unroll") for (int k = 0; k < 2; ++k) \
        acc[ai][bj][m][n] = __builtin_amdgcn_mfma_f32_16x16x32_bf16(Bt[n][k], At[m][k], acc[ai][bj][m][n], 0, 0, 0); __builtin_amdgcn_s_setprio(0); } while (0)
#define PG8_WAIT_V(n) asm volatile("s_waitcnt vmcnt(" #n ")" ::: "memory")
#define PG8_WAIT_L(n) asm volatile("s_waitcnt lgkmcnt(" #n ")" ::: "memory")
#define PG8_BAR __builtin_amdgcn_s_barrier()
#define PG8_SCHED __builtin_amdgcn_sched_barrier(0)
    Unit cur, nxt; int ui = 0;
    if (!unit_next(g, 0, cur)) return;
    f32x4 acc[2][2][4][2];
#pragma unroll
    for (int a = 0; a < 2; ++a)
#pragma unroll
        for (int b = 0; b < 2; ++b)
#pragma unroll
            for (int m = 0; m < 4; ++m)
#pragma unroll
                for (int n = 0; n < 2; ++n) acc[a][b][m][n] = (f32x4){0.f, 0.f, 0.f, 0.f};
    bf16x8 At[4][2], B0[2][2], B1[2][2];
    const size_t ksliceB = (size_t)(g.ksplit > 1 ? g.K / g.ksplit : 0) * 2;
    const size_t ksliceA = g.a_tiled ? (size_t)(g.ksplit > 1 ? g.K / g.ksplit / BK : 0) * 32768 : ksliceB;
#define UNIT_A(u_) ((const char*)g.A + (size_t)(u_).pm * tstepA + (size_t)(u_).pn * g.a_pn_off * 2 + ((u_).ks > 0 ? (u_).ks * ksliceA : 0))
#define UNIT_B(u_) ((const char*)g.Bt + (size_t)(u_).pn * tstepB + ((u_).ks > 0 ? (u_).ks * ksliceB : 0))
    const char* cA = UNIT_A(cur); const char* cB = UNIT_B(cur);
    PG8_STAGE(PG8_SB(0, 0), cB, voffB); PG8_STAGE(PG8_SB(0, 1), cB + hstepB, voffB); PG8_STAGE(PG8_SA(0, 0), cA, voffA); PG8_STAGE(PG8_SA(0, 1), cA + hstepA, voffA);
    if (wr == 1) PG8_BAR;
    PG8_WAIT_V(2); PG8_BAR;
    PG8_STAGE(PG8_SB(1, 0), cB + kstepB, voffB); PG8_STAGE(PG8_SA(1, 0), cA + kstepA, voffA); PG8_STAGE(PG8_SB(1, 1), cB + hstepB + kstepB, voffB);
    PG8_WAIT_V(6); PG8_BAR;
    for (;;) {
        const bool has_next = unit_next(g, ui + 1, nxt);
        const char* nA = has_next ? UNIT_A(nxt) : cA; const char* nB = has_next ? UNIT_B(nxt) : cB;
        const int nt = cur.nt;
        for (int t = 0; t < nt; t += 2) {
            const bool last = (t == nt - 2);
            const char* a1 = cA + (size_t)(t + 1) * kstepA;
            const char* a2 = last ? nA : cA + (size_t)(t + 2) * kstepA; const char* b2 = last ? nB : cB + (size_t)(t + 2) * kstepB;
            const char* a3 = a2 + kstepA; const char* b3 = b2 + kstepB;
            PG8_LDB(B0, 0, 0); PG8_LDB(B1, 0, 1); PG8_SCHED; PG8_LDA(At, 0, 0); PG8_STAGE(PG8_SA(1, 1), a1 + hstepA, voffA);
            PG8_WAIT_V(8); PG8_WAIT_L(0); PG8_BAR; PG8_MMA(0, 0, At, B0); PG8_MMA(0, 1, At, B1); PG8_BAR; PG8_SCHED;
            PG8_LDA(At, 0, 1); PG8_STAGE(PG8_SB(0, 0), b2, voffB); PG8_STAGE(PG8_SB(0, 1), b2 + hstepB, voffB); PG8_STAGE(PG8_SA(0, 0), a2, voffA);
            PG8_WAIT_V(8); PG8_WAIT_L(0); PG8_BAR; PG8_MMA(1, 0, At, B0); PG8_MMA(1, 1, At, B1); PG8_BAR; PG8_SCHED;
            PG8_LDB(B0, 1, 0); PG8_LDB(B1, 1, 1); PG8_SCHED; PG8_LDA(At, 1, 0); PG8_STAGE(PG8_SA(0, 1), a2 + hstepA, voffA);
            PG8_WAIT_V(8); PG8_WAIT_L(0); PG8_BAR; PG8_MMA(0, 0, At, B0); PG8_MMA(0, 1, At, B1); PG8_BAR; PG8_SCHED;
            PG8_LDA(At, 1, 1); PG8_STAGE(PG8_SB(1, 0), b3, voffB); PG8_STAGE(PG8_SB(1, 1), b3 + hstepB, voffB); PG8_STAGE(PG8_SA(1, 0), a3, voffA);
            PG8_WAIT_V(8); PG8_WAIT_L(0); PG8_BAR; PG8_MMA(1, 0, At, B0); PG8_MMA(1, 1, At, B1); PG8_BAR; PG8_SCHED;
        }
        if (wr == 0) PG8_BAR;
        epi_store(acc, cur, wr, wc, fr, fq, e);
        if (!has_next) break;
#pragma unroll
        for (int a = 0; a < 2; ++a)
#pragma unroll
            for (int b = 0; b < 2; ++b)
#pragma unroll
                for (int m = 0; m < 4; ++m)
#pragma unroll
                    for (int n = 0; n < 2; ++n) acc[a][b][m][n] = (f32x4){0.f, 0.f, 0.f, 0.f};
        cur = nxt; cA = nA; cB = nB; ++ui;
        if (wr == 1) PG8_BAR;
    }
    PG8_WAIT_V(0);
    PG8_BAR;
#undef UNIT_A
#undef UNIT_B
#undef PG8_SA
#undef PG8_SB
#undef PG8_STAGE
#undef PG8_LDA
#undef PG8_LDB
#undef PG8_MMA
#undef PG8_WAIT_V
#undef PG8_WAIT_L
#undef PG8_BAR
#undef PG8_SCHED
}

#define SBAR() __builtin_amdgcn_sched_barrier(0)
__device__ __forceinline__ int crow(int r, int hi) { return (r & 3) + 8 * (r >> 2) + 4 * hi; }
__device__ __forceinline__ int v_st(int k, int c) { const int kk = (k & ~0xC) | ((k & 4) << 1) | ((k & 8) >> 1); return ((kk >> 3) * 4 + (c >> 5)) * 512 + ((kk & 7) * 32 + (c & 31)) * 2; }
__device__ __forceinline__ int v_rd_base(int lane) { return ((lane & 3) << 3) | (((lane >> 2) & 3) << 6) | (((lane >> 4) & 1) << 5) | (((lane >> 5) & 1) << 8); }
constexpr int v_rd_off(int d0, int ks, int half) { return d0 * 512 + ks * 4096 + half * 2048; }
template <int OFF> __device__ __forceinline__ s16x4 tr_read(int vb) { s16x4 r; asm volatile("ds_read_b64_tr_b16 %0, %1 offset:%2" : "=&v"(r) : "v"(vb), "i"(OFF) : "memory"); return r; }
template <int D0> __device__ __forceinline__ void pv_one(f32x16& od, int vb, bf16x8 pa0, bf16x8 pa1, bf16x8 pa2, bf16x8 pa3) {
    const s16x4 l0 = tr_read<v_rd_off(D0, 0, 0)>(vb), h0 = tr_read<v_rd_off(D0, 0, 1)>(vb), l1 = tr_read<v_rd_off(D0, 1, 0)>(vb), h1 = tr_read<v_rd_off(D0, 1, 1)>(vb);
    const s16x4 l2 = tr_read<v_rd_off(D0, 2, 0)>(vb), h2 = tr_read<v_rd_off(D0, 2, 1)>(vb), l3 = tr_read<v_rd_off(D0, 3, 0)>(vb), h3 = tr_read<v_rd_off(D0, 3, 1)>(vb);
    asm volatile("s_waitcnt lgkmcnt(0)" ::: "memory"); SBAR();
#define PK(L, H) (bf16x8){L[0], L[1], L[2], L[3], H[0], H[1], H[2], H[3]}
    od = __builtin_amdgcn_mfma_f32_32x32x16_bf16(pa0, PK(l0, h0), od, 0, 0, 0);
    od = __builtin_amdgcn_mfma_f32_32x32x16_bf16(pa1, PK(l1, h1), od, 0, 0, 0);
    od = __builtin_amdgcn_mfma_f32_32x32x16_bf16(pa2, PK(l2, h2), od, 0, 0, 0);
    od = __builtin_amdgcn_mfma_f32_32x32x16_bf16(pa3, PK(l3, h3), od, 0, 0, 0);
#undef PK
}
__device__ __forceinline__ void pv_d0(f32x16* o, int vb, bf16x8 pa0, bf16x8 pa1, bf16x8 pa2, bf16x8 pa3) {
    pv_one<0>(o[0], vb, pa0, pa1, pa2, pa3); pv_one<1>(o[1], vb, pa0, pa1, pa2, pa3); pv_one<2>(o[2], vb, pa0, pa1, pa2, pa3); pv_one<3>(o[3], vb, pa0, pa1, pa2, pa3);
}
__device__ __forceinline__ void partialSM(f32x16& p0, f32x16& p1, float& m_reg, float& mn, float& alpha, const float C, const float thr) {
    float pmax = p0[0];
#pragma unroll
    for (int r = 1; r < 16; ++r) pmax = fmaxf(pmax, p0[r]);
#pragma unroll
    for (int r = 0; r < 16; ++r) pmax = fmaxf(pmax, p1[r]);
    { auto rr = __builtin_amdgcn_permlane32_swap(__float_as_uint(pmax), __float_as_uint(pmax), false, false);
      pmax = fmaxf(__uint_as_float(rr[0]), __uint_as_float(rr[1])); }
    if (__builtin_expect(__all(pmax - m_reg <= thr), 1)) { mn = m_reg; alpha = 1.f; }
    else { mn = fmaxf(m_reg, pmax); alpha = __builtin_amdgcn_exp2f((m_reg - mn) * C); m_reg = mn; }
    const float mnC = -mn * C;
#pragma unroll
    for (int r = 0; r < 16; ++r) p0[r] = fmaf(p0[r], C, mnC);
#pragma unroll
    for (int r = 0; r < 16; ++r) p1[r] = fmaf(p1[r], C, mnC);
#pragma unroll
    for (int r = 0; r < 16; ++r) p0[r] = __builtin_amdgcn_exp2f(p0[r]);
}
__device__ __forceinline__ void finishSM(f32x16& p0, f32x16& p1, float alpha, float& l_reg, bf16x8& pa0, bf16x8& pa1, bf16x8& pa2, bf16x8& pa3) {
#pragma unroll
    for (int r = 0; r < 16; ++r) p1[r] = __builtin_amdgcn_exp2f(p1[r]);
    float ps = 0;
#pragma unroll
    for (int r = 0; r < 16; ++r) ps += p0[r];
#pragma unroll
    for (int r = 0; r < 16; ++r) ps += p1[r];
    { auto rr = __builtin_amdgcn_permlane32_swap(__float_as_uint(ps), __float_as_uint(ps), false, false);
      ps = __uint_as_float(rr[0]) + __uint_as_float(rr[1]); }
    l_reg = l_reg * alpha + ps;
#define PK4(P, BASE, OUT) do { unsigned a0 = cvt_pk_bf16(P[BASE + 0], P[BASE + 1]), a1 = cvt_pk_bf16(P[BASE + 2], P[BASE + 3]);   \
    unsigned b0 = cvt_pk_bf16(P[BASE + 4], P[BASE + 5]), b1 = cvt_pk_bf16(P[BASE + 6], P[BASE + 7]);                              \
    auto r0 = __builtin_amdgcn_permlane32_swap(a0, b0, false, false); auto r1 = __builtin_amdgcn_permlane32_swap(a1, b1, false, false); \
    u32x4 w = {r0[0], r1[0], r0[1], r1[1]}; OUT = *reinterpret_cast<bf16x8*>(&w); } while (0)
    PK4(p0, 0, pa0); PK4(p0, 8, pa1); PK4(p1, 0, pa2); PK4(p1, 8, pa3);
#undef PK4
}

struct AttnArgs {
    const bf16_t* Q; int ldq;
    const bf16_t* Kn; int ldk;
    const bf16_t* Kr; int ldkr;
    const bf16_t* V; int ldv;
    int lat0, ctx0, nlat, NT;
    float C, thr;
};

template <int DQK, int DK1, int LDQ, int LDK, int LDKR, int LDV, int NQL, int SDEPTH>
__device__ __forceinline__ void attn_core(const AttnArgs& a, char* lds, f32x16 (&o)[4]) {
    constexpr int KP = DQK * 2, SHM_K = 64 * KP, SHM_V = 64 * 128 * 2, KCH = DQK / 64, CPR = DQK / 8, ND0 = DQK / 16;
    const int tid = tid_opaque(), wid = tid >> 6, lane = tid & 63, r32 = lane & 31, hi = lane >> 5;
    char* V_lds = lds; char* K_lds = lds + 2 * SHM_V;
    float* wsf = (float*)(lds + 2 * SHM_V + 2 * SHM_K) + wid * 64; float* li_l = wsf; float* al_l = wsf + 32;
    float m_reg = -1e30f, l_reg = 0.f;
#pragma unroll
    for (int d = 0; d < 4; ++d)
#pragma unroll
        for (int r = 0; r < 16; ++r) o[d][r] = 0.f;
    constexpr int NQR = ND0 - NQL;
    bf16x8 qr[NQR];
    char* QL = lds + 2 * SHM_V + 2 * SHM_K + 2048 + tid * 16;
    { const bf16_t* Qw = a.Q + (long)(wid * 32 + r32) * LDQ + hi * 8;
#pragma unroll
      for (int d0 = 0; d0 < NQR; ++d0) qr[d0] = *(const bf16x8*)(Qw + d0 * 16);
#pragma unroll
      for (int d0 = NQR; d0 < ND0; ++d0) *(bf16x8*)(QL + (d0 - NQR) * 8192) = *(const bf16x8*)(Qw + d0 * 16); }
    const int sr = tid >> 4, sc = (tid & 15) * 8, vst0 = v_st(sr, sc), vst1 = v_st(32 + sr, sc);
    const int vb0 = (int)(uintptr_t)V_lds + v_rd_base(lane);
    const bf16_t* kptr[KCH]; int kld[KCH], kwo[KCH];
#pragma unroll
    for (int c = 0; c < KCH; ++c) { const int idx = tid + c * 512, kr_ = idx / CPR, kc = (idx % CPR) * 8;
        if (kc < DK1) { kptr[c] = a.Kn + (long)kr_ * LDK + kc; kld[c] = LDK; } else { kptr[c] = a.Kr + (long)kr_ * LDKR + (kc - DK1); kld[c] = LDKR; }
        kwo[c] = kr_ * KP + ((kc * 2) ^ ((kr_ & 7) << 4)); }
    struct { bf16x8 vs0, vs1, ks[KCH]; } sr_[SDEPTH];
    int kb[4];
#pragma unroll
    for (int m = 0; m < 4; ++m) kb[m] = r32 * KP + ((m * 32 + hi * 16) ^ ((r32 & 7) << 4));
#define KROW(j) ((j) < a.nlat ? a.lat0 + 64 * (j) : a.ctx0 + 64 * ((j) - a.nlat))
#define SLOAD(i, j) do { const long rb_ = KROW(j); sr_[i].vs0 = *(const bf16x8*)(a.V + (rb_ + sr) * LDV + sc); sr_[i].vs1 = *(const bf16x8*)(a.V + (rb_ + 32 + sr) * LDV + sc); \
    _Pragma("unroll") for (int c_ = 0; c_ < KCH; ++c_) sr_[i].ks[c_] = *(const bf16x8*)(kptr[c_] + rb_ * kld[c_]); } while (0)
#define SWRITE(b, i) do { *(bf16x8*)(V_lds + (b) * SHM_V + vst0) = sr_[i].vs0; *(bf16x8*)(V_lds + (b) * SHM_V + vst1) = sr_[i].vs1; \
    _Pragma("unroll") for (int c_ = 0; c_ < KCH; ++c_) *(bf16x8*)(K_lds + (b) * SHM_K + kwo[c_]) = sr_[i].ks[c_]; } while (0)
#define RESC(al) do { if (__any((al) < 1.f)) { if (hi == 0) al_l[r32] = (al); asm volatile("s_waitcnt lgkmcnt(0)" ::: "memory"); \
    _Pragma("unroll") for (int d = 0; d < 4; ++d) _Pragma("unroll") for (int r = 0; r < 16; ++r) o[d][r] *= al_l[crow(r, hi)]; } } while (0)
#define QKT(P0, P1, KB) do { P0 = f32x16{}; P1 = f32x16{}; \
    _Pragma("unroll") for (int d0 = 0; d0 < ND0; ++d0) { \
      const bf16x8 b0 = *(const bf16x8*)((KB) + kb[d0 & 3] + (d0 >> 2) * 128); \
      const bf16x8 b1 = *(const bf16x8*)((KB) + kb[d0 & 3] + (d0 >> 2) * 128 + 32 * KP); \
      const bf16x8 qf = (d0 < NQR) ? qr[d0 < NQR ? d0 : 0] : *(const bf16x8*)(QL + (d0 - NQR) * 8192); \
      P0 = __builtin_amdgcn_mfma_f32_32x32x16_bf16(b0, qf, P0, 0, 0, 0); \
      P1 = __builtin_amdgcn_mfma_f32_32x32x16_bf16(b1, qf, P1, 0, 0, 0); } } while (0)
    f32x16 pA0, pA1, pB0, pB1; float mnA, mnB, alA, alB; bf16x8 pa0, pa1, pa2, pa3; const int NT = a.NT;
    constexpr int SE = 0, SO = SDEPTH - 1;
    SLOAD(SE, 0); asm volatile("s_waitcnt vmcnt(0)" ::: "memory"); SWRITE(0, SE); __syncthreads();
    QKT(pA0, pA1, K_lds); partialSM(pA0, pA1, m_reg, mnA, alA, a.C, a.thr);
    SLOAD(SO, 1); if (SDEPTH == 2 && 2 < NT) SLOAD(SE, 2);
    SWRITE(1, SO); __syncthreads();
    for (int j = 1; j + 1 < NT; j += 2) {
        SBAR(); QKT(pB0, pB1, K_lds + SHM_K);
        finishSM(pA0, pA1, alA, l_reg, pa0, pa1, pa2, pa3); SBAR();
        SLOAD(SO, j + SDEPTH); SBAR();
        pv_d0(o, vb0, pa0, pa1, pa2, pa3); partialSM(pB0, pB1, m_reg, mnB, alB, a.C, a.thr);
        __syncthreads(); SWRITE(0, SE);
        RESC(alB); __syncthreads();
        SBAR(); QKT(pA0, pA1, K_lds);
        finishSM(pB0, pB1, alB, l_reg, pa0, pa1, pa2, pa3); SBAR();
        if (SDEPTH == 1 || j + 3 < NT) SLOAD(SE, j + 1 + SDEPTH); SBAR();
        pv_d0(o, vb0 + SHM_V, pa0, pa1, pa2, pa3); partialSM(pA0, pA1, m_reg, mnA, alA, a.C, a.thr);
        __syncthreads(); SWRITE(1, SO);
        RESC(alA); __syncthreads();
    }
    SBAR(); QKT(pB0, pB1, K_lds + SHM_K);
    finishSM(pA0, pA1, alA, l_reg, pa0, pa1, pa2, pa3); SBAR();
    pv_d0(o, vb0, pa0, pa1, pa2, pa3); partialSM(pB0, pB1, m_reg, mnB, alB, a.C, a.thr);
    __syncthreads(); RESC(alB);
    finishSM(pB0, pB1, alB, l_reg, pa0, pa1, pa2, pa3); SBAR();
    pv_d0(o, vb0 + SHM_V, pa0, pa1, pa2, pa3);
    if (hi == 0) li_l[r32] = l_reg; asm volatile("s_waitcnt lgkmcnt(0)" ::: "memory");
#pragma unroll
    for (int r = 0; r < 16; ++r) { const float rl = __builtin_amdgcn_rcpf(li_l[crow(r, hi)]);
#pragma unroll
        for (int d = 0; d < 4; ++d) o[d][r] *= rl; }
    __syncthreads();
#undef KROW
#undef SLOAD
#undef SWRITE
#undef RESC
#undef QKT
}

__device__ __forceinline__ void phase_attn_mla(const Params& p, char* lds) {
    const bf16_t* T1 = (const bf16_t*)(p.ws + WS_T1); bf16_t* O = (bf16_t*)(p.ws + WS_H);
    const int tid = tid_opaque(), wid = tid >> 6, lane = tid & 63, r32 = lane & 31, hi = lane >> 5;
    const float scale = 0.07216878364870322f;
    for (int it = blockIdx.x; it < 1024 + 128; it += gridDim.x) {
        int b, h, row0; AttnArgs a;
        if (it < 1024) {
            int itm = it;
            if (gridDim.x == 256) { const int w = it & 255, rnd = it >> 8, xcd = w & 7, slot = w >> 3; itm = ((rnd * 32 + xcd * 4 + (slot >> 3)) << 3) | (slot & 7); }
            b = itm >> 6; h = (itm >> 3) & 7; const int qb = itm & 7; row0 = b * SEQ + qb * 256; a.nlat = 32; a.NT = 36; }
        else { const int i2 = it - 1024; b = i2 >> 3; h = i2 & 7; row0 = MLAT + b * CTXL; a.nlat = 0; a.NT = 4; }
        a.lat0 = b * SEQ; a.ctx0 = MLAT + b * CTXL;
        a.Q = T1 + T_Q + (size_t)row0 * 1536 + h * 192; a.ldq = 1536;
        a.Kn = T1 + T_KV + h * 256; a.ldk = 2048; a.Kr = T1 + T_KR; a.ldkr = 64;
        a.V = T1 + T_KV + h * 256 + 128; a.ldv = 2048;
        a.C = scale * 1.4426950408889634f; a.thr = 8.f / scale;
        f32x16 o[4];
        attn_core<192, 128, 1536, 2048, 64, 2048, MLA_NQL, 1>(a, lds, o);
        bf16_t* Ow = O + (size_t)(row0 + wid * 32 + 4 * hi) * 1024 + h * 128 + r32;
        asm volatile("" : "+v"(Ow));
#pragma unroll
        for (int r = 0; r < 16; ++r) { bf16_t* Or = Ow + (size_t)((r & 3) + 8 * (r >> 2)) * 1024;
#pragma unroll
            for (int d0 = 0; d0 < 4; ++d0) Or[d0 * 32] = (bf16_t)(cvt_pk_bf16(o[d0][r], 0.f) & 0xffffu); }
    }
}

__device__ __forceinline__ void phase_attn_diff(const Params& p, char* lds) {
    const bf16_t* T1 = (const bf16_t*)(p.ws + WS_T1); bf16_t* O = (bf16_t*)(p.ws + WS_H);
    const int tid = tid_opaque(), wid = tid >> 6, lane = tid & 63, r32 = lane & 31, hi = lane >> 5;
    float* scr0 = (float*)(p.ws + WS_SCR) + ((size_t)blockIdx.x * 512 + tid) * 64;
    const float scale = 0.125f;
    const float lam_init = 0.8f - 0.6f * 0.40656965974059917f;
    float lam;
    { const float* lv = p.diff_lambda; float s1 = 0.f, s2 = 0.f;
      for (int k = 0; k < 64; ++k) { s1 += lv[k] * lv[64 + k]; s2 += lv[128 + k] * lv[192 + k]; }
      lam = expf(s1) - expf(s2) + lam_init; }
    float gs[4];
#pragma unroll
    for (int d0 = 0; d0 < 4; ++d0) gs[d0] = p.diff_g_subln[d0 * 32 + r32] * (1.0f - lam_init);
    for (int it = blockIdx.x; it < 1024; it += gridDim.x) {
        int itm = it;
        if (gridDim.x == 256) { const int w = it & 255, rnd = it >> 8, xcd = w & 7, slot = w >> 3; itm = ((rnd * 32 + xcd * 4 + (slot >> 3)) << 3) | (slot & 7); }
        const int b = itm >> 6, h = (itm >> 3) & 7, qb = itm & 7, row0 = b * SEQ + qb * 256;
#pragma unroll 1
        for (int j = 0; j < 2; ++j) {
            AttnArgs a; a.nlat = 32; a.NT = 36; a.lat0 = b * SEQ; a.ctx0 = MLAT + b * CTXL;
            a.Q = T1 + (size_t)row0 * 3072 + h * 128 + j * 64; a.ldq = 3072;
            a.Kn = T1 + 1024 + h * 128 + j * 64; a.ldk = 3072; a.Kr = a.Kn; a.ldkr = 3072;
            a.V = T1 + 2048 + h * 128; a.ldv = 3072;
            a.C = scale * 1.4426950408889634f; a.thr = 8.f / scale;
            f32x16 o[4];
            attn_core<64, 64, 3072, 3072, 3072, 3072, 0, 2>(a, lds, o);
            float* scr = scr0; asm volatile("" : "+v"(scr));
            if (j == 0) {
#pragma unroll
                for (int r = 0; r < 16; ++r) { f32x4 t = {o[0][r], o[1][r], o[2][r], o[3][r]}; *(f32x4*)(scr + 4 * r) = t; }
            } else {
                bf16_t* Ow = O + (size_t)(row0 + wid * 32 + 4 * hi) * 1024 + h * 128 + r32;
                asm volatile("" : "+v"(Ow));
#pragma unroll
                for (int r = 0; r < 16; ++r) {
                    const f32x4 t = *(const f32x4*)(scr + 4 * r);
                    const float v0 = t[0] - lam * o[0][r], v1 = t[1] - lam * o[1][r], v2 = t[2] - lam * o[2][r], v3 = t[3] - lam * o[3][r];
                    float ss = v0 * v0 + v1 * v1 + v2 * v2 + v3 * v3;
#pragma unroll
                    for (int x = 16; x >= 1; x >>= 1) ss += __shfl_xor(ss, x);
                    const float rs = rsqrtf(ss * (1.0f / 128.0f) + EPS);
                    bf16_t* Or = Ow + (size_t)((r & 3) + 8 * (r >> 2)) * 1024;
                    Or[0] = (bf16_t)(cvt_pk_bf16(v0 * rs * gs[0], 0.f) & 0xffffu); Or[32] = (bf16_t)(cvt_pk_bf16(v1 * rs * gs[1], 0.f) & 0xffffu);
                    Or[64] = (bf16_t)(cvt_pk_bf16(v2 * rs * gs[2], 0.f) & 0xffffu); Or[96] = (bf16_t)(cvt_pk_bf16(v3 * rs * gs[3], 0.f) & 0xffffu);
                }
            }
        }
    }
}

__device__ __forceinline__ const float* xin_row(const Params& p, int row, bool from_input) {
    if (from_input) return row < MLAT ? p.x + (size_t)row * DM : p.ctx + (size_t)(row - MLAT) * DM;
    return row < MLAT ? p.out + (size_t)row * DM : (const float*)(p.ws + WS_XC) + (size_t)(row - MLAT) * DM;
}
__device__ __forceinline__ float* xout_row(const Params& p, int row) {
    return row < MLAT ? p.out + (size_t)row * DM : (float*)(p.ws + WS_XC) + (size_t)(row - MLAT) * DM;
}

__device__ __forceinline__ void phase_rn(const Params& p, int layer, int stage, const bf16_t* Y, int nrows, int npart) {
    const int tid = tid_opaque(), wid = tid >> 6, lane = tid & 63;
    const float* MOD = (const float*)(p.ws + WS_MOD); bf16_t* H = (bf16_t*)(p.ws + WS_H);
    const int gate_c = stage == 0 ? 2 : 5;
    const float* gA = p.norm_g + (layer * 4 + (stage == 0 ? 1 : 3)) * DM;
    const bool has_next = !(layer == 3 && stage == 1);
    const int nl = stage == 0 ? layer : layer + 1;
    const float* gB = p.norm_g + ((has_next ? nl : 0) * 4 + (stage == 0 ? 2 : 0)) * DM;
    const int sh_c = stage == 0 ? 3 : 0, sc_c = stage == 0 ? 4 : 1;
    const bool from_input = (layer == 0 && stage == 0);
    for (int row = (blockIdx.x * 8 + wid) * 2; row < nrows; row += gridDim.x * 16) {
        const int mr = modrow(row);
        const float* xi = xin_row(p, row, from_input); float* xo = xout_row(p, row);
        const bf16_t* y = Y + (size_t)row * DM;
        const float* mg = MOD + ((size_t)layer * 17 + mr) * 6144 + gate_c * DM;
        u32x2 yw[2][4]; f32x4 xx[2][4], gg[4], gt[4];
#pragma unroll
        for (int q = 0; q < 2; ++q)
#pragma unroll
            for (int i = 0; i < 4; ++i) { yw[q][i] = *(const u32x2*)(y + q * DM + i * 256 + lane * 4); xx[q][i] = __builtin_nontemporal_load((const f32x4*)(xi + q * DM + i * 256 + lane * 4)); }
#pragma unroll
        for (int i = 0; i < 4; ++i) { gg[i] = *(const f32x4*)(gA + i * 256 + lane * 4); gt[i] = *(const f32x4*)(mg + i * 256 + lane * 4); }
        float yv[2][16]; float ss[2] = {0.f, 0.f};
#pragma unroll
        for (int q = 0; q < 2; ++q)
#pragma unroll
            for (int i = 0; i < 4; ++i) { yv[q][4 * i] = bf_lo(yw[q][i].x); yv[q][4 * i + 1] = bf_hi(yw[q][i].x); yv[q][4 * i + 2] = bf_lo(yw[q][i].y); yv[q][4 * i + 3] = bf_hi(yw[q][i].y); }
        if (npart > 1 && row >= MLAT) {
            const bf16_t* yp = (const bf16_t*)(p.ws + WS_SCR) + (size_t)(row - MLAT) * DM;
#pragma unroll
            for (int q = 0; q < 2; ++q)
#pragma unroll
                for (int i = 0; i < 4; ++i) { float a4[4] = {0.f, 0.f, 0.f, 0.f};
                    for (int k = 0; k < npart; ++k) { float t4[4]; load_bf4(yp + (size_t)k * MCTX * DM + q * DM + i * 256 + lane * 4, t4); a4[0] += t4[0]; a4[1] += t4[1]; a4[2] += t4[2]; a4[3] += t4[3]; }
                    yv[q][4 * i] = a4[0]; yv[q][4 * i + 1] = a4[1]; yv[q][4 * i + 2] = a4[2]; yv[q][4 * i + 3] = a4[3]; }
        }
#pragma unroll
        for (int q = 0; q < 2; ++q)
#pragma unroll
            for (int i = 0; i < 16; ++i) ss[q] += yv[q][i] * yv[q][i];
#pragma unroll
        for (int o = 32; o >= 1; o >>= 1) { ss[0] += __shfl_xor(ss[0], o); ss[1] += __shfl_xor(ss[1], o); }
        float ss2[2] = {0.f, 0.f};
#pragma unroll
        for (int q = 0; q < 2; ++q) { const float r1 = rsqrtf(ss[q] * (1.0f / DM) + EPS);
#pragma unroll
            for (int i = 0; i < 4; ++i) { f32x4 xn;
#pragma unroll
                for (int j = 0; j < 4; ++j) { xn[j] = xx[q][i][j] + gt[i][j] * (yv[q][4 * i + j] * r1 * gg[i][j]); ss2[q] += xn[j] * xn[j]; }
                xx[q][i] = xn; __builtin_nontemporal_store(xn, (f32x4*)(xo + q * DM + i * 256 + lane * 4)); } }
        if (has_next) {
            const float* msh = MOD + ((size_t)nl * 17 + mr) * 6144 + sh_c * DM; const float* msc = MOD + ((size_t)nl * 17 + mr) * 6144 + sc_c * DM;
            f32x4 gb[4], sh[4], sc[4];
#pragma unroll
            for (int i = 0; i < 4; ++i) { gb[i] = *(const f32x4*)(gB + i * 256 + lane * 4); sh[i] = *(const f32x4*)(msh + i * 256 + lane * 4); sc[i] = *(const f32x4*)(msc + i * 256 + lane * 4); }
#pragma unroll
            for (int o = 32; o >= 1; o >>= 1) { ss2[0] += __shfl_xor(ss2[0], o); ss2[1] += __shfl_xor(ss2[1], o); }
#pragma unroll
            for (int q = 0; q < 2; ++q) { const float r2 = rsqrtf(ss2[q] * (1.0f / DM) + EPS);
#pragma unroll
                for (int i = 0; i < 4; ++i) { float hv[4];
#pragma unroll
                    for (int j = 0; j < 4; ++j) hv[j] = (xx[q][i][j] * r2 * gb[i][j]) * (1.0f + sc[i][j]) + sh[i][j];
                    store_bf4(H + (size_t)(row + q) * DM + i * 256 + lane * 4, hv[0], hv[1], hv[2], hv[3]); } }
        }
    }
}

template <int I> __device__ __forceinline__ void poold_group(const float* xb, const float* RSs, int t0, int len, int lane, const float* g0, const float* msc, bf16_t* Hrow0) {
    constexpr int W = 2 << I, LO = W / 2, HI = W - 1 - LO, NR = 8 + W - 1;
    const int col = I * 256 + lane * 4;
    f32x4 xs[NR];
#pragma unroll
    for (int k = 0; k < NR; ++k) { const int tt = t0 - LO + k; const bool ok = (tt >= 0 && tt < len); const int tc = ok ? tt : t0;
        const f32x4 xx = *(const f32x4*)(xb + (size_t)tc * DM + col); const float rs = ok ? RSs[tc] : 0.f; xs[k] = xx * rs; }
    const f32x4 gg = *(const f32x4*)(g0 + col), sc = *(const f32x4*)(msc + col);
    f32x4 gm;
#pragma unroll
    for (int j = 0; j < 4; ++j) gm[j] = gg[j] * (1.0f + sc[j]);
    f32x4 S = xs[0];
#pragma unroll
    for (int k = 1; k < W; ++k) S += xs[k];
#pragma unroll
    for (int r = 0; r < 8; ++r) {
        const int t = t0 + r; const int ta = max(t - LO, 0), tb = min(t + HI + 1, len); const float inv = 1.0f / (float)(tb - ta);
        const f32x4 d = (S * inv - xs[r + LO]) * gm;
        store_bf4(Hrow0 + (size_t)r * DM + col, d[0], d[1], d[2], d[3]);
        if (r < 7) S += xs[r + W] - xs[r];
    }
}
__device__ __forceinline__ void phase_poold(const Params& p) {
    const int tid = tid_opaque(), wid = tid >> 6, lane = tid & 63;
    const float* MOD = (const float*)(p.ws + WS_MOD); const float* RS = (const float*)(p.ws + WS_RS); bf16_t* H = (bf16_t*)(p.ws + WS_H);
    const float* g0 = p.norm_g;
    for (int task = blockIdx.x * 8 + wid; task < (MALL / 8) * 4; task += gridDim.x * 8) {
        const int row = (task >> 2) * 8, grp = task & 3;
        const int mr = modrow(row);
        const int s0 = row < MLAT ? (row & ~(SEQ - 1)) : MLAT + ((row - MLAT) & ~(CTXL - 1)); const int len = row < MLAT ? SEQ : CTXL; const int t0 = row - s0;
        const float* xb = row < MLAT ? p.x + (size_t)s0 * DM : p.ctx + (size_t)(s0 - MLAT) * DM;
        const float* msc = MOD + ((size_t)0 * 17 + mr) * 6144 + 1 * DM;
        bf16_t* Hr = H + (size_t)row * DM;
        if (grp == 0) poold_group<0>(xb, RS + s0, t0, len, lane, g0, msc, Hr);
        else if (grp == 1) poold_group<1>(xb, RS + s0, t0, len, lane, g0, msc, Hr);
        else if (grp == 2) poold_group<2>(xb, RS + s0, t0, len, lane, g0, msc, Hr);
        else poold_group<3>(xb, RS + s0, t0, len, lane, g0, msc, Hr);
    }
}

__device__ __forceinline__ void phase_conv(const Params& p) {
    const int tid = tid_opaque(), wid = tid >> 6, lane = tid & 63;
    const bf16_t* T1 = (const bf16_t*)(p.ws + WS_T1); bf16_t* H = (bf16_t*)(p.ws + WS_H);
    for (int task = blockIdx.x * 8 + wid; task < (MALL / 8) * 4; task += gridDim.x * 8) {
        const int row = (task >> 2) * 8;
        const int s0 = row < MLAT ? (row & ~(SEQ - 1)) : MLAT + ((row - MLAT) & ~(CTXL - 1)); const int len = row < MLAT ? SEQ : CTXL; const int t0 = row - s0;
        { const int i = task & 3;
            const int col = i * 256 + lane * 4;
            u32x2 cw[10], vw[10], bw[8];
#pragma unroll
            for (int k = 0; k < 10; ++k) { const int tt = t0 - 1 + k; const bool ok = (tt >= 0 && tt < len); const int tc = ok ? tt : t0;
                const bf16_t* rp = T1 + (size_t)(s0 + tc) * 3072; cw[k] = *(const u32x2*)(rp + 1024 + col); vw[k] = *(const u32x2*)(rp + 2048 + col);
                if (!ok) { cw[k].x = 0u; cw[k].y = 0u; } }
#pragma unroll
            for (int r = 0; r < 8; ++r) bw[r] = *(const u32x2*)(T1 + (size_t)(row + r) * 3072 + col);
            const f32x4 w0 = *(const f32x4*)(p.conv_w + col), w1 = *(const f32x4*)(p.conv_w + DM + col), w2 = *(const f32x4*)(p.conv_w + 2 * DM + col);
            f32x4 u[10];
#pragma unroll
            for (int k = 0; k < 10; ++k) { u[k][0] = bf_lo(cw[k].x) * bf_lo(vw[k].x); u[k][1] = bf_hi(cw[k].x) * bf_hi(vw[k].x); u[k][2] = bf_lo(cw[k].y) * bf_lo(vw[k].y); u[k][3] = bf_hi(cw[k].y) * bf_hi(vw[k].y); }
#pragma unroll
            for (int r = 0; r < 8; ++r) { const f32x4 z = u[r] * w0 + u[r + 1] * w1 + u[r + 2] * w2;
                store_bf4(H + (size_t)(row + r) * DM + col, bf_lo(bw[r].x) * z[0], bf_hi(bw[r].x) * z[1], bf_lo(bw[r].y) * z[2], bf_hi(bw[r].y) * z[3]); }
        }
    }
}

__device__ __forceinline__ void phase_mlaprep(const Params& p) {
    const int tid = tid_opaque(), wid = tid >> 6, lane = tid & 63;
    bf16_t* T1 = (bf16_t*)(p.ws + WS_T1); bf16_t* CKV = (bf16_t*)(p.ws + WS_H); const float* rope = (const float*)(p.ws + WS_ROPE);
    for (int row4 = (blockIdx.x * 8 + wid) * 4; row4 < MALL; row4 += gridDim.x * 32) {
      u32x2 araw[4][3];
#pragma unroll
      for (int q = 0; q < 4; ++q)
#pragma unroll
        for (int i = 0; i < 3; ++i) araw[q][i] = *(const u32x2*)(T1 + T_AB + (size_t)(row4 + q) * 768 + i * 256 + lane * 4);
#pragma unroll
      for (int q = 0; q < 4; ++q) {
        const int row = row4 + q;
        float v[12]; float sq = 0.f, skv = 0.f;
#pragma unroll
        for (int i = 0; i < 3; ++i) { const int col = i * 256 + lane * 4; v[4 * i] = bf_lo(araw[q][i].x); v[4 * i + 1] = bf_hi(araw[q][i].x); v[4 * i + 2] = bf_lo(araw[q][i].y); v[4 * i + 3] = bf_hi(araw[q][i].y);
            const float s = v[4 * i] * v[4 * i] + v[4 * i + 1] * v[4 * i + 1] + v[4 * i + 2] * v[4 * i + 2] + v[4 * i + 3] * v[4 * i + 3];
            if (col < 384) sq += s; else if (col < 640) skv += s; }
        sq = wave_sum(sq); skv = wave_sum(skv);
        const float rq = rsqrtf(sq * (1.0f / 384.0f) + EPS), rkv = rsqrtf(skv * (1.0f / 256.0f) + EPS);
#pragma unroll
        for (int i = 0; i < 3; ++i) { const int col = i * 256 + lane * 4;
            if (col < 384) { const f32x4 g = *(const f32x4*)(p.mla_g_q + col);
                store_bf4(T1 + T_CQ + (size_t)row * 384 + col, v[4 * i] * rq * g[0], v[4 * i + 1] * rq * g[1], v[4 * i + 2] * rq * g[2], v[4 * i + 3] * rq * g[3]); }
            else if (col < 640) { const int c2 = col - 384; const f32x4 g = *(const f32x4*)(p.mla_g_kv + c2);
                store_bf4(CKV + (size_t)row * 256 + c2, v[4 * i] * rkv * g[0], v[4 * i + 1] * rkv * g[1], v[4 * i + 2] * rkv * g[2], v[4 * i + 3] * rkv * g[3]); }
        }
        {
            float pv[4];
#pragma unroll
            for (int j = 0; j < 4; ++j) pv[j] = __shfl_xor(v[8 + j], 4);
            if (lane >= 32 && lane < 48) {
                const int k = lane - 32; float ov[4];
                if (row < MLAT) {
                    const int t = row & (SEQ - 1); const int pos = (k < 8) ? (t >> 6) : (t & 63);
                    const f32x4 t0 = *(const f32x4*)(rope + (pos * 16 + 4 * (k & 3)) * 2), t1 = *(const f32x4*)(rope + (pos * 16 + 4 * (k & 3)) * 2 + 4);
                    const float cs[4] = {t0[0], t0[2], t1[0], t1[2]}, sn[4] = {t0[1], t0[3], t1[1], t1[3]};
#pragma unroll
                    for (int j = 0; j < 4; ++j) ov[j] = (k & 4) ? (v[8 + j] * cs[j] + pv[j] * sn[j]) : (v[8 + j] * cs[j] - pv[j] * sn[j]);
                } else {
#pragma unroll
                    for (int j = 0; j < 4; ++j) ov[j] = v[8 + j];
                }
                store_bf4(T1 + T_KR + (size_t)row * 64 + 4 * k, ov[0], ov[1], ov[2], ov[3]);
            }
        }
      }
    }
}

__device__ __forceinline__ void conv_wt(const float* src, int K, int N, int Npad, bf16_t* dst, float* tile, int rot) {
    const int tid = tid_opaque(), G = gridDim.x;
    const int ntn = Npad / 64, ntk = K / 64, ntiles = ntn * ntk;
    const int r = tid >> 4, c4 = (tid & 15) * 4;
    int u = (blockIdx.x + G - (rot % G)) % G;
    f32x4 v0 = {0.f, 0.f, 0.f, 0.f}, v1 = {0.f, 0.f, 0.f, 0.f};
    if (u < ntiles) { const int k0 = (u / ntn) * 64, n0 = (u % ntn) * 64;
        if (n0 + c4 < N) { v0 = *(const f32x4*)(src + (size_t)(k0 + r) * N + n0 + c4); v1 = *(const f32x4*)(src + (size_t)(k0 + r + 32) * N + n0 + c4); } }
    for (; u < ntiles; u += G) {
        const int k0 = (u / ntn) * 64, n0 = (u % ntn) * 64;
        const int un = u + G; f32x4 w0 = {0.f, 0.f, 0.f, 0.f}, w1 = {0.f, 0.f, 0.f, 0.f};
        if (un < ntiles) { const int k1 = (un / ntn) * 64, n1 = (un % ntn) * 64;
            if (n1 + c4 < N) { w0 = *(const f32x4*)(src + (size_t)(k1 + r) * N + n1 + c4); w1 = *(const f32x4*)(src + (size_t)(k1 + r + 32) * N + n1 + c4); } }
        tile[r * 65 + c4 + 0] = v0[0]; tile[r * 65 + c4 + 1] = v0[1]; tile[r * 65 + c4 + 2] = v0[2]; tile[r * 65 + c4 + 3] = v0[3];
        tile[(r + 32) * 65 + c4 + 0] = v1[0]; tile[(r + 32) * 65 + c4 + 1] = v1[1]; tile[(r + 32) * 65 + c4 + 2] = v1[2]; tile[(r + 32) * 65 + c4 + 3] = v1[3];
        __syncthreads();
        { const int n = tid >> 3, k8 = (tid & 7) * 8; float t[8];
#pragma unroll
          for (int j = 0; j < 8; ++j) t[j] = tile[(k8 + j) * 65 + n];
          u32x4 w; w.x = cvt_pk_bf16(t[0], t[1]); w.y = cvt_pk_bf16(t[2], t[3]); w.z = cvt_pk_bf16(t[4], t[5]); w.w = cvt_pk_bf16(t[6], t[7]);
          *(u32x4*)(dst + (size_t)(n0 + n) * K + k0 + k8) = w; }
        __syncthreads();
        v0 = w0; v1 = w1;
    }
}

__device__ __forceinline__ void phase_prep(const Params& p, char* lds) {
    const int tid = tid_opaque(), wid = tid >> 6, lane = tid & 63, G = gridDim.x;
    float* fl = (float*)lds;
    if (blockIdx.x < 192) {
        { f32x4 cvv[9];
#pragma unroll
          for (int q = 0; q < 9; ++q) { const int idx = tid + q * NTHREADS; const int r = idx >> 8, k4 = (idx & 255) * 4; cvv[q] = (idx < 17 * 256) ? *(const f32x4*)(r < 16 ? p.c + r * 1024 + k4 : p.c_ctx + k4) : (f32x4){0.f, 0.f, 0.f, 0.f}; }
#pragma unroll
          for (int q = 0; q < 9; ++q) { const int idx = tid + q * NTHREADS; const int r = idx >> 8, k4 = (idx & 255) * 4;
              if (idx < 17 * 256) {
#pragma unroll
                  for (int j = 0; j < 4; ++j) fl[(k4 + j) * 17 + r] = cvv[q][j] / (1.0f + expf(-cvv[q][j])); } } }
        __syncthreads();
        float* MOD = (float*)(p.ws + WS_MOD);
        for (int u = blockIdx.x; u < 192; u += G) {
            const int layer = u / 48, cb = u % 48, col0 = cb * 128 + wid * 16 + (lane & 3) * 4, kq = lane >> 2;
            float acc[17][4];
#pragma unroll
            for (int r = 0; r < 17; ++r)
#pragma unroll
                for (int j = 0; j < 4; ++j) acc[r][j] = 0.f;
            const float* W = p.ada_w + (size_t)layer * 1024 * 6144 + col0;
#pragma unroll 8
            for (int itk = 0; itk < 64; ++itk) { const int k = kq + 16 * itk; const f32x4 w = *(const f32x4*)(W + (size_t)k * 6144);
#pragma unroll
                for (int r = 0; r < 17; ++r) { const float s_ = fl[k * 17 + r];
#pragma unroll
                    for (int j = 0; j < 4; ++j) acc[r][j] += s_ * w[j]; } }
#pragma unroll
            for (int r = 0; r < 17; ++r)
#pragma unroll
                for (int j = 0; j < 4; ++j) { float v = acc[r][j]; v += __shfl_xor(v, 4); v += __shfl_xor(v, 8); v += __shfl_xor(v, 16); v += __shfl_xor(v, 32); acc[r][j] = v; }
            if (kq == 0) { const f32x4 bb = *(const f32x4*)(p.ada_b + layer * 6144 + col0);
#pragma unroll
                for (int r = 0; r < 17; ++r) { f32x4 o = {acc[r][0] + bb[0], acc[r][1] + bb[1], acc[r][2] + bb[2], acc[r][3] + bb[3]}; *(f32x4*)(MOD + ((size_t)layer * 17 + r) * 6144 + col0) = o; } }
        }
        __syncthreads();
    }
    if (blockIdx.x == G - 1) {
        float* rt = (float*)(p.ws + WS_ROPE);
        for (int idx = tid; idx < 1024; idx += NTHREADS) { const int pos = idx >> 4, f = idx & 15; const float inv = powf(10000.0f, -(float)f / 16.0f); const float ang = (float)pos * inv;
            rt[idx * 2] = cosf(ang); rt[idx * 2 + 1] = sinf(ang); }
    }
    { float* RS = (float*)(p.ws + WS_RS);
      for (int row = (blockIdx.x * 8 + wid) * 4; row < MALL; row += G * 32) { const float* xi = xin_row(p, row, true); f32x4 xx[4][4];
#pragma unroll
          for (int q = 0; q < 4; ++q)
#pragma unroll
              for (int i = 0; i < 4; ++i) xx[q][i] = *(const f32x4*)(xi + q * DM + i * 256 + lane * 4);
          float ss[4] = {0.f, 0.f, 0.f, 0.f};
#pragma unroll
          for (int q = 0; q < 4; ++q)
#pragma unroll
              for (int i = 0; i < 4; ++i) ss[q] += xx[q][i][0] * xx[q][i][0] + xx[q][i][1] * xx[q][i][1] + xx[q][i][2] * xx[q][i][2] + xx[q][i][3] * xx[q][i][3];
#pragma unroll
          for (int o = 32; o >= 1; o >>= 1) { ss[0] += __shfl_xor(ss[0], o); ss[1] += __shfl_xor(ss[1], o); ss[2] += __shfl_xor(ss[2], o); ss[3] += __shfl_xor(ss[3], o); }
          if (lane < 4) RS[row + lane] = rsqrtf((lane == 0 ? ss[0] : lane == 1 ? ss[1] : lane == 2 ? ss[2] : ss[3]) * (1.0f / DM) + EPS); } }
    bf16_t* W = (bf16_t*)(p.ws + WS_W);
    int rot = 192;
    for (int l = 0; l < 4; ++l) {
        conv_wt(p.ffn_w1 + (size_t)l * 1024 * 4096, 1024, 4096, 4096, W + W_FFN + (size_t)l * 8388608, fl, rot); rot += 1024;
        conv_wt(p.ffn_w2 + (size_t)l * 4096 * 1024, 4096, 1024, 1024, W + W_FFN + (size_t)l * 8388608 + 4194304, fl, rot); rot += 1024;
    }
    for (int g = 0; g < 4; ++g) { conv_wt(p.pool_w + (size_t)g * 65536, 256, 256, 256, W + W_POOL + (size_t)g * 65536, fl, rot); rot += 16; }
    conv_wt(p.conv_in_w, 1024, 3072, 3072, W + W_CIN, fl, rot); rot += 768;
    conv_wt(p.conv_out_w, 1024, 1024, 1024, W + W_COUT, fl, rot); rot += 256;
    conv_wt(p.mla_w_down, 1024, 704, 768, W + W_DOWN, fl, rot); rot += 192;
    conv_wt(p.mla_w_uq, 384, 1536, 1536, W + W_UQ, fl, rot); rot += 144;
    conv_wt(p.mla_w_ukv, 256, 2048, 2048, W + W_UKV, fl, rot); rot += 128;
    conv_wt(p.mla_w_o, 1024, 1024, 1024, W + W_MO, fl, rot); rot += 256;
    conv_wt(p.diff_w_qkv, 1024, 3072, 3072, W + W_DQKV, fl, rot); rot += 768;
    conv_wt(p.diff_w_o, 1024, 1024, 1024, W + W_DO, fl, rot);
}

__device__ __forceinline__ void grid_barrier(unsigned* bar, unsigned gen) {
    asm volatile("s_waitcnt vmcnt(0) lgkmcnt(0)" ::: "memory");
    __syncthreads();
    if (threadIdx.x < 64) {
        if (threadIdx.x == 0) {
            const unsigned g = blockIdx.x & 7, G = gridDim.x, gsize = (G + 7 - g) >> 3, ng = G < 8 ? G : 8;
            __builtin_amdgcn_fence(__ATOMIC_RELEASE, "agent");
            asm volatile("s_waitcnt vmcnt(0)" ::: "memory");
            if (__hip_atomic_fetch_add(bar + 64 * (1 + g), 1u, __ATOMIC_RELAXED, __HIP_MEMORY_SCOPE_AGENT) + 1 == gen * gsize) {
                if (__hip_atomic_fetch_add(bar, 1u, __ATOMIC_RELAXED, __HIP_MEMORY_SCOPE_AGENT) + 1 == gen * ng) {
                    for (unsigned j = 0; j < ng; ++j) __hip_atomic_store(bar + 64 * (9 + j), gen, __ATOMIC_RELAXED, __HIP_MEMORY_SCOPE_AGENT);
                }
            }
            while (__hip_atomic_load(bar + 64 * (9 + g), __ATOMIC_RELAXED, __HIP_MEMORY_SCOPE_AGENT) < gen) __builtin_amdgcn_s_sleep(1);
        }
        __builtin_amdgcn_fence(__ATOMIC_ACQUIRE, "agent");
        asm volatile("s_waitcnt vmcnt(0)" ::: "memory");
    }
    __syncthreads();
}

enum { T_PREP = 0, T_POOLD, T_GEMM, T_RN, T_CONV, T_MLAPREP, T_ATTN_MLA, T_ATTN_DIFF };
constexpr int N_PHASES = 31;

__global__ void __launch_bounds__(NTHREADS, 2) mk_fwd(Params p_arg) {
    extern __shared__ __attribute__((aligned(16))) unsigned char shm[];
    LAS unsigned char* ldsl = (LAS unsigned char*)shm; char* ldsg = (char*)shm;
    const int ph_lo = p_arg.ph_lo, ph_hi = p_arg.ph_hi; unsigned char* const wsb = p_arg.ws;
    bf16_t* H = (bf16_t*)(wsb + WS_H); bf16_t* T1 = (bf16_t*)(wsb + WS_T1); const bf16_t* W = (const bf16_t*)(wsb + WS_W);
    const float* rope = (const float*)(wsb + WS_ROPE);
    unsigned nbar = 0; unsigned* barcnt = (unsigned*)(wsb + WS_BAR);
    for (int ph = ph_lo; ph < ph_hi; ++ph) {
#if defined(__HIP_DEVICE_COMPILE__)
        typedef const __attribute__((address_space(4))) Params* KArgP;
        KArgP pp = (KArgP)__builtin_amdgcn_kernarg_segment_ptr(); asm volatile("" : "+s"(pp));
        const Params p = *pp;
#else
        const Params p = p_arg;
#endif
        int type = T_GEMM, sync = 1, layer = 0, stage = 0, nrows = MALL, npart = 1; const bf16_t* Y = T1;
        GemmP g; g.A = H; g.Bt = W; g.lda = 1024; g.ldb = 1024; g.K = 1024; g.nM = 144; g.nN = 4; g.a_pn_off = 0; g.ksplit = 1; g.a_tiled = 0; g.rev = 0; g.magicN = 16384;
        EpiP e; e.O = T1; e.ldo = 1024; e.mode = 0; e.colscale = nullptr; e.rope = rope; e.Opart = (bf16_t*)(wsb + WS_SCR);
        switch (ph) {
        case 0: type = T_PREP; break;
        case 1: type = T_POOLD; break;
        case 2: g.Bt = W + W_POOL; g.ldb = 256; g.K = 256; g.a_pn_off = 256; e.colscale = p.pool_scale; break;
        case 3: type = T_RN; layer = 0; stage = 0; Y = T1; break;
        case 4: case 11: case 21: case 28: { const int l = ph == 4 ? 0 : ph == 11 ? 1 : ph == 21 ? 2 : 3;
            g.Bt = W + W_FFN + (size_t)l * 8388608; g.nN = 16; g.magicN = 4096; g.nM = l == 3 ? 128 : 144; e.ldo = 4096; e.mode = 1; } break;
        case 5: case 12: case 22: case 29: { const int l = ph == 5 ? 0 : ph == 12 ? 1 : ph == 22 ? 2 : 3;
            g.A = T1; g.lda = 4096; g.Bt = W + W_FFN + (size_t)l * 8388608 + 4194304; g.ldb = 4096; g.K = 4096; g.nM = l == 3 ? 128 : 144; g.ksplit = l == 3 ? 1 : 4; g.a_tiled = 1; e.O = H; } break;
        case 6: type = T_RN; layer = 0; stage = 1; Y = H; npart = 4; break;
        case 7: g.Bt = W + W_CIN; g.nN = 12; g.magicN = 5462; e.ldo = 3072; break;
        case 8: type = T_CONV; break;
        case 9: g.Bt = W + W_COUT; g.ksplit = 4; break;
        case 10: type = T_RN; layer = 1; stage = 0; Y = T1; npart = 4; break;
        case 13: type = T_RN; layer = 1; stage = 1; Y = H; npart = 4; break;
        case 14: g.Bt = W + W_DOWN; g.nN = 3; g.magicN = 21846; e.O = T1 + T_AB; e.ldo = 768; break;
        case 15: type = T_MLAPREP; break;
        case 16: g.A = T1 + T_CQ; g.lda = 384; g.Bt = W + W_UQ; g.ldb = 384; g.K = 384; g.nN = 6; g.magicN = 10923; e.O = T1 + T_Q; e.ldo = 1536; e.mode = 3; break;
        case 17: sync = 0; g.rev = 1; g.A = H; g.lda = 256; g.Bt = W + W_UKV; g.ldb = 256; g.K = 256; g.nN = 8; g.magicN = 8192; e.O = T1 + T_KV; e.ldo = 2048; break;
        case 18: type = T_ATTN_MLA; break;
        case 19: g.Bt = W + W_MO; g.ksplit = 4; break;
        case 20: type = T_RN; layer = 2; stage = 0; Y = T1; npart = 4; break;
        case 23: type = T_RN; layer = 2; stage = 1; Y = H; npart = 4; break;
        case 24: g.Bt = W + W_DQKV; g.nN = 12; g.magicN = 5462; e.ldo = 3072; e.mode = 2; break;
        case 25: type = T_ATTN_DIFF; break;
        case 26: g.Bt = W + W_DO; g.nM = 128; break;
        case 27: type = T_RN; layer = 3; stage = 0; Y = T1; nrows = MLAT; break;
        case 30: type = T_RN; layer = 3; stage = 1; Y = H; nrows = MLAT; break;
        default: break;
        }
        if (ph > ph_lo && sync) { if (ph_hi > N_PHASES) cg::this_grid().sync(); else { ++nbar; grid_barrier(barcnt, nbar); } }
#ifdef REPEAT_MASK
        for (int rep_ = 0; rep_ < (((REPEAT_MASK) >> ph) & 1 ? 2 : 1); ++rep_) {
        if (rep_) cg::this_grid().sync();
#endif
        switch (type) {
#ifndef PH_MASK
#define PH_MASK 0xff
#endif
#if PH_MASK & 1
        case T_PREP: phase_prep(p, ldsg); break;
#endif
#if PH_MASK & 2
        case T_POOLD: phase_poold(p); break;
#endif
#if PH_MASK & 4
        case T_GEMM: gemm_phase(ldsl, g, e); break;
#endif
#if PH_MASK & 8
        case T_RN: phase_rn(p, layer, stage, Y, nrows, npart); break;
#endif
#if PH_MASK & 16
        case T_CONV: phase_conv(p); break;
#endif
#if PH_MASK & 32
        case T_MLAPREP: phase_mlaprep(p); break;
#endif
#if PH_MASK & 64
        case T_ATTN_MLA: phase_attn_mla(p, ldsg); break;
#endif
#if PH_MASK & 128
        case T_ATTN_DIFF: phase_attn_diff(p, ldsg); break;
#endif
        }
#ifdef REPEAT_MASK
        }
#endif
    }
}

extern "C" void kernel_launch(void* const* d_in, const int* in_sizes, int n_in, void* d_out, int out_size, void* d_ws, size_t ws_size, hipStream_t stream) {
    static int grid = 0;
    if (grid == 0) {
        if (n_in != 24 || out_size != MLAT * DM || ws_size < WS_END) { fprintf(stderr, "kernel_launch: unexpected shapes (n_in %d out %d ws %zu need %zu)\n", n_in, out_size, ws_size, (size_t)WS_END); grid = -1; return; }
        if (hipFuncSetAttribute((const void*)mk_fwd, hipFuncAttributeMaxDynamicSharedMemorySize, LDS_BYTES) != hipSuccess) { fprintf(stderr, "kernel_launch: hipFuncSetAttribute failed\n"); grid = -1; return; }
        int dev = 0, cus = 0, per_cu = 0;
        (void)hipGetDevice(&dev); (void)hipDeviceGetAttribute(&cus, hipDeviceAttributeMultiprocessorCount, dev);
        (void)hipOccupancyMaxActiveBlocksPerMultiprocessor(&per_cu, (const void*)mk_fwd, NTHREADS, LDS_BYTES);
        if (per_cu < 1) { fprintf(stderr, "kernel_launch: occupancy query says %d blocks per CU\n", per_cu); per_cu = 1; }
        (void)hipGetLastError();
        grid = cus * 1;
        if (grid > 256) grid = 256;
    }
    if (grid < 0) return;
    Params p{};
    const float** pp = (const float**)&p;
    for (int i = 0; i < 24; ++i) pp[i] = (const float*)d_in[i];
    p.out = (float*)d_out; p.ws = (unsigned char*)d_ws;
#if MK_ONE_LAUNCH
    (void)hipMemsetAsync((char*)d_ws + WS_BAR, 0, 17 * 256, stream);
    p.ph_lo = 0; p.ph_hi = N_PHASES;
    void* args[] = {&p};
    hipError_t e = hipLaunchCooperativeKernel((const void*)mk_fwd, dim3(grid), dim3(NTHREADS), args, LDS_BYTES, stream);
    if (e != hipSuccess) fprintf(stderr, "cooperative launch failed: %s (grid %d)\n", hipGetErrorString(e), grid);
#else
    for (int ph = 0; ph < N_PHASES; ++ph) {
        p.ph_lo = ph; p.ph_hi = ph + 1;
        hipLaunchKernelGGL(mk_fwd, dim3(grid), dim3(NTHREADS), LDS_BYTES, stream, p);
    }
#endif
}
```

```cpp
#include <hip/hip_runtime.h>
#include <hip/hip_cooperative_groups.h>
#include <cstdio>
#include <cstdint>
namespace cg = cooperative_groups;

#ifndef MK_ONE_LAUNCH
#define MK_ONE_LAUNCH 1
#endif

#define LAS __attribute__((address_space(3)))
typedef unsigned short bf16_t;
typedef short bf16x8 __attribute__((ext_vector_type(8)));
typedef short s16x4 __attribute__((ext_vector_type(4)));
typedef float f32x4 __attribute__((ext_vector_type(4)));
typedef float f32x16 __attribute__((ext_vector_type(16)));
typedef unsigned u32x4 __attribute__((ext_vector_type(4)));
typedef unsigned u32x2 __attribute__((ext_vector_type(2)));

constexpr int DM = 1024, NB = 16, SEQ = 2048, CTXL = 256, MLAT = NB * SEQ, MCTX = NB * CTXL, MALL = MLAT + MCTX;
constexpr float EPS = 1e-6f;
constexpr int NTHREADS = 512;
#ifndef MLA_NQL
#define MLA_NQL 4
#endif
constexpr int LDS_BYTES = (32768 + 49152 + 2048 + MLA_NQL * 8192) > 131072 ? (32768 + 49152 + 2048 + MLA_NQL * 8192) : 131072;

constexpr size_t WS_XC = 0;
constexpr size_t WS_H = WS_XC + (size_t)MCTX * DM * 4;
constexpr size_t WS_T1 = WS_H + (size_t)MALL * DM * 2;
constexpr size_t WS_W = WS_T1 + (size_t)MALL * 4096 * 2;
constexpr size_t W_ELTS = 45154304;
constexpr size_t WS_MOD = WS_W + W_ELTS * 2;
constexpr size_t WS_RS = WS_MOD + (size_t)4 * 17 * 6144 * 4;
constexpr size_t WS_ROPE = WS_RS + (size_t)MALL * 4;
constexpr size_t WS_SCR = WS_ROPE + 8192;
constexpr size_t WS_BAR = WS_SCR + (size_t)256 * 64 * 512 * 4;
constexpr size_t WS_END = WS_BAR + 17 * 256;
static_assert(WS_SCR % 256 == 0 && WS_MOD % 256 == 0 && WS_RS % 256 == 0 && WS_ROPE % 256 == 0, "align");
static_assert(WS_END <= 536870912ull, "workspace budget");
constexpr size_t W_FFN = 0;
constexpr size_t W_POOL = 33554432;
constexpr size_t W_CIN = W_POOL + 262144;
constexpr size_t W_COUT = W_CIN + 3145728;
constexpr size_t W_DOWN = W_COUT + 1048576;
constexpr size_t W_UQ = W_DOWN + 786432;
constexpr size_t W_UKV = W_UQ + 589824;
constexpr size_t W_MO = W_UKV + 524288;
constexpr size_t W_DQKV = W_MO + 1048576;
constexpr size_t W_DO = W_DQKV + 3145728;
static_assert(W_DO + 1048576 == W_ELTS, "weights");
constexpr size_t T_Q = 0;
constexpr size_t T_KV = T_Q + (size_t)MALL * 1536;
constexpr size_t T_CQ = T_KV + (size_t)MALL * 2048;
constexpr size_t T_KR = T_CQ + (size_t)MALL * 384;
constexpr size_t T_AB = T_KV;
static_assert(T_KR + (size_t)MALL * 64 <= (size_t)MALL * 4096, "arena");

struct Params {
    const float *x, *c, *ctx, *c_ctx, *ada_w, *ada_b, *norm_g, *ffn_w1, *ffn_w2, *pool_w, *pool_scale, *conv_in_w, *conv_w, *conv_out_w,
        *mla_w_down, *mla_g_q, *mla_g_kv, *mla_w_uq, *mla_w_ukv, *mla_w_o, *diff_w_qkv, *diff_lambda, *diff_g_subln, *diff_w_o;
    float* out; unsigned char* ws; int ph_lo, ph_hi;
};

__device__ __forceinline__ int tid_opaque() { int t = threadIdx.x; asm volatile("" : "+v"(t)); return t; }
__device__ __forceinline__ unsigned cvt_pk_bf16(float lo, float hi) { unsigned r; asm volatile("v_cvt_pk_bf16_f32 %0, %1, %2" : "=v"(r) : "v"(lo), "v"(hi)); return r; }
__device__ __forceinline__ float bf_lo(unsigned w) { return __uint_as_float(w << 16); }
__device__ __forceinline__ float bf_hi(unsigned w) { return __uint_as_float(w & 0xffff0000u); }
__device__ __forceinline__ float wave_sum(float v) {
#pragma unroll
    for (int o = 32; o >= 1; o >>= 1) v += __shfl_xor(v, o);
    return v;
}
__device__ __forceinline__ int modrow(int row) { return row < MLAT ? (row >> 11) : NB; }
__device__ __forceinline__ void load_bf4(const bf16_t* p, float* v) { const u32x2 w = *(const u32x2*)p; v[0] = bf_lo(w.x); v[1] = bf_hi(w.x); v[2] = bf_lo(w.y); v[3] = bf_hi(w.y); }
__device__ __forceinline__ void store_bf4(bf16_t* p, float a, float b, float c, float d) { u32x2 w; w.x = cvt_pk_bf16(a, b); w.y = cvt_pk_bf16(c, d); *(u32x2*)p = w; }

constexpr int BM = 256, BK = 64, HALF = 128, HTB = HALF * BK * 2;
__device__ __forceinline__ int lds_byte(int r, int c) { const int st = (r >> 4) * 2 + (c >> 5), rr = r & 15, cc = c & 31, ob = rr * 64 + cc * 2; return st * 1024 + (ob ^ (((ob >> 9) & 1) << 5)); }
__device__ __forceinline__ void stage_rc(int b, int& R, int& C) { const int st = b / 1024, sb = b % 1024, swz = sb ^ (((sb >> 9) & 1) << 5); R = (st >> 1) * 16 + swz / 64; C = (st & 1) * 32 + (swz % 64) / 2; }

struct Unit { int pm, pn, ks, nt; };
struct GemmP { const bf16_t* A; const bf16_t* Bt; int lda, ldb, K, nM, nN, a_pn_off, ksplit, a_tiled, rev, magicN; };
struct EpiP { bf16_t* O; int ldo; int mode; const float* colscale; const float* rope; bf16_t* Opart; };

__device__ __forceinline__ bool unit_next(const GemmP& g, int i, Unit& u) {
    const int nMf = g.ksplit > 1 ? 128 : g.nM;
    const int nwg = nMf * g.nN; const int L = i * (int)gridDim.x + (g.rev ? (int)gridDim.x - 1 - (int)blockIdx.x : (int)blockIdx.x);
    if (L >= nwg) {
        if (g.ksplit <= 1) return false;
        const int idx = L - nwg; if (idx >= (g.nM - nMf) * 16) return false;
        u.pm = nMf + (idx >> 4); const int r = idx & 15; u.pn = r >> 2; u.ks = r & 3; u.nt = g.K >> 8; return true;
    }
    int wgid = L; { const int q = nwg >> 3, xcd = wgid & 7, off = wgid >> 3; wgid = xcd * q + off; }
    const int w8 = wgid >> 3, gid = (w8 * g.magicN) >> 16, rem = wgid - gid * 8 * g.nN;
    u.pm = gid * 8 + (rem & 7); u.pn = rem >> 3; u.ks = -1; u.nt = g.K >> 6; return true;
}

__device__ __forceinline__ void epi_store(const f32x4 (&acc)[2][2][4][2], const Unit& u, int wr, int wc, int fr, int fq, const EpiP& e) {
    const int row0 = u.pm * BM + wr * 64 + fr;
    if (e.mode < 2) {
        const int col0 = u.pn * BM + wc * 32 + 8 * fq;
#pragma unroll
        for (int bj = 0; bj < 2; ++bj) {
            const int c = col0 + bj * HALF;
            f32x4 cs0 = {1.f, 1.f, 1.f, 1.f}, cs1 = {1.f, 1.f, 1.f, 1.f};
            if (e.mode == 0 && e.colscale) { cs0 = *(const f32x4*)(e.colscale + c); cs1 = *(const f32x4*)(e.colscale + c + 4); }
#pragma unroll
            for (int ai = 0; ai < 2; ++ai)
#pragma unroll
                for (int m = 0; m < 4; ++m) {
                    const int row = row0 + ai * HALF + m * 16;
                    f32x4 v0 = acc[ai][bj][m][0], v1 = acc[ai][bj][m][1];
                    if (e.mode == 1) {
#pragma unroll
                        for (int j = 0; j < 4; ++j) { const float a = fmaxf(v0[j], 0.f), b = fmaxf(v1[j], 0.f); v0[j] = a * a; v1[j] = b * b; }
                    } else { v0 *= cs0; v1 *= cs1; }
                    bf16_t* rowp = (u.ks < 0 ? e.O + (size_t)row * e.ldo : e.Opart + ((size_t)u.ks * MCTX + (row - MLAT)) * 1024) + c;
                    if (e.mode == 1)
                        rowp = (bf16_t*)((char*)e.O + ((size_t)(u.pm * 64 + u.pn * 4 + bj * 2 + (wc >> 1))) * 32768 + ai * 16384 + (((wr * 4 + m) * 2 + (wc & 1)) * 1024) + (fr * 4 + fq) * 16);
                    u32x4 w; w.x = cvt_pk_bf16(v0[0], v0[1]); w.y = cvt_pk_bf16(v0[2], v0[3]); w.z = cvt_pk_bf16(v1[0], v1[1]); w.w = cvt_pk_bf16(v1[2], v1[3]);
                    *(u32x4*)rowp = w;
                }
        }
        return;
    }
    const int col0 = u.pn * BM + wc * 32 + 4 * fq;
#pragma unroll
    for (int bj = 0; bj < 2; ++bj) {
        const int c = col0 + bj * HALF;
        int kind = 0;
        if (e.mode == 2) { if (c < 2048) kind = ((c >> 5) & 1) ? 2 : 1; }
        else { const int d = c % 192; if (d >= 128) kind = (d >= 160) ? 2 : 1; }
#pragma unroll
        for (int ai = 0; ai < 2; ++ai)
#pragma unroll
            for (int m = 0; m < 4; ++m) {
                const int row = row0 + ai * HALF + m * 16;
                f32x4 v0 = acc[ai][bj][m][0], v1 = acc[ai][bj][m][1];
                if (kind != 0 && row < MLAT) {
                    const int t = row & (SEQ - 1); const int pos = (kind == 1) ? (t >> 6) : (t & 63);
                    const f32x4 t0 = *(const f32x4*)(e.rope + (pos * 16 + 4 * fq) * 2), t1 = *(const f32x4*)(e.rope + (pos * 16 + 4 * fq) * 2 + 4);
                    const float cs[4] = {t0[0], t0[2], t1[0], t1[2]}, sn[4] = {t0[1], t0[3], t1[1], t1[3]};
#pragma unroll
                    for (int j = 0; j < 4; ++j) { const float x1 = v0[j], x2 = v1[j]; v0[j] = x1 * cs[j] - x2 * sn[j]; v1[j] = x2 * cs[j] + x1 * sn[j]; }
                }
                bf16_t* rowp = e.O + (size_t)row * e.ldo + c;
                u32x2 w0, w1; w0.x = cvt_pk_bf16(v0[0], v0[1]); w0.y = cvt_pk_bf16(v0[2], v0[3]); w1.x = cvt_pk_bf16(v1[0], v1[1]); w1.y = cvt_pk_bf16(v1[2], v1[3]);
                const bool odd = (fq & 1) != 0;
                const unsigned sx = odd ? w0.x : w1.x, sy = odd ? w0.y : w1.y;
                const unsigned rx = (unsigned)__shfl_xor((int)sx, 16), ry = (unsigned)__shfl_xor((int)sy, 16);
                u32x4 w; if (odd) { w.x = rx; w.y = ry; w.z = w1.x; w.w = w1.y; } else { w.x = w0.x; w.y = w0.y; w.z = rx; w.w = ry; }
                *(u32x4*)(rowp + (odd ? 12 : 0)) = w;
            }
    }
}

__device__ __forceinline__ void gemm_phase(LAS unsigned char* lds, const GemmP g, const EpiP e) {
    const int tid = tid_opaque(), wid = __builtin_amdgcn_readfirstlane(tid >> 6), lane = tid & 63, wr = wid >> 2, wc = wid & 3, fr = lane & 15, fq = lane >> 4;
    unsigned voffA[2], voffB[2];
#pragma unroll
    for (int i = 0; i < 2; ++i) { int R, C; stage_rc(tid * 16 + i * 8192, R, C); const int rho = R & 31; const int Rb = (e.mode < 2) ? ((R & ~31) + 8 * ((rho & 15) >> 2) + 4 * (rho >> 4) + (rho & 3)) : R;
        voffA[i] = g.a_tiled ? (unsigned)((((R >> 4) * 2 + (C >> 5)) * 1024) + ((R & 15) * 4 + ((C >> 3) & 3)) * 16) : (unsigned)(R * g.lda + C) * 2u; voffB[i] = (unsigned)(Rb * g.ldb + C) * 2u; }
    const size_t kstepB = (size_t)(BK * 2), kstepA = g.a_tiled ? (size_t)32768 : (size_t)(BK * 2);
    const size_t hstepA = g.a_tiled ? (size_t)16384 : (size_t)HALF * g.lda * 2, hstepB = (size_t)HALF * g.ldb * 2;
    const size_t tstepA = g.a_tiled ? (size_t)(g.K / BK) * 32768 : 2 * hstepA, tstepB = 2 * hstepB;
    const unsigned ldsw = (unsigned)wid * 1024u;
    const int aoff = lds_byte(wr * 64 + fr, fq * 8), boff = lds_byte(wc * 32 + fr, fq * 8);
#define PG8_SA(b, h) (((b) * 2 + (h)) * HTB)
#define PG8_SB(b, h) ((4 + (b) * 2 + (h)) * HTB)
#define PG8_STAGE(bufoff, gbase, voff) do { _Pragma("unroll") for (int _i = 0; _i < 2; ++_i) \
        __builtin_amdgcn_global_load_lds((const unsigned*)((const char*)(gbase) + (voff)[_i]), (LAS unsigned*)(lds + (bufoff) + ldsw + _i * 8192), 16, 0, 0); } while (0)
#define PG8_LDA(dst, b, h) do { _Pragma("unroll") for (int m = 0; m < 4; ++m) _Pragma("unroll") for (int k = 0; k < 2; ++k) dst[m][k] = *(const LAS bf16x8*)(lds + PG8_SA(b, h) + aoff + m * 2048 + k * 1024); } while (0)
#define PG8_LDB(dst, b, h) do { _Pragma("unroll") for (int n = 0; n < 2; ++n) _Pragma("unroll") for (int k = 0; k < 2; ++k) dst[n][k] = *(const LAS bf16x8*)(lds + PG8_SB(b, h) + boff + n * 2048 + k * 1024); } while (0)
#define PG8_MMA(ai, bj, At, Bt) do { __builtin_amdgcn_s_setprio(1); _Pragma("unroll") for (int m = 0; m < 4; ++m) _Pragma("unroll") for (int n = 0; n < 2; ++n) _Pragma("unroll") for (int k = 0; k < 2; ++k) \
        acc[ai][bj][m][n] = __builtin_amdgcn_mfma_f32_16x16x32_bf16(Bt[n][k], At[m][k], acc[ai][bj][m][n], 0, 0, 0); __builtin_amdgcn_s_setprio(0); } while (0)
#define PG8_WAIT_V(n) asm volatile("s_waitcnt vmcnt(" #n ")" ::: "memory")
#define PG8_WAIT_L(n) asm volatile("s_waitcnt lgkmcnt(" #n ")" ::: "memory")
#define PG8_BAR __builtin_amdgcn_s_barrier()
#define PG8_SCHED __builtin_amdgcn_sched_barrier(0)
    Unit cur, nxt; int ui = 0;
    if (!unit_next(g, 0, cur)) return;
    f32x4 acc[2][2][4][2];
#pragma unroll
    for (int a = 0; a < 2; ++a)
#pragma unroll
        for (int b = 0; b < 2; ++b)
#pragma unroll
            for (int m = 0; m < 4; ++m)
#pragma unroll
                for (int n = 0; n < 2; ++n) acc[a][b][m][n] = (f32x4){0.f, 0.f, 0.f, 0.f};
    bf16x8 At[4][2], B0[2][2], B1[2][2];
    const size_t ksliceB = (size_t)(g.ksplit > 1 ? g.K / g.ksplit : 0) * 2;
    const size_t ksliceA = g.a_tiled ? (size_t)(g.ksplit > 1 ? g.K / g.ksplit / BK : 0) * 32768 : ksliceB;
#define UNIT_A(u_) ((const char*)g.A + (size_t)(u_).pm * tstepA + (size_t)(u_).pn * g.a_pn_off * 2 + ((u_).ks > 0 ? (u_).ks * ksliceA : 0))
#define UNIT_B(u_) ((const char*)g.Bt + (size_t)(u_).pn * tstepB + ((u_).ks > 0 ? (u_).ks * ksliceB : 0))
    const char* cA = UNIT_A(cur); const char* cB = UNIT_B(cur);
    PG8_STAGE(PG8_SB(0, 0), cB, voffB); PG8_STAGE(PG8_SB(0, 1), cB + hstepB, voffB); PG8_STAGE(PG8_SA(0, 0), cA, voffA); PG8_STAGE(PG8_SA(0, 1), cA + hstepA, voffA);
    if (wr == 1) PG8_BAR;
    PG8_WAIT_V(2); PG8_BAR;
    PG8_STAGE(PG8_SB(1, 0), cB + kstepB, voffB); PG8_STAGE(PG8_SA(1, 0), cA + kstepA, voffA); PG8_STAGE(PG8_SB(1, 1), cB + hstepB + kstepB, voffB);
    PG8_WAIT_V(6); PG8_BAR;
    for (;;) {
        const bool has_next = unit_next(g, ui + 1, nxt);
        const char* nA = has_next ? UNIT_A(nxt) : cA; const char* nB = has_next ? UNIT_B(nxt) : cB;
        const int nt = cur.nt;
        for (int t = 0; t < nt; t += 2) {
            const bool last = (t == nt - 2);
            const char* a1 = cA + (size_t)(t + 1) * kstepA;
            const char* a2 = last ? nA : cA + (size_t)(t + 2) * kstepA; const char* b2 = last ? nB : cB + (size_t)(t + 2) * kstepB;
            const char* a3 = a2 + kstepA; const char* b3 = b2 + kstepB;
            PG8_LDB(B0, 0, 0); PG8_LDB(B1, 0, 1); PG8_SCHED; PG8_LDA(At, 0, 0); PG8_STAGE(PG8_SA(1, 1), a1 + hstepA, voffA);
            PG8_WAIT_V(8); PG8_WAIT_L(0); PG8_BAR; PG8_MMA(0, 0, At, B0); PG8_MMA(0, 1, At, B1); PG8_BAR; PG8_SCHED;
            PG8_LDA(At, 0, 1); PG8_STAGE(PG8_SB(0, 0), b2, voffB); PG8_STAGE(PG8_SB(0, 1), b2 + hstepB, voffB); PG8_STAGE(PG8_SA(0, 0), a2, voffA);
            PG8_WAIT_V(8); PG8_WAIT_L(0); PG8_BAR; PG8_MMA(1, 0, At, B0); PG8_MMA(1, 1, At, B1); PG8_BAR; PG8_SCHED;
            PG8_LDB(B0, 1, 0); PG8_LDB(B1, 1, 1); PG8_SCHED; PG8_LDA(At, 1, 0); PG8_STAGE(PG8_SA(0, 1), a2 + hstepA, voffA);
            PG8_WAIT_V(8); PG8_WAIT_L(0); PG8_BAR; PG8_MMA(0, 0, At, B0); PG8_MMA(0, 1, At, B1); PG8_BAR; PG8_SCHED;
            PG8_LDA(At, 1, 1); PG8_STAGE(PG8_SB(1, 0), b3, voffB); PG8_STAGE(PG8_SB(1, 1), b3 + hstepB, voffB); PG8_STAGE(PG8_SA(1, 0), a3, voffA);
            PG8_WAIT_V(8); PG8_WAIT_L(0); PG8_BAR; PG8_MMA(1, 0, At, B0); PG8_MMA(1, 1, At, B1); PG8_BAR; PG8_SCHED;
        }
        if (wr == 0) PG8_BAR;
        epi_store(acc, cur, wr, wc, fr, fq, e);
        if (!has_next) break;
#pragma unroll
        for (int a = 0; a < 2; ++a)
#pragma unroll
            for (int b = 0; b < 2; ++b)
#pragma unroll
                for (int m = 0; m < 4; ++m)
#pragma unroll
                    for (int n = 0; n < 2; ++n) acc[a][b][m][n] = (f32x4){0.f, 0.f, 0.f, 0.f};
        cur = nxt; cA = nA; cB = nB; ++ui;
        if (wr == 1) PG8_BAR;
    }
    PG8_WAIT_V(0);
    PG8_BAR;
#undef UNIT_A
#undef UNIT_B
#undef PG8_SA
#undef PG8_SB
#undef PG8_STAGE
#undef PG8_LDA
#undef PG8_LDB
#undef PG8_MMA
#undef PG8_WAIT_V
#undef PG8_WAIT_L
#undef PG8_BAR
#undef PG8_SCHED
}

#define SBAR() __builtin_amdgcn_sched_barrier(0)
__device__ __forceinline__ int crow(int r, int hi) { return (r & 3) + 8 * (r >> 2) + 4 * hi; }
__device__ __forceinline__ int v_st(int k, int c) { const int kk = (k & ~0xC) | ((k & 4) << 1) | ((k & 8) >> 1); return ((kk >> 3) * 4 + (c >> 5)) * 512 + ((kk & 7) * 32 + (c & 31)) * 2; }
__device__ __forceinline__ int v_rd_base(int lane) { return ((lane & 3) << 3) | (((lane >> 2) & 3) << 6) | (((lane >> 4) & 1) << 5) | (((lane >> 5) & 1) << 8); }
constexpr int v_rd_off(int d0, int ks, int half) { return d0 * 512 + ks * 4096 + half * 2048; }
template <int OFF> __device__ __forceinline__ s16x4 tr_read(int vb) { s16x4 r; asm volatile("ds_read_b64_tr_b16 %0, %1 offset:%2" : "=&v"(r) : "v"(vb), "i"(OFF) : "memory"); return r; }
template <int D0> __device__ __forceinline__ void pv_one(f32x16& od, int vb, bf16x8 pa0, bf16x8 pa1, bf16x8 pa2, bf16x8 pa3) {
    const s16x4 l0 = tr_read<v_rd_off(D0, 0, 0)>(vb), h0 = tr_read<v_rd_off(D0, 0, 1)>(vb), l1 = tr_read<v_rd_off(D0, 1, 0)>(vb), h1 = tr_read<v_rd_off(D0, 1, 1)>(vb);
    const s16x4 l2 = tr_read<v_rd_off(D0, 2, 0)>(vb), h2 = tr_read<v_rd_off(D0, 2, 1)>(vb), l3 = tr_read<v_rd_off(D0, 3, 0)>(vb), h3 = tr_read<v_rd_off(D0, 3, 1)>(vb);
    asm volatile("s_waitcnt lgkmcnt(0)" ::: "memory"); SBAR();
#define PK(L, H) (bf16x8){L[0], L[1], L[2], L[3], H[0], H[1], H[2], H[3]}
    od = __builtin_amdgcn_mfma_f32_32x32x16_bf16(pa0, PK(l0, h0), od, 0, 0, 0);
    od = __builtin_amdgcn_mfma_f32_32x32x16_bf16(pa1, PK(l1, h1), od, 0, 0, 0);
    od = __builtin_amdgcn_mfma_f32_32x32x16_bf16(pa2, PK(l2, h2), od, 0, 0, 0);
    od = __builtin_amdgcn_mfma_f32_32x32x16_bf16(pa3, PK(l3, h3), od, 0, 0, 0);
#undef PK
}
__device__ __forceinline__ void pv_d0(f32x16* o, int vb, bf16x8 pa0, bf16x8 pa1, bf16x8 pa2, bf16x8 pa3) {
    pv_one<0>(o[0], vb, pa0, pa1, pa2, pa3); pv_one<1>(o[1], vb, pa0, pa1, pa2, pa3); pv_one<2>(o[2], vb, pa0, pa1, pa2, pa3); pv_one<3>(o[3], vb, pa0, pa1, pa2, pa3);
}
__device__ __forceinline__ void partialSM(f32x16& p0, f32x16& p1, float& m_reg, float& mn, float& alpha, const float C, const float thr) {
    float pmax = p0[0];
#pragma unroll
    for (int r = 1; r < 16; ++r) pmax = fmaxf(pmax, p0[r]);
#pragma unroll
    for (int r = 0; r < 16; ++r) pmax = fmaxf(pmax, p1[r]);
    { auto rr = __builtin_amdgcn_permlane32_swap(__float_as_uint(pmax), __float_as_uint(pmax), false, false);
      pmax = fmaxf(__uint_as_float(rr[0]), __uint_as_float(rr[1])); }
    if (__builtin_expect(__all(pmax - m_reg <= thr), 1)) { mn = m_reg; alpha = 1.f; }
    else { mn = fmaxf(m_reg, pmax); alpha = __builtin_amdgcn_exp2f((m_reg - mn) * C); m_reg = mn; }
    const float mnC = -mn * C;
#pragma unroll
    for (int r = 0; r < 16; ++r) p0[r] = fmaf(p0[r], C, mnC);
#pragma unroll
    for (int r = 0; r < 16; ++r) p1[r] = fmaf(p1[r], C, mnC);
#pragma unroll
    for (int r = 0; r < 16; ++r) p0[r] = __builtin_amdgcn_exp2f(p0[r]);
}
__device__ __forceinline__ void finishSM(f32x16& p0, f32x16& p1, float alpha, float& l_reg, bf16x8& pa0, bf16x8& pa1, bf16x8& pa2, bf16x8& pa3) {
#pragma unroll
    for (int r = 0; r < 16; ++r) p1[r] = __builtin_amdgcn_exp2f(p1[r]);
    float ps = 0;
#pragma unroll
    for (int r = 0; r < 16; ++r) ps += p0[r];
#pragma unroll
    for (int r = 0; r < 16; ++r) ps += p1[r];
    { auto rr = __builtin_amdgcn_permlane32_swap(__float_as_uint(ps), __float_as_uint(ps), false, false);
      ps = __uint_as_float(rr[0]) + __uint_as_float(rr[1]); }
    l_reg = l_reg * alpha + ps;
#define PK4(P, BASE, OUT) do { unsigned a0 = cvt_pk_bf16(P[BASE + 0], P[BASE + 1]), a1 = cvt_pk_bf16(P[BASE + 2], P[BASE + 3]);   \
    unsigned b0 = cvt_pk_bf16(P[BASE + 4], P[BASE + 5]), b1 = cvt_pk_bf16(P[BASE + 6], P[BASE + 7]);                              \
    auto r0 = __builtin_amdgcn_permlane32_swap(a0, b0, false, false); auto r1 = __builtin_amdgcn_permlane32_swap(a1, b1, false, false); \
    u32x4 w = {r0[0], r1[0], r0[1], r1[1]}; OUT = *reinterpret_cast<bf16x8*>(&w); } while (0)
    PK4(p0, 0, pa0); PK4(p0, 8, pa1); PK4(p1, 0, pa2); PK4(p1, 8, pa3);
#undef PK4
}

struct AttnArgs {
    const bf16_t* Q; int ldq;
    const bf16_t* Kn; int ldk;
    const bf16_t* Kr; int ldkr;
    const bf16_t* V; int ldv;
    int lat0, ctx0, nlat, NT;
    float C, thr;
};

template <int DQK, int DK1, int LDQ, int LDK, int LDKR, int LDV, int NQL, int SDEPTH>
__device__ __forceinline__ void attn_core(const AttnArgs& a, char* lds, f32x16 (&o)[4]) {
    constexpr int KP = DQK * 2, SHM_K = 64 * KP, SHM_V = 64 * 128 * 2, KCH = DQK / 64, CPR = DQK / 8, ND0 = DQK / 16;
    const int tid = tid_opaque(), wid = tid >> 6, lane = tid & 63, r32 = lane & 31, hi = lane >> 5;
    char* V_lds = lds; char* K_lds = lds + 2 * SHM_V;
    float* wsf = (float*)(lds + 2 * SHM_V + 2 * SHM_K) + wid * 64; float* li_l = wsf; float* al_l = wsf + 32;
    float m_reg = -1e30f, l_reg = 0.f;
#pragma unroll
    for (int d = 0; d < 4; ++d)
#pragma unroll
        for (int r = 0; r < 16; ++r) o[d][r] = 0.f;
    constexpr int NQR = ND0 - NQL;
    bf16x8 qr[NQR];
    char* QL = lds + 2 * SHM_V + 2 * SHM_K + 2048 + tid * 16;
    { const bf16_t* Qw = a.Q + (long)(wid * 32 + r32) * LDQ + hi * 8;
#pragma unroll
      for (int d0 = 0; d0 < NQR; ++d0) qr[d0] = *(const bf16x8*)(Qw + d0 * 16);
#pragma unroll
      for (int d0 = NQR; d0 < ND0; ++d0) *(bf16x8*)(QL + (d0 - NQR) * 8192) = *(const bf16x8*)(Qw + d0 * 16); }
    const int sr = tid >> 4, sc = (tid & 15) * 8, vst0 = v_st(sr, sc), vst1 = v_st(32 + sr, sc);
    const int vb0 = (int)(uintptr_t)V_lds + v_rd_base(lane);
    const bf16_t* kptr[KCH]; int kld[KCH], kwo[KCH];
#pragma unroll
    for (int c = 0; c < KCH; ++c) { const int idx = tid + c * 512, kr_ = idx / CPR, kc = (idx % CPR) * 8;
        if (kc < DK1) { kptr[c] = a.Kn + (long)kr_ * LDK + kc; kld[c] = LDK; } else { kptr[c] = a.Kr + (long)kr_ * LDKR + (kc - DK1); kld[c] = LDKR; }
        kwo[c] = kr_ * KP + ((kc * 2) ^ ((kr_ & 7) << 4)); }
    struct { bf16x8 vs0, vs1, ks[KCH]; } sr_[SDEPTH];
    int kb[4];
#pragma unroll
    for (int m = 0; m < 4; ++m) kb[m] = r32 * KP + ((m * 32 + hi * 16) ^ ((r32 & 7) << 4));
#define KROW(j) ((j) < a.nlat ? a.lat0 + 64 * (j) : a.ctx0 + 64 * ((j) - a.nlat))
#define SLOAD(i, j) do { const long rb_ = KROW(j); sr_[i].vs0 = *(const bf16x8*)(a.V + (rb_ + sr) * LDV + sc); sr_[i].vs1 = *(const bf16x8*)(a.V + (rb_ + 32 + sr) * LDV + sc); \
    _Pragma("unroll") for (int c_ = 0; c_ < KCH; ++c_) sr_[i].ks[c_] = *(const bf16x8*)(kptr[c_] + rb_ * kld[c_]); } while (0)
#define SWRITE(b, i) do { *(bf16x8*)(V_lds + (b) * SHM_V + vst0) = sr_[i].vs0; *(bf16x8*)(V_lds + (b) * SHM_V + vst1) = sr_[i].vs1; \
    _Pragma("unroll") for (int c_ = 0; c_ < KCH; ++c_) *(bf16x8*)(K_lds + (b) * SHM_K + kwo[c_]) = sr_[i].ks[c_]; } while (0)
#define RESC(al) do { if (__any((al) < 1.f)) { if (hi == 0) al_l[r32] = (al); asm volatile("s_waitcnt lgkmcnt(0)" ::: "memory"); \
    _Pragma("unroll") for (int d = 0; d < 4; ++d) _Pragma("unroll") for (int r = 0; r < 16; ++r) o[d][r] *= al_l[crow(r, hi)]; } } while (0)
#define QKT(P0, P1, KB) do { P0 = f32x16{}; P1 = f32x16{}; \
    _Pragma("unroll") for (int d0 = 0; d0 < ND0; ++d0) { \
      const bf16x8 b0 = *(const bf16x8*)((KB) + kb[d0 & 3] + (d0 >> 2) * 128); \
      const bf16x8 b1 = *(const bf16x8*)((KB) + kb[d0 & 3] + (d0 >> 2) * 128 + 32 * KP); \
      const bf16x8 qf = (d0 < NQR) ? qr[d0 < NQR ? d0 : 0] : *(const bf16x8*)(QL + (d0 - NQR) * 8192); \
      P0 = __builtin_amdgcn_mfma_f32_32x32x16_bf16(b0, qf, P0, 0, 0, 0); \
      P1 = __builtin_amdgcn_mfma_f32_32x32x16_bf16(b1, qf, P1, 0, 0, 0); } } while (0)
    f32x16 pA0, pA1, pB0, pB1; float mnA, mnB, alA, alB; bf16x8 pa0, pa1, pa2, pa3; const int NT = a.NT;
    constexpr int SE = 0, SO = SDEPTH - 1;
    SLOAD(SE, 0); asm volatile("s_waitcnt vmcnt(0)" ::: "memory"); SWRITE(0, SE); __syncthreads();
    QKT(pA0, pA1, K_lds); partialSM(pA0, pA1, m_reg, mnA, alA, a.C, a.thr);
    SLOAD(SO, 1); if (SDEPTH == 2 && 2 < NT) SLOAD(SE, 2);
    SWRITE(1, SO); __syncthreads();
    for (int j = 1; j + 1 < NT; j += 2) {
        SBAR(); QKT(pB0, pB1, K_lds + SHM_K);
        finishSM(pA0, pA1, alA, l_reg, pa0, pa1, pa2, pa3); SBAR();
        SLOAD(SO, j + SDEPTH); SBAR();
        pv_d0(o, vb0, pa0, pa1, pa2, pa3); partialSM(pB0, pB1, m_reg, mnB, alB, a.C, a.thr);
        __syncthreads(); SWRITE(0, SE);
        RESC(alB); __syncthreads();
        SBAR(); QKT(pA0, pA1, K_lds);
        finishSM(pB0, pB1, alB, l_reg, pa0, pa1, pa2, pa3); SBAR();
        if (SDEPTH == 1 || j + 3 < NT) SLOAD(SE, j + 1 + SDEPTH); SBAR();
        pv_d0(o, vb0 + SHM_V, pa0, pa1, pa2, pa3); partialSM(pA0, pA1, m_reg, mnA, alA, a.C, a.thr);
        __syncthreads(); SWRITE(1, SO);
        RESC(alA); __syncthreads();
    }
    SBAR(); QKT(pB0, pB1, K_lds + SHM_K);
    finishSM(pA0, pA1, alA, l_reg, pa0, pa1, pa2, pa3); SBAR();
    pv_d0(o, vb0, pa0, pa1, pa2, pa3); partialSM(pB0, pB1, m_reg, mnB, alB, a.C, a.thr);
    __syncthreads(); RESC(alB);
    finishSM(pB0, pB1, alB, l_reg, pa0, pa1, pa2, pa3); SBAR();
    pv_d0(o, vb0 + SHM_V, pa0, pa1, pa2, pa3);
    if (hi == 0) li_l[r32] = l_reg; asm volatile("s_waitcnt lgkmcnt(0)" ::: "memory");
#pragma unroll
    for (int r = 0; r < 16; ++r) { const float rl = __builtin_amdgcn_rcpf(li_l[crow(r, hi)]);
#pragma unroll
        for (int d = 0; d < 4; ++d) o[d][r] *= rl; }
    __syncthreads();
#undef KROW
#undef SLOAD
#undef SWRITE
#undef RESC
#undef QKT
}

__device__ __forceinline__ void phase_attn_mla(const Params& p, char* lds) {
    const bf16_t* T1 = (const bf16_t*)(p.ws + WS_T1); bf16_t* O = (bf16_t*)(p.ws + WS_H);
    const int tid = tid_opaque(), wid = tid >> 6, lane = tid & 63, r32 = lane & 31, hi = lane >> 5;
    const float scale = 0.07216878364870322f;
    for (int it = blockIdx.x; it < 1024 + 128; it += gridDim.x) {
        int b, h, row0; AttnArgs a;
        if (it < 1024) {
            int itm = it;
            if (gridDim.x == 256) { const int w = it & 255, rnd = it >> 8, xcd = w & 7, slot = w >> 3; itm = ((rnd * 32 + xcd * 4 + (slot >> 3)) << 3) | (slot & 7); }
            b = itm >> 6; h = (itm >> 3) & 7; const int qb = itm & 7; row0 = b * SEQ + qb * 256; a.nlat = 32; a.NT = 36; }
        else { const int i2 = it - 1024; b = i2 >> 3; h = i2 & 7; row0 = MLAT + b * CTXL; a.nlat = 0; a.NT = 4; }
        a.lat0 = b * SEQ; a.ctx0 = MLAT + b * CTXL;
        a.Q = T1 + T_Q + (size_t)row0 * 1536 + h * 192; a.ldq = 1536;
        a.Kn = T1 + T_KV + h * 256; a.ldk = 2048; a.Kr = T1 + T_KR; a.ldkr = 64;
        a.V = T1 + T_KV + h * 256 + 128; a.ldv = 2048;
        a.C = scale * 1.4426950408889634f; a.thr = 8.f / scale;
        f32x16 o[4];
        attn_core<192, 128, 1536, 2048, 64, 2048, MLA_NQL, 1>(a, lds, o);
        bf16_t* Ow = O + (size_t)(row0 + wid * 32 + 4 * hi) * 1024 + h * 128 + r32;
        asm volatile("" : "+v"(Ow));
#pragma unroll
        for (int r = 0; r < 16; ++r) { bf16_t* Or = Ow + (size_t)((r & 3) + 8 * (r >> 2)) * 1024;
#pragma unroll
            for (int d0 = 0; d0 < 4; ++d0) Or[d0 * 32] = (bf16_t)(cvt_pk_bf16(o[d0][r], 0.f) & 0xffffu); }
    }
}

__device__ __forceinline__ void phase_attn_diff(const Params& p, char* lds) {
    const bf16_t* T1 = (const bf16_t*)(p.ws + WS_T1); bf16_t* O = (bf16_t*)(p.ws + WS_H);
    const int tid = tid_opaque(), wid = tid >> 6, lane = tid & 63, r32 = lane & 31, hi = lane >> 5;
    float* scr0 = (float*)(p.ws + WS_SCR) + ((size_t)blockIdx.x * 512 + tid) * 64;
    const float scale = 0.125f;
    const float lam_init = 0.8f - 0.6f * 0.40656965974059917f;
    float lam;
    { const float* lv = p.diff_lambda; float s1 = 0.f, s2 = 0.f;
      for (int k = 0; k < 64; ++k) { s1 += lv[k] * lv[64 + k]; s2 += lv[128 + k] * lv[192 + k]; }
      lam = expf(s1) - expf(s2) + lam_init; }
    float gs[4];
#pragma unroll
    for (int d0 = 0; d0 < 4; ++d0) gs[d0] = p.diff_g_subln[d0 * 32 + r32] * (1.0f - lam_init);
    for (int it = blockIdx.x; it < 1024; it += gridDim.x) {
        int itm = it;
        if (gridDim.x == 256) { const int w = it & 255, rnd = it >> 8, xcd = w & 7, slot = w >> 3; itm = ((rnd * 32 + xcd * 4 + (slot >> 3)) << 3) | (slot & 7); }
        const int b = itm >> 6, h = (itm >> 3) & 7, qb = itm & 7, row0 = b * SEQ + qb * 256;
#pragma unroll 1
        for (int j = 0; j < 2; ++j) {
            AttnArgs a; a.nlat = 32; a.NT = 36; a.lat0 = b * SEQ; a.ctx0 = MLAT + b * CTXL;
            a.Q = T1 + (size_t)row0 * 3072 + h * 128 + j * 64; a.ldq = 3072;
            a.Kn = T1 + 1024 + h * 128 + j * 64; a.ldk = 3072; a.Kr = a.Kn; a.ldkr = 3072;
            a.V = T1 + 2048 + h * 128; a.ldv = 3072;
            a.C = scale * 1.4426950408889634f; a.thr = 8.f / scale;
            f32x16 o[4];
            attn_core<64, 64, 3072, 3072, 3072, 3072, 0, 2>(a, lds, o);
            float* scr = scr0; asm volatile("" : "+v"(scr));
            if (j == 0) {
#pragma unroll
                for (int r = 0; r < 16; ++r) { f32x4 t = {o[0][r], o[1][r], o[2][r], o[3][r]}; *(f32x4*)(scr + 4 * r) = t; }
            } else {
                bf16_t* Ow = O + (size_t)(row0 + wid * 32 + 4 * hi) * 1024 + h * 128 + r32;
                asm volatile("" : "+v"(Ow));
#pragma unroll
                for (int r = 0; r < 16; ++r) {
                    const f32x4 t = *(const f32x4*)(scr + 4 * r);
                    const float v0 = t[0] - lam * o[0][r], v1 = t[1] - lam * o[1][r], v2 = t[2] - lam * o[2][r], v3 = t[3] - lam * o[3][r];
                    float ss = v0 * v0 + v1 * v1 + v2 * v2 + v3 * v3;
#pragma unroll
                    for (int x = 16; x >= 1; x >>= 1) ss += __shfl_xor(ss, x);
                    const float rs = rsqrtf(ss * (1.0f / 128.0f) + EPS);
                    bf16_t* Or = Ow + (size_t)((r & 3) + 8 * (r >> 2)) * 1024;
                    Or[0] = (bf16_t)(cvt_pk_bf16(v0 * rs * gs[0], 0.f) & 0xffffu); Or[32] = (bf16_t)(cvt_pk_bf16(v1 * rs * gs[1], 0.f) & 0xffffu);
                    Or[64] = (bf16_t)(cvt_pk_bf16(v2 * rs * gs[2], 0.f) & 0xffffu); Or[96] = (bf16_t)(cvt_pk_bf16(v3 * rs * gs[3], 0.f) & 0xffffu);
                }
            }
        }
    }
}

__device__ __forceinline__ const float* xin_row(const Params& p, int row, bool from_input) {
    if (from_input) return row < MLAT ? p.x + (size_t)row * DM : p.ctx + (size_t)(row - MLAT) * DM;
    return row < MLAT ? p.out + (size_t)row * DM : (const float*)(p.ws + WS_XC) + (size_t)(row - MLAT) * DM;
}
__device__ __forceinline__ float* xout_row(const Params& p, int row) {
    return row < MLAT ? p.out + (size_t)row * DM : (float*)(p.ws + WS_XC) + (size_t)(row - MLAT) * DM;
}

__device__ __forceinline__ void phase_rn(const Params& p, int layer, int stage, const bf16_t* Y, int nrows, int npart) {
    const int tid = tid_opaque(), wid = tid >> 6, lane = tid & 63;
    const float* MOD = (const float*)(p.ws + WS_MOD); bf16_t* H = (bf16_t*)(p.ws + WS_H);
    const int gate_c = stage == 0 ? 2 : 5;
    const float* gA = p.norm_g + (layer * 4 + (stage == 0 ? 1 : 3)) * DM;
    const bool has_next = !(layer == 3 && stage == 1);
    const int nl = stage == 0 ? layer : layer + 1;
    const float* gB = p.norm_g + ((has_next ? nl : 0) * 4 + (stage == 0 ? 2 : 0)) * DM;
    const int sh_c = stage == 0 ? 3 : 0, sc_c = stage == 0 ? 4 : 1;
    const bool from_input = (layer == 0 && stage == 0);
    for (int row = (blockIdx.x * 8 + wid) * 2; row < nrows; row += gridDim.x * 16) {
        const int mr = modrow(row);
        const float* xi = xin_row(p, row, from_input); float* xo = xout_row(p, row);
        const bf16_t* y = Y + (size_t)row * DM;
        const float* mg = MOD + ((size_t)layer * 17 + mr) * 6144 + gate_c * DM;
        u32x2 yw[2][4]; f32x4 xx[2][4], gg[4], gt[4];
#pragma unroll
        for (int q = 0; q < 2; ++q)
#pragma unroll
            for (int i = 0; i < 4; ++i) { yw[q][i] = __builtin_nontemporal_load((const u32x2*)(y + q * DM + i * 256 + lane * 4)); xx[q][i] = __builtin_nontemporal_load((const f32x4*)(xi + q * DM + i * 256 + lane * 4)); }
#pragma unroll
        for (int i = 0; i < 4; ++i) { gg[i] = *(const f32x4*)(gA + i * 256 + lane * 4); gt[i] = *(const f32x4*)(mg + i * 256 + lane * 4); }
        float yv[2][16]; float ss[2] = {0.f, 0.f};
#pragma unroll
        for (int q = 0; q < 2; ++q)
#pragma unroll
            for (int i = 0; i < 4; ++i) { yv[q][4 * i] = bf_lo(yw[q][i].x); yv[q][4 * i + 1] = bf_hi(yw[q][i].x); yv[q][4 * i + 2] = bf_lo(yw[q][i].y); yv[q][4 * i + 3] = bf_hi(yw[q][i].y); }
        if (npart > 1 && row >= MLAT) {
            const bf16_t* yp = (const bf16_t*)(p.ws + WS_SCR) + (size_t)(row - MLAT) * DM;
#pragma unroll
            for (int q = 0; q < 2; ++q)
#pragma unroll
                for (int i = 0; i < 4; ++i) { float a4[4] = {0.f, 0.f, 0.f, 0.f};
                    for (int k = 0; k < npart; ++k) { float t4[4]; load_bf4(yp + (size_t)k * MCTX * DM + q * DM + i * 256 + lane * 4, t4); a4[0] += t4[0]; a4[1] += t4[1]; a4[2] += t4[2]; a4[3] += t4[3]; }
                    yv[q][4 * i] = a4[0]; yv[q][4 * i + 1] = a4[1]; yv[q][4 * i + 2] = a4[2]; yv[q][4 * i + 3] = a4[3]; }
        }
#pragma unroll
        for (int q = 0; q < 2; ++q)
#pragma unroll
            for (int i = 0; i < 16; ++i) ss[q] += yv[q][i] * yv[q][i];
#pragma unroll
        for (int o = 32; o >= 1; o >>= 1) { ss[0] += __shfl_xor(ss[0], o); ss[1] += __shfl_xor(ss[1], o); }
        float ss2[2] = {0.f, 0.f};
#pragma unroll
        for (int q = 0; q < 2; ++q) { const float r1 = rsqrtf(ss[q] * (1.0f / DM) + EPS);
#pragma unroll
            for (int i = 0; i < 4; ++i) { f32x4 xn;
#pragma unroll
                for (int j = 0; j < 4; ++j) { xn[j] = xx[q][i][j] + gt[i][j] * (yv[q][4 * i + j] * r1 * gg[i][j]); ss2[q] += xn[j] * xn[j]; }
                xx[q][i] = xn; __builtin_nontemporal_store(xn, (f32x4*)(xo + q * DM + i * 256 + lane * 4)); } }
        if (has_next) {
            const float* msh = MOD + ((size_t)nl * 17 + mr) * 6144 + sh_c * DM; const float* msc = MOD + ((size_t)nl * 17 + mr) * 6144 + sc_c * DM;
            f32x4 gb[4], sh[4], sc[4];
#pragma unroll
            for (int i = 0; i < 4; ++i) { gb[i] = *(const f32x4*)(gB + i * 256 + lane * 4); sh[i] = *(const f32x4*)(msh + i * 256 + lane * 4); sc[i] = *(const f32x4*)(msc + i * 256 + lane * 4); }
#pragma unroll
            for (int o = 32; o >= 1; o >>= 1) { ss2[0] += __shfl_xor(ss2[0], o); ss2[1] += __shfl_xor(ss2[1], o); }
#pragma unroll
            for (int q = 0; q < 2; ++q) { const float r2 = rsqrtf(ss2[q] * (1.0f / DM) + EPS);
#pragma unroll
                for (int i = 0; i < 4; ++i) { float hv[4];
#pragma unroll
                    for (int j = 0; j < 4; ++j) hv[j] = (xx[q][i][j] * r2 * gb[i][j]) * (1.0f + sc[i][j]) + sh[i][j];
                    store_bf4(H + (size_t)(row + q) * DM + i * 256 + lane * 4, hv[0], hv[1], hv[2], hv[3]); } }
        }
    }
}

template <int I> __device__ __forceinline__ void poold_group(const float* xb, const float* RSs, int t0, int len, int lane, const float* g0, const float* msc, bf16_t* Hrow0) {
    constexpr int W = 2 << I, LO = W / 2, HI = W - 1 - LO, NR = 8 + W - 1;
    const int col = I * 256 + lane * 4;
    f32x4 xs[NR];
#pragma unroll
    for (int k = 0; k < NR; ++k) { const int tt = t0 - LO + k; const bool ok = (tt >= 0 && tt < len); const int tc = ok ? tt : t0;
        const f32x4 xx = *(const f32x4*)(xb + (size_t)tc * DM + col); const float rs = ok ? RSs[tc] : 0.f; xs[k] = xx * rs; }
    const f32x4 gg = *(const f32x4*)(g0 + col), sc = *(const f32x4*)(msc + col);
    f32x4 gm;
#pragma unroll
    for (int j = 0; j < 4; ++j) gm[j] = gg[j] * (1.0f + sc[j]);
    f32x4 S = xs[0];
#pragma unroll
    for (int k = 1; k < W; ++k) S += xs[k];
#pragma unroll
    for (int r = 0; r < 8; ++r) {
        const int t = t0 + r; const int ta = max(t - LO, 0), tb = min(t + HI + 1, len); const float inv = 1.0f / (float)(tb - ta);
        const f32x4 d = (S * inv - xs[r + LO]) * gm;
        store_bf4(Hrow0 + (size_t)r * DM + col, d[0], d[1], d[2], d[3]);
        if (r < 7) S += xs[r + W] - xs[r];
    }
}
__device__ __forceinline__ void phase_poold(const Params& p) {
    const int tid = tid_opaque(), wid = tid >> 6, lane = tid & 63;
    const float* MOD = (const float*)(p.ws + WS_MOD); const float* RS = (const float*)(p.ws + WS_RS); bf16_t* H = (bf16_t*)(p.ws + WS_H);
    const float* g0 = p.norm_g;
    for (int task = blockIdx.x * 8 + wid; task < (MALL / 8) * 4; task += gridDim.x * 8) {
        const int row = (task >> 2) * 8, grp = task & 3;
        const int mr = modrow(row);
        const int s0 = row < MLAT ? (row & ~(SEQ - 1)) : MLAT + ((row - MLAT) & ~(CTXL - 1)); const int len = row < MLAT ? SEQ : CTXL; const int t0 = row - s0;
        const float* xb = row < MLAT ? p.x + (size_t)s0 * DM : p.ctx + (size_t)(s0 - MLAT) * DM;
        const float* msc = MOD + ((size_t)0 * 17 + mr) * 6144 + 1 * DM;
        bf16_t* Hr = H + (size_t)row * DM;
        if (grp == 0) poold_group<0>(xb, RS + s0, t0, len, lane, g0, msc, Hr);
        else if (grp == 1) poold_group<1>(xb, RS + s0, t0, len, lane, g0, msc, Hr);
        else if (grp == 2) poold_group<2>(xb, RS + s0, t0, len, lane, g0, msc, Hr);
        else poold_group<3>(xb, RS + s0, t0, len, lane, g0, msc, Hr);
    }
}

__device__ __forceinline__ void phase_conv(const Params& p) {
    const int tid = tid_opaque(), wid = tid >> 6, lane = tid & 63;
    const bf16_t* T1 = (const bf16_t*)(p.ws + WS_T1); bf16_t* H = (bf16_t*)(p.ws + WS_H);
    for (int task = blockIdx.x * 8 + wid; task < (MALL / 8) * 4; task += gridDim.x * 8) {
        const int row = (task >> 2) * 8;
        const int s0 = row < MLAT ? (row & ~(SEQ - 1)) : MLAT + ((row - MLAT) & ~(CTXL - 1)); const int len = row < MLAT ? SEQ : CTXL; const int t0 = row - s0;
        { const int i = task & 3;
            const int col = i * 256 + lane * 4;
            u32x2 cw[10], vw[10], bw[8];
#pragma unroll
            for (int k = 0; k < 10; ++k) { const int tt = t0 - 1 + k; const bool ok = (tt >= 0 && tt < len); const int tc = ok ? tt : t0;
                const bf16_t* rp = T1 + (size_t)(s0 + tc) * 3072; cw[k] = *(const u32x2*)(rp + 1024 + col); vw[k] = *(const u32x2*)(rp + 2048 + col);
                if (!ok) { cw[k].x = 0u; cw[k].y = 0u; } }
#pragma unroll
            for (int r = 0; r < 8; ++r) bw[r] = *(const u32x2*)(T1 + (size_t)(row + r) * 3072 + col);
            const f32x4 w0 = *(const f32x4*)(p.conv_w + col), w1 = *(const f32x4*)(p.conv_w + DM + col), w2 = *(const f32x4*)(p.conv_w + 2 * DM + col);
            f32x4 u[10];
#pragma unroll
            for (int k = 0; k < 10; ++k) { u[k][0] = bf_lo(cw[k].x) * bf_lo(vw[k].x); u[k][1] = bf_hi(cw[k].x) * bf_hi(vw[k].x); u[k][2] = bf_lo(cw[k].y) * bf_lo(vw[k].y); u[k][3] = bf_hi(cw[k].y) * bf_hi(vw[k].y); }
#pragma unroll
            for (int r = 0; r < 8; ++r) { const f32x4 z = u[r] * w0 + u[r + 1] * w1 + u[r + 2] * w2;
                store_bf4(H + (size_t)(row + r) * DM + col, bf_lo(bw[r].x) * z[0], bf_hi(bw[r].x) * z[1], bf_lo(bw[r].y) * z[2], bf_hi(bw[r].y) * z[3]); }
        }
    }
}

__device__ __forceinline__ void phase_mlaprep(const Params& p) {
    const int tid = tid_opaque(), wid = tid >> 6, lane = tid & 63;
    bf16_t* T1 = (bf16_t*)(p.ws + WS_T1); bf16_t* CKV = (bf16_t*)(p.ws + WS_H); const float* rope = (const float*)(p.ws + WS_ROPE);
    for (int row4 = (blockIdx.x * 8 + wid) * 4; row4 < MALL; row4 += gridDim.x * 32) {
      u32x2 araw[4][3];
#pragma unroll
      for (int q = 0; q < 4; ++q)
#pragma unroll
        for (int i = 0; i < 3; ++i) araw[q][i] = *(const u32x2*)(T1 + T_AB + (size_t)(row4 + q) * 768 + i * 256 + lane * 4);
#pragma unroll
      for (int q = 0; q < 4; ++q) {
        const int row = row4 + q;
        float v[12]; float sq = 0.f, skv = 0.f;
#pragma unroll
        for (int i = 0; i < 3; ++i) { const int col = i * 256 + lane * 4; v[4 * i] = bf_lo(araw[q][i].x); v[4 * i + 1] = bf_hi(araw[q][i].x); v[4 * i + 2] = bf_lo(araw[q][i].y); v[4 * i + 3] = bf_hi(araw[q][i].y);
            const float s = v[4 * i] * v[4 * i] + v[4 * i + 1] * v[4 * i + 1] + v[4 * i + 2] * v[4 * i + 2] + v[4 * i + 3] * v[4 * i + 3];
            if (col < 384) sq += s; else if (col < 640) skv += s; }
        sq = wave_sum(sq); skv = wave_sum(skv);
        const float rq = rsqrtf(sq * (1.0f / 384.0f) + EPS), rkv = rsqrtf(skv * (1.0f / 256.0f) + EPS);
#pragma unroll
        for (int i = 0; i < 3; ++i) { const int col = i * 256 + lane * 4;
            if (col < 384) { const f32x4 g = *(const f32x4*)(p.mla_g_q + col);
                store_bf4(T1 + T_CQ + (size_t)row * 384 + col, v[4 * i] * rq * g[0], v[4 * i + 1] * rq * g[1], v[4 * i + 2] * rq * g[2], v[4 * i + 3] * rq * g[3]); }
            else if (col < 640) { const int c2 = col - 384; const f32x4 g = *(const f32x4*)(p.mla_g_kv + c2);
                store_bf4(CKV + (size_t)row * 256 + c2, v[4 * i] * rkv * g[0], v[4 * i + 1] * rkv * g[1], v[4 * i + 2] * rkv * g[2], v[4 * i + 3] * rkv * g[3]); }
        }
        {
            float pv[4];
#pragma unroll
            for (int j = 0; j < 4; ++j) pv[j] = __shfl_xor(v[8 + j], 4);
            if (lane >= 32 && lane < 48) {
                const int k = lane - 32; float ov[4];
                if (row < MLAT) {
                    const int t = row & (SEQ - 1); const int pos = (k < 8) ? (t >> 6) : (t & 63);
                    const f32x4 t0 = *(const f32x4*)(rope + (pos * 16 + 4 * (k & 3)) * 2), t1 = *(const f32x4*)(rope + (pos * 16 + 4 * (k & 3)) * 2 + 4);
                    const float cs[4] = {t0[0], t0[2], t1[0], t1[2]}, sn[4] = {t0[1], t0[3], t1[1], t1[3]};
#pragma unroll
                    for (int j = 0; j < 4; ++j) ov[j] = (k & 4) ? (v[8 + j] * cs[j] + pv[j] * sn[j]) : (v[8 + j] * cs[j] - pv[j] * sn[j]);
                } else {
#pragma unroll
                    for (int j = 0; j < 4; ++j) ov[j] = v[8 + j];
                }
                store_bf4(T1 + T_KR + (size_t)row * 64 + 4 * k, ov[0], ov[1], ov[2], ov[3]);
            }
        }
      }
    }
}

__device__ __forceinline__ void conv_wt(const float* src, int K, int N, int Npad, bf16_t* dst, float* tile, int rot) {
    const int tid = tid_opaque(), G = gridDim.x;
    const int ntn = Npad / 64, ntk = K / 64, ntiles = ntn * ntk;
    const int r = tid >> 4, c4 = (tid & 15) * 4;
    int u = (blockIdx.x + G - (rot % G)) % G;
    f32x4 v0 = {0.f, 0.f, 0.f, 0.f}, v1 = {0.f, 0.f, 0.f, 0.f};
    if (u < ntiles) { const int k0 = (u / ntn) * 64, n0 = (u % ntn) * 64;
        if (n0 + c4 < N) { v0 = __builtin_nontemporal_load((const f32x4*)(src + (size_t)(k0 + r) * N + n0 + c4)); v1 = __builtin_nontemporal_load((const f32x4*)(src + (size_t)(k0 + r + 32) * N + n0 + c4)); } }
    for (; u < ntiles; u += G) {
        const int k0 = (u / ntn) * 64, n0 = (u % ntn) * 64;
        const int un = u + G; f32x4 w0 = {0.f, 0.f, 0.f, 0.f}, w1 = {0.f, 0.f, 0.f, 0.f};
        if (un < ntiles) { const int k1 = (un / ntn) * 64, n1 = (un % ntn) * 64;
            if (n1 + c4 < N) { w0 = __builtin_nontemporal_load((const f32x4*)(src + (size_t)(k1 + r) * N + n1 + c4)); w1 = __builtin_nontemporal_load((const f32x4*)(src + (size_t)(k1 + r + 32) * N + n1 + c4)); } }
        tile[r * 65 + c4 + 0] = v0[0]; tile[r * 65 + c4 + 1] = v0[1]; tile[r * 65 + c4 + 2] = v0[2]; tile[r * 65 + c4 + 3] = v0[3];
        tile[(r + 32) * 65 + c4 + 0] = v1[0]; tile[(r + 32) * 65 + c4 + 1] = v1[1]; tile[(r + 32) * 65 + c4 + 2] = v1[2]; tile[(r + 32) * 65 + c4 + 3] = v1[3];
        __syncthreads();
        { const int n = tid >> 3, k8 = (tid & 7) * 8; float t[8];
#pragma unroll
          for (int j = 0; j < 8; ++j) t[j] = tile[(k8 + j) * 65 + n];
          u32x4 w; w.x = cvt_pk_bf16(t[0], t[1]); w.y = cvt_pk_bf16(t[2], t[3]); w.z = cvt_pk_bf16(t[4], t[5]); w.w = cvt_pk_bf16(t[6], t[7]);
          *(u32x4*)(dst + (size_t)(n0 + n) * K + k0 + k8) = w; }
        __syncthreads();
        v0 = w0; v1 = w1;
    }
}

__device__ __forceinline__ void phase_prep(const Params& p, char* lds) {
    const int tid = tid_opaque(), wid = tid >> 6, lane = tid & 63, G = gridDim.x;
    float* fl = (float*)lds;
    if (blockIdx.x < 192) {
        { f32x4 cvv[9];
#pragma unroll
          for (int q = 0; q < 9; ++q) { const int idx = tid + q * NTHREADS; const int r = idx >> 8, k4 = (idx & 255) * 4; cvv[q] = (idx < 17 * 256) ? *(const f32x4*)(r < 16 ? p.c + r * 1024 + k4 : p.c_ctx + k4) : (f32x4){0.f, 0.f, 0.f, 0.f}; }
#pragma unroll
          for (int q = 0; q < 9; ++q) { const int idx = tid + q * NTHREADS; const int r = idx >> 8, k4 = (idx & 255) * 4;
              if (idx < 17 * 256) {
#pragma unroll
                  for (int j = 0; j < 4; ++j) fl[(k4 + j) * 17 + r] = cvv[q][j] / (1.0f + expf(-cvv[q][j])); } } }
        __syncthreads();
        float* MOD = (float*)(p.ws + WS_MOD);
        for (int u = blockIdx.x; u < 192; u += G) {
            const int layer = u / 48, cb = u % 48, col0 = cb * 128 + wid * 16 + (lane & 3) * 4, kq = lane >> 2;
            float acc[17][4];
#pragma unroll
            for (int r = 0; r < 17; ++r)
#pragma unroll
                for (int j = 0; j < 4; ++j) acc[r][j] = 0.f;
            const float* W = p.ada_w + (size_t)layer * 1024 * 6144 + col0;
#pragma unroll 8
            for (int itk = 0; itk < 64; ++itk) { const int k = kq + 16 * itk; const f32x4 w = __builtin_nontemporal_load((const f32x4*)(W + (size_t)k * 6144));
#pragma unroll
                for (int r = 0; r < 17; ++r) { const float s_ = fl[k * 17 + r];
#pragma unroll
                    for (int j = 0; j < 4; ++j) acc[r][j] += s_ * w[j]; } }
#pragma unroll
            for (int r = 0; r < 17; ++r)
#pragma unroll
                for (int j = 0; j < 4; ++j) { float v = acc[r][j]; v += __shfl_xor(v, 4); v += __shfl_xor(v, 8); v += __shfl_xor(v, 16); v += __shfl_xor(v, 32); acc[r][j] = v; }
            if (kq == 0) { const f32x4 bb = *(const f32x4*)(p.ada_b + layer * 6144 + col0);
#pragma unroll
                for (int r = 0; r < 17; ++r) { f32x4 o = {acc[r][0] + bb[0], acc[r][1] + bb[1], acc[r][2] + bb[2], acc[r][3] + bb[3]}; *(f32x4*)(MOD + ((size_t)layer * 17 + r) * 6144 + col0) = o; } }
        }
        __syncthreads();
    }
    if (blockIdx.x == G - 1) {
        float* rt = (float*)(p.ws + WS_ROPE);
        for (int idx = tid; idx < 1024; idx += NTHREADS) { const int pos = idx >> 4, f = idx & 15; const float inv = powf(10000.0f, -(float)f / 16.0f); const float ang = (float)pos * inv;
            rt[idx * 2] = cosf(ang); rt[idx * 2 + 1] = sinf(ang); }
    }
    { float* RS = (float*)(p.ws + WS_RS);
      for (int row = (blockIdx.x * 8 + wid) * 4; row < MALL; row += G * 32) { const float* xi = xin_row(p, row, true); f32x4 xx[4][4];
#pragma unroll
          for (int q = 0; q < 4; ++q)
#pragma unroll
              for (int i = 0; i < 4; ++i) xx[q][i] = *(const f32x4*)(xi + q * DM + i * 256 + lane * 4);
          float ss[4] = {0.f, 0.f, 0.f, 0.f};
#pragma unroll
          for (int q = 0; q < 4; ++q)
#pragma unroll
              for (int i = 0; i < 4; ++i) ss[q] += xx[q][i][0] * xx[q][i][0] + xx[q][i][1] * xx[q][i][1] + xx[q][i][2] * xx[q][i][2] + xx[q][i][3] * xx[q][i][3];
#pragma unroll
          for (int o = 32; o >= 1; o >>= 1) { ss[0] += __shfl_xor(ss[0], o); ss[1] += __shfl_xor(ss[1], o); ss[2] += __shfl_xor(ss[2], o); ss[3] += __shfl_xor(ss[3], o); }
          if (lane < 4) RS[row + lane] = rsqrtf((lane == 0 ? ss[0] : lane == 1 ? ss[1] : lane == 2 ? ss[2] : ss[3]) * (1.0f / DM) + EPS); } }
    bf16_t* W = (bf16_t*)(p.ws + WS_W);
    int rot = 192;
    for (int l = 0; l < 4; ++l) {
        conv_wt(p.ffn_w1 + (size_t)l * 1024 * 4096, 1024, 4096, 4096, W + W_FFN + (size_t)l * 8388608, fl, rot); rot += 1024;
        conv_wt(p.ffn_w2 + (size_t)l * 4096 * 1024, 4096, 1024, 1024, W + W_FFN + (size_t)l * 8388608 + 4194304, fl, rot); rot += 1024;
    }
    for (int g = 0; g < 4; ++g) { conv_wt(p.pool_w + (size_t)g * 65536, 256, 256, 256, W + W_POOL + (size_t)g * 65536, fl, rot); rot += 16; }
    conv_wt(p.conv_in_w, 1024, 3072, 3072, W + W_CIN, fl, rot); rot += 768;
    conv_wt(p.conv_out_w, 1024, 1024, 1024, W + W_COUT, fl, rot); rot += 256;
    conv_wt(p.mla_w_down, 1024, 704, 768, W + W_DOWN, fl, rot); rot += 192;
    conv_wt(p.mla_w_uq, 384, 1536, 1536, W + W_UQ, fl, rot); rot += 144;
    conv_wt(p.mla_w_ukv, 256, 2048, 2048, W + W_UKV, fl, rot); rot += 128;
    conv_wt(p.mla_w_o, 1024, 1024, 1024, W + W_MO, fl, rot); rot += 256;
    conv_wt(p.diff_w_qkv, 1024, 3072, 3072, W + W_DQKV, fl, rot); rot += 768;
    conv_wt(p.diff_w_o, 1024, 1024, 1024, W + W_DO, fl, rot);
}

__device__ __forceinline__ void grid_barrier(unsigned* bar, unsigned gen) {
    asm volatile("s_waitcnt vmcnt(0) lgkmcnt(0)" ::: "memory");
    __syncthreads();
    if (threadIdx.x < 64) {
        if (threadIdx.x == 0) {
            const unsigned g = blockIdx.x & 7, G = gridDim.x, gsize = (G + 7 - g) >> 3, ng = G < 8 ? G : 8;
            __builtin_amdgcn_fence(__ATOMIC_RELEASE, "agent");
            asm volatile("s_waitcnt vmcnt(0)" ::: "memory");
            if (__hip_atomic_fetch_add(bar + 64 * (1 + g), 1u, __ATOMIC_RELAXED, __HIP_MEMORY_SCOPE_AGENT) + 1 == gen * gsize) {
                if (__hip_atomic_fetch_add(bar, 1u, __ATOMIC_RELAXED, __HIP_MEMORY_SCOPE_AGENT) + 1 == gen * ng) {
                    for (unsigned j = 0; j < ng; ++j) __hip_atomic_store(bar + 64 * (9 + j), gen, __ATOMIC_RELAXED, __HIP_MEMORY_SCOPE_AGENT);
                }
            }
            while (__hip_atomic_load(bar + 64 * (9 + g), __ATOMIC_RELAXED, __HIP_MEMORY_SCOPE_AGENT) < gen) __builtin_amdgcn_s_sleep(1);
        }
        __builtin_amdgcn_fence(__ATOMIC_ACQUIRE, "agent");
        asm volatile("s_waitcnt vmcnt(0)" ::: "memory");
    }
    __syncthreads();
}

enum { T_PREP = 0, T_POOLD, T_GEMM, T_RN, T_CONV, T_MLAPREP, T_ATTN_MLA, T_ATTN_DIFF };
constexpr int N_PHASES = 31;

__global__ void __launch_bounds__(NTHREADS, 2) mk_fwd(Params p_arg) {
    extern __shared__ __attribute__((aligned(16))) unsigned char shm[];
    LAS unsigned char* ldsl = (LAS unsigned char*)shm; char* ldsg = (char*)shm;
    const int ph_lo = p_arg.ph_lo, ph_hi = p_arg.ph_hi; unsigned char* const wsb = p_arg.ws;
    bf16_t* H = (bf16_t*)(wsb + WS_H); bf16_t* T1 = (bf16_t*)(wsb + WS_T1); const bf16_t* W = (const bf16_t*)(wsb + WS_W);
    const float* rope = (const float*)(wsb + WS_ROPE);
    unsigned nbar = 0; unsigned* barcnt = (unsigned*)(wsb + WS_BAR);
    for (int ph = ph_lo; ph < ph_hi; ++ph) {
#if defined(__HIP_DEVICE_COMPILE__)
        typedef const __attribute__((address_space(4))) Params* KArgP;
        KArgP pp = (KArgP)__builtin_amdgcn_kernarg_segment_ptr(); asm volatile("" : "+s"(pp));
        const Params p = *pp;
#else
        const Params p = p_arg;
#endif
        int type = T_GEMM, sync = 1, layer = 0, stage = 0, nrows = MALL, npart = 1; const bf16_t* Y = T1;
        GemmP g; g.A = H; g.Bt = W; g.lda = 1024; g.ldb = 1024; g.K = 1024; g.nM = 144; g.nN = 4; g.a_pn_off = 0; g.ksplit = 1; g.a_tiled = 0; g.rev = 0; g.magicN = 16384;
        EpiP e; e.O = T1; e.ldo = 1024; e.mode = 0; e.colscale = nullptr; e.rope = rope; e.Opart = (bf16_t*)(wsb + WS_SCR);
        switch (ph) {
        case 0: type = T_PREP; break;
        case 1: type = T_POOLD; break;
        case 2: g.Bt = W + W_POOL; g.ldb = 256; g.K = 256; g.a_pn_off = 256; e.colscale = p.pool_scale; break;
        case 3: type = T_RN; layer = 0; stage = 0; Y = T1; break;
        case 4: case 11: case 21: case 28: { const int l = ph == 4 ? 0 : ph == 11 ? 1 : ph == 21 ? 2 : 3;
            g.Bt = W + W_FFN + (size_t)l * 8388608; g.nN = 16; g.magicN = 4096; g.nM = l == 3 ? 128 : 144; e.ldo = 4096; e.mode = 1; } break;
        case 5: case 12: case 22: case 29: { const int l = ph == 5 ? 0 : ph == 12 ? 1 : ph == 22 ? 2 : 3;
            g.A = T1; g.lda = 4096; g.Bt = W + W_FFN + (size_t)l * 8388608 + 4194304; g.ldb = 4096; g.K = 4096; g.nM = l == 3 ? 128 : 144; g.ksplit = l == 3 ? 1 : 4; g.a_tiled = 1; e.O = H; } break;
        case 6: type = T_RN; layer = 0; stage = 1; Y = H; npart = 4; break;
        case 7: g.Bt = W + W_CIN; g.nN = 12; g.magicN = 5462; e.ldo = 3072; break;
        case 8: type = T_CONV; break;
        case 9: g.Bt = W + W_COUT; g.ksplit = 4; break;
        case 10: type = T_RN; layer = 1; stage = 0; Y = T1; npart = 4; break;
        case 13: type = T_RN; layer = 1; stage = 1; Y = H; npart = 4; break;
        case 14: g.Bt = W + W_DOWN; g.nN = 3; g.magicN = 21846; e.O = T1 + T_AB; e.ldo = 768; break;
        case 15: type = T_MLAPREP; break;
        case 16: g.A = T1 + T_CQ; g.lda = 384; g.Bt = W + W_UQ; g.ldb = 384; g.K = 384; g.nN = 6; g.magicN = 10923; e.O = T1 + T_Q; e.ldo = 1536; e.mode = 3; break;
        case 17: sync = 0; g.rev = 1; g.A = H; g.lda = 256; g.Bt = W + W_UKV; g.ldb = 256; g.K = 256; g.nN = 8; g.magicN = 8192; e.O = T1 + T_KV; e.ldo = 2048; break;
        case 18: type = T_ATTN_MLA; break;
        case 19: g.Bt = W + W_MO; g.ksplit = 4; break;
        case 20: type = T_RN; layer = 2; stage = 0; Y = T1; npart = 4; break;
        case 23: type = T_RN; layer = 2; stage = 1; Y = H; npart = 4; break;
        case 24: g.Bt = W + W_DQKV; g.nN = 12; g.magicN = 5462; e.ldo = 3072; e.mode = 2; break;
        case 25: type = T_ATTN_DIFF; break;
        case 26: g.Bt = W + W_DO; g.nM = 128; break;
        case 27: type = T_RN; layer = 3; stage = 0; Y = T1; nrows = MLAT; break;
        case 30: type = T_RN; layer = 3; stage = 1; Y = H; nrows = MLAT; break;
        default: break;
        }
        if (ph > ph_lo && sync) { if (ph_hi > N_PHASES) cg::this_grid().sync(); else { ++nbar; grid_barrier(barcnt, nbar); } }
#ifdef REPEAT_MASK
        for (int rep_ = 0; rep_ < (((REPEAT_MASK) >> ph) & 1 ? 2 : 1); ++rep_) {
        if (rep_) cg::this_grid().sync();
#endif
        switch (type) {
#ifndef PH_MASK
#define PH_MASK 0xff
#endif
#if PH_MASK & 1
        case T_PREP: phase_prep(p, ldsg); break;
#endif
#if PH_MASK & 2
        case T_POOLD: phase_poold(p); break;
#endif
#if PH_MASK & 4
        case T_GEMM: gemm_phase(ldsl, g, e); break;
#endif
#if PH_MASK & 8
        case T_RN: phase_rn(p, layer, stage, Y, nrows, npart); break;
#endif
#if PH_MASK & 16
        case T_CONV: phase_conv(p); break;
#endif
#if PH_MASK & 32
        case T_MLAPREP: phase_mlaprep(p); break;
#endif
#if PH_MASK & 64
        case T_ATTN_MLA: phase_attn_mla(p, ldsg); break;
#endif
#if PH_MASK & 128
        case T_ATTN_DIFF: phase_attn_diff(p, ldsg); break;
#endif
        }
#ifdef REPEAT_MASK
        }
#endif
    }
}

extern "C" void kernel_launch(void* const* d_in, const int* in_sizes, int n_in, void* d_out, int out_size, void* d_ws, size_t ws_size, hipStream_t stream) {
    static int grid = 0;
    if (grid == 0) {
        if (n_in != 24 || out_size != MLAT * DM || ws_size < WS_END) { fprintf(stderr, "kernel_launch: unexpected shapes (n_in %d out %d ws %zu need %zu)\n", n_in, out_size, ws_size, (size_t)WS_END); grid = -1; return; }
        if (hipFuncSetAttribute((const void*)mk_fwd, hipFuncAttributeMaxDynamicSharedMemorySize, LDS_BYTES) != hipSuccess) { fprintf(stderr, "kernel_launch: hipFuncSetAttribute failed\n"); grid = -1; return; }
        int dev = 0, cus = 0, per_cu = 0;
        (void)hipGetDevice(&dev); (void)hipDeviceGetAttribute(&cus, hipDeviceAttributeMultiprocessorCount, dev);
        (void)hipOccupancyMaxActiveBlocksPerMultiprocessor(&per_cu, (const void*)mk_fwd, NTHREADS, LDS_BYTES);
        if (per_cu < 1) { fprintf(stderr, "kernel_launch: occupancy query says %d blocks per CU\n", per_cu); per_cu = 1; }
        (void)hipGetLastError();
        grid = cus * 1;
        if (grid > 256) grid = 256;
    }
    if (grid < 0) return;
    Params p{};
    const float** pp = (const float**)&p;
    for (int i = 0; i < 24; ++i) pp[i] = (const float*)d_in[i];
    p.out = (float*)d_out; p.ws = (unsigned char*)d_ws;
#if MK_ONE_LAUNCH
    (void)hipMemsetAsync((char*)d_ws + WS_BAR, 0, 17 * 256, stream);
    p.ph_lo = 0; p.ph_hi = N_PHASES;
    void* args[] = {&p};
    hipError_t e = hipLaunchCooperativeKernel((const void*)mk_fwd, dim3(grid), dim3(NTHREADS), args, LDS_BYTES, stream);
    if (e != hipSuccess) fprintf(stderr, "cooperative launch failed: %s (grid %d)\n", hipGetErrorString(e), grid);
#else
    for (int ph = 0; ph < N_PHASES; ++ph) {
        p.ph_lo = ph; p.ph_hi = ph + 1;
        hipLaunchKernelGGL(mk_fwd, dim3(grid), dim3(NTHREADS), LDS_BYTES, stream, p);
    }
#endif
}
```
